# Optimizing an MI355X kernel written in HIP

```python
import jax
import jax.numpy as jnp
from jax import lax
import numpy as np

D_MODEL = 2048
BATCH = 4
SEQ = 2048
DEPTH = 1

GRID_W = 64
CTX_LEN = 256

RET_HEADS = 8
RET_DK = 128
RET_DV = 128
RET_CHUNK = 128
RET_W = RET_HEADS * RET_DV

MLA_HEADS = 8
MLA_Q_LORA = 512
MLA_KV_LORA = 256
MLA_NOPE = 128
MLA_ROPE = 64
MLA_DV = 128
MLA_W = MLA_HEADS * MLA_DV
Q_BLOCK = 128

MIX_W = RET_W + MLA_W
IN_SIZES = (RET_HEADS * RET_DK, RET_HEADS * RET_DK, RET_W, RET_W, MLA_Q_LORA, MLA_KV_LORA, MLA_ROPE)
IN_W = sum(IN_SIZES)

N_GROUPS = 4
EXPERTS_PER_GROUP = 8
TOP_K = 2
D_EXPERT = 512

ROPE_BASE = 10000.0
EPS = 1e-6
DEEPNORM_ALPHA = (2.0 * DEPTH) ** 0.25
DEEPNORM_BETA = (8.0 * DEPTH) ** -0.25
F32 = jnp.float32

kernel_name = 'hybrid_retention_mla_hmoe_diffusion_block'


def plain_norm(x):
    xf = x.astype(F32)
    mu = jnp.mean(xf, -1, keepdims=True)
    var = jnp.mean(jnp.square(xf - mu), -1, keepdims=True)
    return (xf - mu) * lax.rsqrt(var + EPS)


def layer_norm(x, w, b):
    return (plain_norm(x) * w.astype(F32) + b.astype(F32)).astype(x.dtype)


def rms_norm(x, w):
    xf = x.astype(F32)
    y = xf * lax.rsqrt(jnp.mean(jnp.square(xf), -1, keepdims=True) + EPS)
    return (y * w.astype(F32)).astype(x.dtype)


def modulate(x, shift, scale):
    y = plain_norm(x) * (1.0 + scale[:, None].astype(F32)) + shift[:, None].astype(F32)
    return y.astype(x.dtype)


def to_heads(t, n_heads):
    b, l, w = t.shape
    return t.reshape(b, l, n_heads, w // n_heads).transpose(0, 2, 1, 3)


def from_heads(t):
    b, h, l, d = t.shape
    return t.transpose(0, 2, 1, 3).reshape(b, l, h * d)


def split_projection(p):
    offs = np.cumsum(np.array(IN_SIZES))[:-1].tolist()
    return jnp.split(p, offs, axis=-1)


def axial_rope(x, rows, cols):
    half = x.shape[-1] // 2
    inv_freq = ROPE_BASE ** (-jnp.arange(0, half, 2, dtype=F32) / half)

    def rotate(xa, pos):
        ang = pos.astype(F32)[:, None] * inv_freq[None, :]
        cos, sin = jnp.cos(ang), jnp.sin(ang)
        x1, x2 = jnp.split(xa.astype(F32), 2, axis=-1)
        return jnp.concatenate([x1 * cos - x2 * sin, x1 * sin + x2 * cos], -1)

    return jnp.concatenate([rotate(x[..., :half], rows), rotate(x[..., half:], cols)], -1).astype(x.dtype)


def retention_chunkwise(q, k, v, log_gamma, state0):
    b, h, l, dk = q.shape
    dv = v.shape[-1]
    n = l // RET_CHUNK
    qc = q.reshape(b, h, n, RET_CHUNK, dk).astype(F32)
    kc = k.reshape(b, h, n, RET_CHUNK, dk).astype(F32)
    vc = v.reshape(b, h, n, RET_CHUNK, dv).astype(F32)
    idx = jnp.arange(RET_CHUNK, dtype=F32)
    lg = log_gamma[:, None]
    diff = idx[:, None] - idx[None, :]
    decay_in = jnp.where(diff >= 0, jnp.exp(log_gamma[:, None, None] * jnp.maximum(diff, 0.0)), 0.0)
    zeta = jnp.exp(lg * (RET_CHUNK - 1.0 - idx))
    xi = jnp.exp(lg * (idx + 1.0))
    chunk_decay = jnp.exp(log_gamma * RET_CHUNK)[None, :, None, None]
    scores = jnp.einsum('bhncd,bhnsd->bhncs', qc, kc) * decay_in[None, :, None]
    o_inner = jnp.einsum('bhncs,bhnse->bhnce', scores, vc)
    chunk_kv = jnp.einsum('bhnsd,bhnse->nbhde', kc * zeta[None, :, None, :, None], vc)

    def step(s, u):
        return chunk_decay * s + u, s

    _, s_prev = lax.scan(step, state0.astype(F32), chunk_kv)
    o_cross = jnp.einsum('bhncd,nbhde->bhnce', qc, s_prev) * xi[None, :, None, :, None]
    return (o_inner + o_cross).reshape(b, h, l, dv)


def retention_final_state(k, v, log_gamma):
    l = k.shape[2]
    pw = jnp.exp(log_gamma[:, None] * (l - 1.0 - jnp.arange(l, dtype=F32)))
    return jnp.einsum('bhld,bhle->bhde', k.astype(F32) * pw[None, :, :, None], v.astype(F32))


def context_retention_states(k, v, log_gamma):
    return (retention_final_state(k, v, log_gamma[0]),
            retention_final_state(jnp.flip(k, 2), jnp.flip(v, 2), log_gamma[1]))


def bidirectional_retention(q, k, v, log_gamma, s_fwd, s_bwd):
    o_fwd = retention_chunkwise(q, k, v, log_gamma[0], s_fwd)
    o_bwd = retention_chunkwise(jnp.flip(q, 2), jnp.flip(k, 2), jnp.flip(v, 2), log_gamma[1], s_bwd)
    return o_fwd + jnp.flip(o_bwd, 2)


def retention_output(o, g, gn_w):
    y = from_heads(plain_norm(o)) * gn_w.astype(F32)
    return (jax.nn.silu(g.astype(F32)) * y).astype(g.dtype)


def mla_queries(c_q, q_norm_w, w_uq):
    return to_heads(rms_norm(c_q, q_norm_w) @ w_uq, MLA_HEADS)


def mla_keys_values(c_kv, k_pe, kv_norm_w, w_ukv):
    kv = to_heads(rms_norm(c_kv, kv_norm_w) @ w_ukv, MLA_HEADS)
    k_nope, v = kv[..., :MLA_NOPE], kv[..., MLA_NOPE:]
    b, h, l, _ = k_nope.shape
    k_pe_h = jnp.broadcast_to(k_pe[:, None], (b, h, l, MLA_ROPE)).astype(k_nope.dtype)
    return jnp.concatenate([k_nope, k_pe_h], -1), v


def block_attention(q, k, v):
    b, h, lq, dq = q.shape
    nb = lq // Q_BLOCK
    qb = jnp.moveaxis(q.reshape(b, h, nb, Q_BLOCK, dq), 2, 0)
    scale = dq ** -0.5

    def one_block(qblk):
        s = jnp.einsum('bhqd,bhkd->bhqk', qblk, k).astype(F32) * scale
        p = jax.nn.softmax(s, axis=-1)
        return jnp.einsum('bhqk,bhkd->bhqd', p.astype(v.dtype), v)

    o = lax.map(one_block, qb)
    return jnp.moveaxis(o, 0, 2).reshape(b, h, lq, v.shape[-1])


def hier_moe(x, w_group, b_group, w_route, b_route, w_gate, w_up, w_down):
    t = x.reshape(-1, x.shape[-1])
    g_logits = (t @ w_group).astype(F32) + b_group.astype(F32)
    g_onehot = jax.nn.one_hot(jnp.argmax(g_logits, -1), N_GROUPS, dtype=F32)
    g_prob = jnp.sum(jax.nn.softmax(g_logits, -1) * g_onehot, -1, keepdims=True)
    e_logits = jnp.einsum('td,gde->tge', t, w_route).astype(F32) + b_route.astype(F32)
    e_logits = jnp.einsum('tge,tg->te', e_logits, g_onehot)
    top_v, top_i = lax.top_k(e_logits, TOP_K)
    top_w = jax.nn.softmax(top_v, -1) * g_prob
    e_w = jnp.sum(jax.nn.one_hot(top_i, EXPERTS_PER_GROUP, dtype=F32) * top_w[..., None], 1)
    gate = g_onehot[:, :, None] * e_w[:, None, :]
    y = jnp.zeros(t.shape, F32)
    for gi in range(N_GROUPS):
        hid = jax.nn.silu(jnp.einsum('td,edf->tef', t, w_gate[gi]).astype(F32)) * jnp.einsum('td,edf->tef', t, w_up[gi]).astype(F32)
        y = y + jnp.einsum('tef,efd->td', hid * gate[:, gi, :, None], w_down[gi].astype(F32))
    return y.reshape(x.shape).astype(x.dtype)


def layer_forward(x, ctx, c, c_ctx, rows, cols, w_ada, b_ada, w_in, ret_decay, ret_gn_w,
                  mla_q_norm, mla_kv_norm, w_uq, w_ukv, w_o, ln1_w, ln1_b,
                  router_group_w, router_group_b, router_expert_w, router_expert_b,
                  expert_w_gate, expert_w_up, expert_w_down, ln2_w, ln2_b, update_ctx):
    def moe(t):
        return hier_moe(t, router_group_w, router_group_b, router_expert_w, router_expert_b,
                        expert_w_gate, expert_w_up, expert_w_down)

    mod_x = jnp.split(jax.nn.silu(c) @ w_ada + b_ada, 6, axis=-1)
    mod_c = jnp.split(jax.nn.silu(c_ctx)[None] @ w_ada + b_ada, 6, axis=-1)
    log_gamma = jax.nn.log_sigmoid(ret_decay.astype(F32))
    k_scale = RET_DK ** -0.5

    qr, kr, vr, gr, cq, ckv, kpe = split_projection(modulate(x, mod_x[0], mod_x[1]) @ w_in)
    qr_c, kr_c, vr_c, gr_c, cq_c, ckv_c, kpe_c = split_projection(modulate(ctx, mod_c[0], mod_c[1]) @ w_in)

    kh_c = to_heads(kr_c, RET_HEADS) * k_scale
    vh_c = to_heads(vr_c, RET_HEADS)
    s_fwd, s_bwd = context_retention_states(kh_c, vh_c, log_gamma)
    k_ctx, v_ctx = mla_keys_values(ckv_c, kpe_c, mla_kv_norm, w_ukv)

    qh = axial_rope(to_heads(qr, RET_HEADS), rows, cols)
    kh = axial_rope(to_heads(kr, RET_HEADS), rows, cols) * k_scale
    o_ret = bidirectional_retention(qh, kh, to_heads(vr, RET_HEADS), log_gamma, s_fwd, s_bwd)
    ret = retention_output(o_ret, gr, ret_gn_w)

    q = mla_queries(cq, mla_q_norm, w_uq)
    q = jnp.concatenate([q[..., :MLA_NOPE], axial_rope(q[..., MLA_NOPE:], rows, cols)], -1)
    k_lat, v_lat = mla_keys_values(ckv, axial_rope(kpe, rows, cols), mla_kv_norm, w_ukv)
    att = block_attention(q, jnp.concatenate([k_ctx, k_lat], 2), jnp.concatenate([v_ctx, v_lat], 2))

    mix = jnp.concatenate([ret, from_heads(att)], -1) @ w_o
    h = layer_norm(DEEPNORM_ALPHA * x + mod_x[2][:, None] * mix, ln1_w, ln1_b)
    y = moe(modulate(h, mod_x[3], mod_x[4]))
    x_out = layer_norm(DEEPNORM_ALPHA * h + mod_x[5][:, None] * y, ln2_w, ln2_b)

    if not update_ctx:
        return x_out, ctx

    z = jnp.zeros((ctx.shape[0], RET_HEADS, RET_DK, RET_DV), F32)
    o_ret_c = bidirectional_retention(to_heads(qr_c, RET_HEADS), kh_c, vh_c, log_gamma, z, z)
    ret_c = retention_output(o_ret_c, gr_c, ret_gn_w)
    att_c = block_attention(mla_queries(cq_c, mla_q_norm, w_uq), k_ctx, v_ctx)
    mix_c = jnp.concatenate([ret_c, from_heads(att_c)], -1) @ w_o
    hc = layer_norm(DEEPNORM_ALPHA * ctx + mod_c[2][:, None] * mix_c, ln1_w, ln1_b)
    yc = moe(modulate(hc, mod_c[3], mod_c[4]))
    ctx_out = layer_norm(DEEPNORM_ALPHA * hc + mod_c[5][:, None] * yc, ln2_w, ln2_b)
    return x_out, ctx_out


def setup_inputs(seed: int = 0) -> dict:
    key = jax.random.key(seed)
    ks = jax.random.split(key, 25)

    def nrm(k, shape, s):
        return jax.random.normal(k, shape, F32) * s

    L = DEPTH
    E = EXPERTS_PER_GROUP
    base_decay = jnp.log(2.0 ** (5.0 + jnp.arange(RET_HEADS, dtype=F32)) - 1.0)
    return {
        'x': nrm(ks[0], (BATCH, SEQ, D_MODEL), 1.0),
        'c': nrm(ks[1], (BATCH, D_MODEL), 1.0),
        'ctx': nrm(ks[2], (BATCH, CTX_LEN, D_MODEL), 1.0),
        'c_ctx': nrm(ks[3], (D_MODEL,), 1.0),
        'w_ada': nrm(ks[4], (L, D_MODEL, 6 * D_MODEL), 0.5 * D_MODEL ** -0.5),
        'b_ada': nrm(ks[5], (L, 6 * D_MODEL), 0.02),
        'w_in': nrm(ks[6], (L, D_MODEL, IN_W), D_MODEL ** -0.5),
        'ret_decay': base_decay + nrm(ks[7], (L, 2, RET_HEADS), 0.1),
        'ret_gn_w': 1.0 + nrm(ks[8], (L, RET_W), 0.02),
        'mla_q_norm': 1.0 + nrm(ks[9], (L, MLA_Q_LORA), 0.02),
        'mla_kv_norm': 1.0 + nrm(ks[10], (L, MLA_KV_LORA), 0.02),
        'w_uq': nrm(ks[11], (L, MLA_Q_LORA, MLA_HEADS * (MLA_NOPE + MLA_ROPE)), MLA_Q_LORA ** -0.5),
        'w_ukv': nrm(ks[12], (L, MLA_KV_LORA, MLA_HEADS * (MLA_NOPE + MLA_DV)), MLA_KV_LORA ** -0.5),
        'w_o': nrm(ks[13], (L, MIX_W, D_MODEL), DEEPNORM_BETA * MIX_W ** -0.5),
        'ln1_w': 1.0 + nrm(ks[14], (L, D_MODEL), 0.02),
        'ln1_b': nrm(ks[15], (L, D_MODEL), 0.02),
        'router_group_w': nrm(ks[16], (L, D_MODEL, N_GROUPS), D_MODEL ** -0.5),
        'router_group_b': nrm(ks[17], (L, N_GROUPS), 0.01),
        'router_expert_w': nrm(ks[18], (L, N_GROUPS, D_MODEL, E), D_MODEL ** -0.5),
        'router_expert_b': nrm(ks[19], (L, N_GROUPS, E), 0.01),
        'expert_w_gate': nrm(ks[20], (L, N_GROUPS, E, D_MODEL, D_EXPERT), D_MODEL ** -0.5),
        'expert_w_up': nrm(ks[21], (L, N_GROUPS, E, D_MODEL, D_EXPERT), D_MODEL ** -0.5),
        'expert_w_down': nrm(ks[22], (L, N_GROUPS, E, D_EXPERT, D_MODEL), DEEPNORM_BETA * D_EXPERT ** -0.5),
        'ln2_w': 1.0 + nrm(ks[23], (L, D_MODEL), 0.02),
        'ln2_b': nrm(ks[24], (L, D_MODEL), 0.02),
    }


def reference(x, c, ctx, c_ctx, w_ada, b_ada, w_in, ret_decay, ret_gn_w, mla_q_norm, mla_kv_norm,
              w_uq, w_ukv, w_o, ln1_w, ln1_b, router_group_w, router_group_b, router_expert_w,
              router_expert_b, expert_w_gate, expert_w_up, expert_w_down, ln2_w, ln2_b):
    n_rows = x.shape[1] // GRID_W
    rows = jnp.repeat(jnp.arange(n_rows, dtype=jnp.int32), GRID_W)
    cols = jnp.tile(jnp.arange(GRID_W, dtype=jnp.int32), n_rows)
    for l in range(DEPTH):
        x, ctx = layer_forward(
            x, ctx, c, c_ctx, rows, cols, w_ada[l], b_ada[l], w_in[l], ret_decay[l], ret_gn_w[l],
            mla_q_norm[l], mla_kv_norm[l], w_uq[l], w_ukv[l], w_o[l], ln1_w[l], ln1_b[l],
            router_group_w[l], router_group_b[l], router_expert_w[l], router_expert_b[l],
            expert_w_gate[l], expert_w_up[l], expert_w_down[l], ln2_w[l], ln2_b[l],
            l < DEPTH - 1)
    return x
```

```cpp
#include <hip/hip_runtime.h>
#include <cstdio>
#include <cstdint>

#ifndef REP_MASK
#define REP_MASK 0
#endif
#define REP(k) ((REP_MASK >> (k)) & 1)
#define LAS __attribute__((address_space(3)))
#define GAS __attribute__((address_space(1)))
typedef _Float16 h16;
typedef _Float16 h16x8 __attribute__((ext_vector_type(8)));
typedef _Float16 h16x4 __attribute__((ext_vector_type(4)));
typedef _Float16 h16x2 __attribute__((ext_vector_type(2)));
typedef float f32x4 __attribute__((ext_vector_type(4)));
typedef float f32x2 __attribute__((ext_vector_type(2)));
typedef float f32x16 __attribute__((ext_vector_type(16)));
typedef unsigned u32x4 __attribute__((ext_vector_type(4)));
typedef unsigned u32x2 __attribute__((ext_vector_type(2)));
typedef short s16x4v __attribute__((__vector_size__(8)));

constexpr int DM = 2048, NB = 4, SEQ = 2048, LC = 256, LK = LC + SEQ;
constexpr int T = NB * SEQ, TCX = NB * LC, TA = T + TCX;
constexpr int INW = 4928, NEXP = 32, DE = 512;
constexpr int ADAW = 6 * DM;
constexpr float EPS = 1e-6f, ALPHA = 1.189207115002721f;
constexpr float KSCALE = 0.08838834764831845f;
constexpr float L2_10000 = 13.287712379549449f;
constexpr int NTHREADS = 512;

constexpr size_t al256(size_t x) { return (x + 255) / 256 * 256; }
constexpr size_t WS_CTL = 0, CTL_BYTES = 65536;
constexpr size_t WS_PART = WS_CTL + CTL_BYTES;
constexpr size_t WS_MOD = WS_PART + al256((size_t)8 * 5 * ADAW * 4);
constexpr size_t WS_A1 = WS_MOD + al256((size_t)5 * ADAW * 4);
constexpr size_t WS_QR = WS_A1 + al256((size_t)TA * DM * 2);
constexpr size_t WS_KR = WS_QR + al256((size_t)T * 1024 * 2);
constexpr size_t WS_VR = WS_KR + al256((size_t)T * 1024 * 2);
constexpr size_t WS_KC = WS_VR + al256((size_t)T * 1024 * 2);
constexpr size_t WS_VC = WS_KC + al256((size_t)TCX * 1024 * 2);
constexpr size_t WS_GS = WS_VC + al256((size_t)TCX * 1024 * 2);
constexpr size_t WS_CQ = WS_GS + al256((size_t)T * 1024 * 2);
constexpr size_t WS_CKV = WS_CQ + al256((size_t)T * 512 * 2);
constexpr size_t WS_KPE = WS_CKV + al256((size_t)NB * LK * 256 * 2);
constexpr size_t WS_Q = WS_KPE + al256((size_t)NB * LK * 64 * 2);
constexpr size_t WS_KN = WS_Q + al256((size_t)T * 1536 * 2);
constexpr size_t WS_VV = WS_KN + al256((size_t)NB * 8 * LK * 128 * 2);
constexpr size_t WS_UF = WS_VV + al256((size_t)NB * 8 * LK * 128 * 2);
constexpr size_t WS_UB = WS_UF + al256((size_t)32 * 16 * 16384 * 4);
constexpr size_t WS_S0F = WS_UB + al256((size_t)32 * 16 * 16384 * 4);
constexpr size_t WS_S0B = WS_S0F + al256((size_t)32 * 16384 * 4);
constexpr size_t WS_SF = WS_S0B + al256((size_t)32 * 16384 * 4);
constexpr size_t WS_SB = WS_SF + al256((size_t)32 * 16 * 16384 * 2);
constexpr size_t WS_MIX = WS_SB + al256((size_t)32 * 16 * 16384 * 2);
constexpr size_t WS_U = WS_MIX + al256((size_t)T * DM * 2);
constexpr size_t WS_H = WS_U + al256((size_t)T * DM * 2);
constexpr size_t WS_A2 = WS_H + al256((size_t)T * DM * 2);
constexpr int SUBCAP = 2048;
constexpr size_t WS_LIST = WS_A2 + al256((size_t)T * DM * 2);
constexpr size_t WS_WL = WS_LIST + al256((size_t)NEXP * 8 * SUBCAP * 4);
constexpr int HID_ROWS = 2 * T + NEXP * 256;
constexpr size_t WS_HID = WS_WL + al256((size_t)NEXP * 8 * SUBCAP * 4);
constexpr size_t WS_Y = WS_HID + al256((size_t)HID_ROWS * DE * 2);
constexpr int WINP = 5120;
constexpr size_t WS_WIN16 = WS_Y + al256((size_t)2 * T * DM * 2);
constexpr size_t WS_WO16 = WS_WIN16 + al256((size_t)DM * WINP * 2);
constexpr size_t WS_WUQ16 = WS_WO16 + al256((size_t)DM * DM * 2);
constexpr size_t WS_WUKV16 = WS_WUQ16 + al256((size_t)512 * 1536 * 2);
constexpr size_t WS_WRH = WS_WUKV16 + al256((size_t)256 * 2048 * 2);
constexpr size_t WS_WRL = WS_WRH + al256((size_t)48 * DM * 2);
constexpr size_t WS_WD16 = WS_WRL + al256((size_t)48 * DM * 2);
constexpr size_t WS_END = WS_WD16 + al256((size_t)NEXP * DE * DM * 2);

constexpr int CW_CNT = 256;
constexpr int CW_POOL = 128;
constexpr int CW_BAR = 1024;

constexpr int LDS_BYTES = 151808;
constexpr int LDS_ROWS = 147456;
constexpr int LDS_MAP = 148480;
constexpr int LDS_MISC = 151552;

template <int M> __device__ __forceinline__ float swz_xor(float v) {
    return __int_as_float(__builtin_amdgcn_ds_swizzle(__float_as_int(v), 0x1F | (M << 10)));
}
__device__ __forceinline__ float wave_sum(float v) {
    v += swz_xor<1>(v); v += swz_xor<2>(v); v += swz_xor<4>(v); v += swz_xor<8>(v); v += swz_xor<16>(v);
    { auto rr = __builtin_amdgcn_permlane32_swap(__float_as_uint(v), __float_as_uint(v), false, false); v = __uint_as_float(rr[0]) + __uint_as_float(rr[1]); }
    return v;
}
__device__ __forceinline__ float silu_f(float x) { return x / (1.f + __expf(-x)); }
__device__ __forceinline__ h16x4 cvt4(f32x4 v) { h16x4 r; r[0] = (h16)v[0]; r[1] = (h16)v[1]; r[2] = (h16)v[2]; r[3] = (h16)v[3]; return r; }
__device__ __forceinline__ h16x4 trrd(LAS char* p) { s16x4v t = __builtin_amdgcn_ds_read_tr16_b64_v4i16((LAS s16x4v*)p); return __builtin_bit_cast(h16x4, t); }
__device__ __forceinline__ h16x8 cat8(h16x4 a, h16x4 b) { return __builtin_shufflevector(a, b, 0, 1, 2, 3, 4, 5, 6, 7); }
__device__ __forceinline__ f32x4 mfma16(h16x8 a, h16x8 b, f32x4 c) { return __builtin_amdgcn_mfma_f32_16x16x32_f16(a, b, c, 0, 0, 0); }

__device__ __forceinline__ int a_off(int row, int ch) { return row * 128 + ((ch ^ (row & 7)) << 4); }
__device__ __forceinline__ int off_b(int row, int ch) { return 256 * row + 16 * (ch ^ (((row & 3) << 2) | ((row >> 2) & 3))); }
__device__ __forceinline__ int tr_addr16(int lane, int c, int ks, int t) {
    const int g = lane >> 4, q = (lane & 15) >> 2, p = lane & 3;
    return off_b(32 * ks + 8 * g + 4 * t + q, 2 * c + (p >> 1)) + 8 * (p & 1);
}
__device__ __forceinline__ int row_addr16(int lane, int rb, int s) { return off_b((lane & 15) + 16 * rb, 4 * s + (lane >> 4)); }

#define XB_TMO      128
#define XB_XCNT(j)  (256  + 64 * (j))
#define XB_XSUB(j)  (1280 + 64 * (j))
#define XB_XGEN(j)  (2304 + 64 * (j))
#define XB_TOP      3328
#define XB_TOPGEN   3392
#define XCD_BAR_WORDS 3456
#define XB_SPIN_CAP (1u << 22)
__device__ __forceinline__ unsigned xb_ld(unsigned* p)              { return __hip_atomic_load(p, __ATOMIC_RELAXED, __HIP_MEMORY_SCOPE_AGENT); }
__device__ __forceinline__ unsigned xb_add(unsigned* p, unsigned v) { return __hip_atomic_fetch_add(p, v, __ATOMIC_RELAXED, __HIP_MEMORY_SCOPE_AGENT); }
__device__ __forceinline__ unsigned xb_xcc_id() { return (unsigned)__builtin_amdgcn_s_getreg((3 << 11) | 20) & 0xFu; }
#define XB_SPIN(cond, bar) do { unsigned _sp = 0; while (cond) { __builtin_amdgcn_s_sleep(1); \
    if ((++_sp & 255u) == 0u) { if (xb_ld(&(bar)[XB_TMO])) break; if (_sp > XB_SPIN_CAP) { atomicAdd(&(bar)[XB_TMO], 1u); break; } } } } while (0)
struct XcdBarrier { unsigned* bar; unsigned x; volatile LAS unsigned* st; };
__device__ __forceinline__ XcdBarrier xcd_barrier_post(unsigned* bar, volatile LAS unsigned* st) {
    XcdBarrier b; b.bar = bar; b.x = xb_xcc_id(); b.st = st;
    if (threadIdx.x == 0) (void)xb_add(&bar[XB_XCNT(b.x)], 1u);
    return b;
}
__device__ __forceinline__ void xcd_barrier_complete(unsigned* bar, unsigned x, unsigned& nloc, unsigned& nx) {
    const unsigned G = gridDim.x * gridDim.y * gridDim.z;
    unsigned sum, cnt, mine, sp = 0u;
    for (;;) {
        sum = 0u; cnt = 0u; mine = 0u;
#pragma unroll
        for (unsigned j = 0; j < 16; ++j) { const unsigned c = xb_ld(&bar[XB_XCNT(j)]); sum += c; cnt += (c > 0u) ? 1u : 0u; mine = (j == x) ? c : mine; }
        if (sum == G) break;
        __builtin_amdgcn_s_sleep(1);
        if ((++sp & 255u) == 0u) { if (xb_ld(&bar[XB_TMO])) break; if (sp > XB_SPIN_CAP) { atomicAdd(&bar[XB_TMO], 1u); break; } }
    }
    nloc = mine > 0u ? mine : 1u; nx = cnt > 0u ? cnt : 1u;
}
__device__ __forceinline__ void xcd_barrier(const XcdBarrier& b) {
    asm volatile("s_waitcnt vmcnt(0)" ::: "memory");
    __syncthreads();
    if (threadIdx.x == 0) {
        unsigned* bar = b.bar;
        __builtin_amdgcn_s_waitcnt(0);
        unsigned nloc = b.st[0], nx = b.st[1];
        if (nloc == 0u) { xcd_barrier_complete(bar, b.x, nloc, nx); b.st[0] = nloc; b.st[1] = nx; }
        const unsigned old = xb_add(&bar[XB_XSUB(b.x)], 1u);
        const unsigned gen = old / nloc;
        if (old + 1u == (gen + 1u) * nloc) {
            __builtin_amdgcn_fence(__ATOMIC_RELEASE, "agent");
            asm volatile("s_waitcnt vmcnt(0)" ::: "memory");
            const unsigned og = xb_add(&bar[XB_TOP], 1u);
            const unsigned tg = og / nx;
            if (og + 1u == (tg + 1u) * nx) xb_add(&bar[XB_TOPGEN], 1u);
            else XB_SPIN(xb_ld(&bar[XB_TOPGEN]) == tg, bar);
            __builtin_amdgcn_fence(__ATOMIC_ACQUIRE, "agent");
            xb_add(&bar[XB_XGEN(b.x)], 1u);
            asm volatile("s_waitcnt vmcnt(0)" ::: "memory");
        } else {
            XB_SPIN(xb_ld(&bar[XB_XGEN(b.x)]) == gen, bar);
            __builtin_amdgcn_fence(__ATOMIC_ACQUIRE, "agent");
            asm volatile("s_waitcnt vmcnt(0)" ::: "memory");
        }
    }
    __syncthreads();
}

struct Args {
    const float* in[25];
    float* out;
    unsigned char* ws;
    int ph_lo, ph_hi;
};
enum { I_X = 0, I_C, I_CTX, I_CCTX, I_WADA, I_BADA, I_WIN, I_RDEC, I_RGN, I_QNORM, I_KVNORM, I_WUQ, I_WUKV, I_WO, I_LN1W, I_LN1B,
       I_RGW, I_RGB, I_REW, I_REB, I_EWG, I_EWU, I_EWD, I_LN2W, I_LN2B };

__device__ __forceinline__ void wdown_pool(const Args& a, LAS char* lds, int budget);
constexpr int GEMM_STAGE = 49152, GEMM_ROWS_OFF = LDS_ROWS;
struct GemmThread {
    int tid, lane, wid, wm, wn, r16, g;
    int a_st;
    int b_st;
    int ta[2];
    int tb[4][2];
    __device__ __forceinline__ void init(bool opaque = false) {
        tid = threadIdx.x; if (opaque) asm volatile("" : "+v"(tid));
        lane = tid & 63; wid = __builtin_amdgcn_readfirstlane(tid >> 6); wm = wid >> 1; wn = wid & 1; r16 = lane & 15; g = lane >> 4;
        a_st = a_off(tid >> 3, tid & 7);
        const int nq = tid & 31, kk = tid >> 5;
        b_st = off_b(kk, nq >> 1) + (nq & 1) * 8;
#pragma unroll
        for (int ks = 0; ks < 2; ++ks) ta[ks] = a_off(wm * 64 + r16, ks * 4 + g);
#pragma unroll
        for (int ni = 0; ni < 4; ++ni)
#pragma unroll
            for (int t = 0; t < 2; ++t) tb[ni][t] = tr_addr16(lane, wn * 4 + ni, 0, t);
    }
};

__device__ __forceinline__ h16x8 fp8x8_to_h16(unsigned w0, unsigned w1) {
    const f32x2 a = __builtin_amdgcn_cvt_pk_f32_fp8((int)w0, false), b = __builtin_amdgcn_cvt_pk_f32_fp8((int)w0, true);
    const f32x2 c = __builtin_amdgcn_cvt_pk_f32_fp8((int)w1, false), d = __builtin_amdgcn_cvt_pk_f32_fp8((int)w1, true);
    h16x8 r; r[0] = (h16)a[0]; r[1] = (h16)a[1]; r[2] = (h16)b[0]; r[3] = (h16)b[1]; r[4] = (h16)c[0]; r[5] = (h16)c[1]; r[6] = (h16)d[0]; r[7] = (h16)d[1];
    return r;
}
__device__ __forceinline__ void gemm_tile(LAS char* lds, const GemmThread& G, const unsigned char* const (&arow)[2], const float* bcol, size_t ldb,
                                          int nk, f32x4 (&acc)[4][4]) {
#pragma unroll
    for (int i = 0; i < 4; ++i)
#pragma unroll
        for (int j = 0; j < 4; ++j) acc[i][j] = (f32x4){0.f, 0.f, 0.f, 0.f};
    u32x4 ar0[2], ar1[2]; f32x4 br0[4], br1[4];
    const int aq0 = a_off(G.tid >> 2, 2 * (G.tid & 3)), aq1 = a_off(G.tid >> 2, 2 * (G.tid & 3) + 1);
#define GT_LOAD(AR, BR, kt) do { _Pragma("unroll") for (int i = 0; i < 2; ++i) AR[i] = *(const u32x4*)(arow[i] + (size_t)(kt) * 64); \
        _Pragma("unroll") for (int i = 0; i < 4; ++i) BR[i] = *(const f32x4*)(bcol + (size_t)((kt) * 64 + 16 * i) * ldb); } while (0)
#define GT_STORE(AR, BR, buf) do { LAS char* Ab_ = lds + (buf) * GEMM_STAGE; _Pragma("unroll") for (int i = 0; i < 2; ++i) { \
        *(LAS h16x8*)(Ab_ + aq0 + i * 16384) = fp8x8_to_h16(AR[i][0], AR[i][1]); *(LAS h16x8*)(Ab_ + aq1 + i * 16384) = fp8x8_to_h16(AR[i][2], AR[i][3]); } \
        _Pragma("unroll") for (int i = 0; i < 4; ++i) *(LAS h16x4*)(Ab_ + 32768 + G.b_st + i * 4096) = cvt4(BR[i]); } while (0)
#define GT_COMP(buf) do { LAS char* Ab = lds + (buf) * GEMM_STAGE; LAS char* Bb = Ab + 32768; \
        _Pragma("unroll") for (int ks = 0; ks < 2; ++ks) { h16x8 bf[4], af[4]; \
            _Pragma("unroll") for (int ni = 0; ni < 4; ++ni) bf[ni] = cat8(trrd(Bb + G.tb[ni][0] + ks * 8192), trrd(Bb + G.tb[ni][1] + ks * 8192)); \
            _Pragma("unroll") for (int mi = 0; mi < 4; ++mi) af[mi] = *(LAS h16x8*)(Ab + G.ta[ks] + mi * 2048); \
            _Pragma("unroll") for (int mi = 0; mi < 4; ++mi) _Pragma("unroll") for (int ni = 0; ni < 4; ++ni) acc[mi][ni] = mfma16(bf[ni], af[mi], acc[mi][ni]); } } while (0)
    __syncthreads();
    GT_LOAD(ar0, br0, 0);
    GT_LOAD(ar1, br1, 1);
    GT_STORE(ar0, br0, 0);
    __syncthreads();
    int kt = 0;
    for (; kt + 2 < nk; kt += 2) {
        GT_LOAD(ar0, br0, kt + 2); __builtin_amdgcn_sched_barrier(0);
        GT_COMP(0); __builtin_amdgcn_sched_barrier(0);
        GT_STORE(ar1, br1, 1);
        __syncthreads();
        GT_LOAD(ar1, br1, kt + 3); __builtin_amdgcn_sched_barrier(0);
        GT_COMP(1); __builtin_amdgcn_sched_barrier(0);
        GT_STORE(ar0, br0, 0);
        __syncthreads();
    }
    GT_COMP(0);
    GT_STORE(ar1, br1, 1);
    __syncthreads();
    GT_COMP(1);
#undef GT_LOAD
#undef GT_STORE
#undef GT_COMP
}

typedef short s16x4 __attribute__((ext_vector_type(4)));
template <int OFF> __device__ __forceinline__ s16x4 asm_tr(int addr) { s16x4 r; asm volatile("ds_read_b64_tr_b16 %0, %1 offset:%2" : "=v"(r) : "v"(addr), "i"(OFF) : "memory"); return r; }
template <int OFF> __device__ __forceinline__ h16x8 asm_rd128(int addr) { h16x8 r; asm volatile("ds_read_b128 %0, %1 offset:%2" : "=v"(r) : "v"(addr), "i"(OFF) : "memory"); return r; }
#define LGKM0() do { asm volatile("s_waitcnt lgkmcnt(0)" ::: "memory"); __builtin_amdgcn_sched_barrier(0); } while (0)
__device__ __forceinline__ h16x8 cat8s(s16x4 a, s16x4 b) { return __builtin_bit_cast(h16x8, __builtin_shufflevector(a, b, 0, 1, 2, 3, 4, 5, 6, 7)); }
struct G3Stream { int gs; bool primed; };
template <bool RMS>
__device__ __forceinline__ void gemm_tile_g(LAS char* lds, const GemmThread& G, const h16* Ab, int lda, const h16* Bb, int ldb, int nk, f32x4 (&acc)[4][4],
                                            G3Stream& S, const h16* nAb, const h16* nBb) {
#pragma unroll
    for (int i = 0; i < 4; ++i)
#pragma unroll
        for (int j = 0; j < 4; ++j) acc[i][j] = (f32x4){0.f, 0.f, 0.f, 0.f};
    float ss[4] = {0.f, 0.f, 0.f, 0.f};
    const size_t a_i = (size_t)64 * lda, b_i = (size_t)32 * ldb, b_k = (size_t)64 * ldb;
    const size_t lane_a = (size_t)(8 * G.wid + (G.lane >> 3)) * lda + (((G.lane & 7) ^ (G.lane >> 3)) << 3);
    const size_t lane_b = (size_t)(4 * G.wid + (G.lane >> 4)) * ldb + (((G.lane & 15) ^ (((G.lane >> 4) << 2) | (G.wid & 3))) << 3);
    const bool has_next = (nAb != nullptr);
    const h16* asrc = Ab + lane_a; const h16* bsrc = Bb + lane_b;
    const h16* nasrc = (has_next ? nAb : Ab) + lane_a; const h16* nbsrc = (has_next ? nBb : Bb) + lane_b;
    LAS char* wbase = lds + G.wid * 1024;
    const int lbase = (int)(uintptr_t)lds;
#define G3_ISSUE_(AS, BS, kt, st) do { LAS char* sb_ = wbase + (st) * GEMM_STAGE; \
        _Pragma("unroll") for (int i = 0; i < 4; ++i) __builtin_amdgcn_global_load_lds((const unsigned*)((AS) + i * a_i + (size_t)(kt) * 64), (LAS unsigned*)(sb_ + i * 8192), 16, 0, 0); \
        _Pragma("unroll") for (int i = 0; i < 2; ++i) __builtin_amdgcn_global_load_lds((const unsigned*)((BS) + i * b_i + (size_t)(kt) * b_k), (LAS unsigned*)(sb_ + 32768 + i * 8192), 16, 0, 0); } while (0)
#define G3_ISSUE(kt, st) G3_ISSUE_(asrc, bsrc, kt, st)
#define G3_READ(BF, AF, KS) do { \
        BF[0] = cat8s(asm_tr<32768 + (KS) * 8192>(sbase + G.tb[0][0]), asm_tr<32768 + (KS) * 8192>(sbase + G.tb[0][1])); \
        BF[1] = cat8s(asm_tr<32768 + (KS) * 8192>(sbase + G.tb[1][0]), asm_tr<32768 + (KS) * 8192>(sbase + G.tb[1][1])); \
        BF[2] = cat8s(asm_tr<32768 + (KS) * 8192>(sbase + G.tb[2][0]), asm_tr<32768 + (KS) * 8192>(sbase + G.tb[2][1])); \
        BF[3] = cat8s(asm_tr<32768 + (KS) * 8192>(sbase + G.tb[3][0]), asm_tr<32768 + (KS) * 8192>(sbase + G.tb[3][1])); \
        AF[0] = asm_rd128<0>(sbase + G.ta[KS]); AF[1] = asm_rd128<2048>(sbase + G.ta[KS]); AF[2] = asm_rd128<4096>(sbase + G.ta[KS]); AF[3] = asm_rd128<6144>(sbase + G.ta[KS]); } while (0)
#define G3_MMA(BF, AF) do { _Pragma("unroll") for (int mi = 0; mi < 4; ++mi) _Pragma("unroll") for (int ni = 0; ni < 4; ++ni) acc[mi][ni] = mfma16(BF[ni], AF[mi], acc[mi][ni]); } while (0)
    int sc = S.gs, si = (S.gs == 0) ? 2 : S.gs - 1;
    if (!S.primed) {
        asm volatile("s_waitcnt vmcnt(0)" ::: "memory");
        __builtin_amdgcn_s_barrier();
        asm volatile("" ::: "memory");
        G3_ISSUE(0, sc);
        G3_ISSUE(1, (sc == 2) ? 0 : sc + 1);
    }
    for (int kt = 0; kt < nk; ++kt) {
        if ((kt == 0 && S.primed) || !(kt + 1 < nk || has_next)) asm volatile("s_waitcnt vmcnt(0)" ::: "memory"); else asm volatile("s_waitcnt vmcnt(6)" ::: "memory");
        __builtin_amdgcn_s_barrier();
        asm volatile("" ::: "memory");
        if (kt + 2 < nk) G3_ISSUE(kt + 2, si);
        else if (has_next) G3_ISSUE_(nasrc, nbsrc, kt + 2 - nk, si);
        const int sbase = lbase + sc * GEMM_STAGE;
        h16x8 bf0[4], af0[4], bf1[4], af1[4];
        G3_READ(bf0, af0, 0);
        if (RMS) {
            h16x8 hv[4];
            hv[0] = asm_rd128<0>(sbase + G.a_st); hv[1] = asm_rd128<8192>(sbase + G.a_st); hv[2] = asm_rd128<16384>(sbase + G.a_st); hv[3] = asm_rd128<24576>(sbase + G.a_st);
            LGKM0();
#pragma unroll
            for (int i = 0; i < 4; ++i)
#pragma unroll
                for (int e = 0; e < 8; ++e) { const float f = (float)hv[i][e]; ss[i] += f * f; }
        } else LGKM0();
        G3_READ(bf1, af1, 1);
        G3_MMA(bf0, af0);
        LGKM0();
        G3_MMA(bf1, af1);
        sc = (sc == 2) ? 0 : sc + 1; si = (si == 2) ? 0 : si + 1;
    }
#undef G3_ISSUE
#undef G3_ISSUE_
#undef G3_READ
#undef G3_MMA
    S.gs = sc; S.primed = has_next;
    if (RMS) {
        LAS float* rs = (LAS float*)(lds + GEMM_ROWS_OFF);
#pragma unroll
        for (int i = 0; i < 4; ++i) {
            float s = ss[i]; s += __shfl_xor(s, 1); s += __shfl_xor(s, 2); s += __shfl_xor(s, 4);
            if ((G.tid & 7) == 0) rs[(G.tid >> 3) + 64 * i] = __builtin_amdgcn_rsqf(s / (float)(nk * 64) + EPS);
        }
        asm volatile("s_waitcnt lgkmcnt(0)" ::: "memory");
        __builtin_amdgcn_s_barrier();
        asm volatile("" ::: "memory");
    }
}

constexpr int G2_STAGE = 65536;
struct GemmThread2 {
    int tid, lane, wid, wm, wn, r16, g;
    int ta[2];
    int tb[4][2];
    __device__ __forceinline__ void init() {
        tid = threadIdx.x; lane = tid & 63; wid = __builtin_amdgcn_readfirstlane(tid >> 6); wm = wid >> 2; wn = wid & 3; r16 = lane & 15; g = lane >> 4;
#pragma unroll
        for (int ks = 0; ks < 2; ++ks) ta[ks] = a_off(wm * 128 + r16, ks * 4 + g);
#pragma unroll
        for (int ni = 0; ni < 4; ++ni)
#pragma unroll
            for (int t = 0; t < 2; ++t) tb[ni][t] = 32768 + (wn >> 1) * 16384 + tr_addr16(lane, (wn & 1) * 4 + ni, 0, t);
    }
};
__device__ __forceinline__ void gemm_tile_g2(LAS char* lds, const GemmThread2& G, const h16* Ab, int lda, const h16* Bb, int ldb, int nk, f32x4 (&acc)[8][4]) {
#pragma unroll
    for (int i = 0; i < 8; ++i)
#pragma unroll
        for (int j = 0; j < 4; ++j) acc[i][j] = (f32x4){0.f, 0.f, 0.f, 0.f};
    const h16* asrc = Ab + (size_t)(8 * G.wid + (G.lane >> 3)) * lda + (((G.lane & 7) ^ (G.lane >> 3)) << 3);
    const h16* bsrc = Bb + (size_t)(4 * G.wid + (G.lane >> 4)) * ldb + (((G.lane & 15) ^ (((G.lane >> 4) << 2) | (G.wid & 3))) << 3);
    const size_t a_i = (size_t)64 * lda, b_i = (size_t)32 * ldb, b_k = (size_t)64 * ldb;
    LAS char* wbase = lds + G.wid * 1024;
    const int lbase = (int)(uintptr_t)lds;
#define G2_ISSUE(kt, st) do { LAS char* sb_ = wbase + (st) * G2_STAGE; \
        _Pragma("unroll") for (int i = 0; i < 4; ++i) __builtin_amdgcn_global_load_lds((const unsigned*)(asrc + i * a_i + (size_t)(kt) * 64), (LAS unsigned*)(sb_ + i * 8192), 16, 0, 0); \
        _Pragma("unroll") for (int i = 0; i < 4; ++i) __builtin_amdgcn_global_load_lds((const unsigned*)(bsrc + (i & 1) * b_i + (i >> 1) * 128 + (size_t)(kt) * b_k), (LAS unsigned*)(sb_ + 32768 + (i >> 1) * 16384 + (i & 1) * 8192), 16, 0, 0); } while (0)
#define G2_RB(BF, KS) do { \
        BF[0] = cat8s(asm_tr<(KS) * 8192>(sbase + G.tb[0][0]), asm_tr<(KS) * 8192>(sbase + G.tb[0][1])); \
        BF[1] = cat8s(asm_tr<(KS) * 8192>(sbase + G.tb[1][0]), asm_tr<(KS) * 8192>(sbase + G.tb[1][1])); \
        BF[2] = cat8s(asm_tr<(KS) * 8192>(sbase + G.tb[2][0]), asm_tr<(KS) * 8192>(sbase + G.tb[2][1])); \
        BF[3] = cat8s(asm_tr<(KS) * 8192>(sbase + G.tb[3][0]), asm_tr<(KS) * 8192>(sbase + G.tb[3][1])); } while (0)
#define G2_RA(AF, KS, H) do { AF[0] = asm_rd128<(H) * 8192>(sbase + G.ta[KS]); AF[1] = asm_rd128<(H) * 8192 + 2048>(sbase + G.ta[KS]); \
        AF[2] = asm_rd128<(H) * 8192 + 4096>(sbase + G.ta[KS]); AF[3] = asm_rd128<(H) * 8192 + 6144>(sbase + G.ta[KS]); } while (0)
#define G2_MMA(BF, AF, H) do { _Pragma("unroll") for (int mi = 0; mi < 4; ++mi) _Pragma("unroll") for (int ni = 0; ni < 4; ++ni) \
        acc[(H) * 4 + mi][ni] = mfma16(BF[ni], AF[mi], acc[(H) * 4 + mi][ni]); } while (0)
    asm volatile("s_waitcnt vmcnt(0)" ::: "memory");
    __builtin_amdgcn_s_barrier();
    asm volatile("" ::: "memory");
    G2_ISSUE(0, 0);
    for (int kt = 0; kt < nk; ++kt) {
        asm volatile("s_waitcnt vmcnt(0)" ::: "memory");
        __builtin_amdgcn_s_barrier();
        asm volatile("" ::: "memory");
        if (kt + 1 < nk) G2_ISSUE(kt + 1, (kt + 1) & 1);
        const int sbase = lbase + (kt & 1) * G2_STAGE;
        h16x8 bf0[4], bf1[4], afx[4], afy[4];
        G2_RB(bf0, 0); G2_RA(afx, 0, 0);
        LGKM0();
        G2_RA(afy, 0, 1); G2_RB(bf1, 1);
        G2_MMA(bf0, afx, 0);
        LGKM0();
        G2_RA(afx, 1, 0);
        G2_MMA(bf0, afy, 1);
        LGKM0();
        G2_RA(afy, 1, 1);
        G2_MMA(bf1, afx, 0);
        LGKM0();
        G2_MMA(bf1, afy, 1);
    }
#undef G2_ISSUE
#undef G2_RB
#undef G2_RA
#undef G2_MMA
}

__device__ __forceinline__ void cvt_weight(const float* W, const float* rowscale, h16* O, int K, int N, int NP, int gtid, int gthreads) {
    const int cpr = NP >> 3;
    for (int idx = gtid; idx < K * cpr; idx += gthreads) {
        const int k = idx / cpr, c = (idx - k * cpr) << 3;
        h16x8 o;
        if (c < N) {
            f32x4 v0 = *(const f32x4*)(W + (size_t)k * N + c), v1 = *(const f32x4*)(W + (size_t)k * N + c + 4);
            if (rowscale) { const float r = rowscale[k]; v0 = v0 * r; v1 = v1 * r; }
#pragma unroll
            for (int e = 0; e < 4; ++e) { o[e] = (h16)v0[e]; o[4 + e] = (h16)v1[e]; }
        } else {
#pragma unroll
            for (int e = 0; e < 8; ++e) o[e] = (h16)0.f;
        }
        *(h16x8*)(O + (size_t)k * NP + c) = o;
    }
}
__device__ __forceinline__ void phase_cvt(const Args& a) {
    const int gtid = blockIdx.x * NTHREADS + threadIdx.x, gth = gridDim.x * NTHREADS;
    cvt_weight(a.in[I_WIN], nullptr, (h16*)(a.ws + WS_WIN16), DM, INW, WINP, gtid, gth);
    cvt_weight(a.in[I_WO], nullptr, (h16*)(a.ws + WS_WO16), DM, DM, DM, gtid, gth);
    cvt_weight(a.in[I_WUQ], a.in[I_QNORM], (h16*)(a.ws + WS_WUQ16), 512, 1536, 1536, gtid, gth);
    cvt_weight(a.in[I_WUKV], a.in[I_KVNORM], (h16*)(a.ws + WS_WUKV16), 256, 2048, 2048, gtid, gth);
    h16* WRH = (h16*)(a.ws + WS_WRH); h16* WRL = (h16*)(a.ws + WS_WRL);
    for (int idx = gtid; idx < 48 * DM; idx += gth) {
        const int n = idx / DM, k = idx - n * DM;
        float w = 0.f;
        if (n < 4) w = a.in[I_RGW][k * 4 + n];
        else if (n < 36) w = a.in[I_REW][(size_t)((n - 4) >> 3) * DM * 8 + (size_t)k * 8 + ((n - 4) & 7)];
        w *= 1024.f;
        const h16 hi = (h16)w; const h16 lo = (h16)(w - (float)hi);
        WRH[idx] = hi; WRL[idx] = lo;
    }
}

__device__ __forceinline__ void phase_adaln(const Args& a, LAS char* lds) {
    const int tid = threadIdx.x;
    LAS float* sact = (LAS float*)lds;
    LAS f32x4* red = (LAS f32x4*)(lds + 40960);
    const float* c = a.in[I_C]; const float* cc = a.in[I_CCTX]; const float* W = a.in[I_WADA];
    float* PART = (float*)(a.ws + WS_PART);
    for (int i = tid; i < 5 * DM; i += NTHREADS) { const float v = (i < 4 * DM) ? c[i] : cc[i - 4 * DM]; sact[i] = silu_f(v); }
    __syncthreads();
    const int col4 = tid & 31, ksub = tid >> 5;
    for (int u = blockIdx.x; u < 768; u += gridDim.x) {
        const int nc = u % 96, kc = u / 96;
        const int k0 = kc * 256 + ksub * 16;
        const float* wp = W + (size_t)k0 * ADAW + nc * 128 + col4 * 4;
        f32x4 acc[5];
#pragma unroll
        for (int r = 0; r < 5; ++r) acc[r] = (f32x4){0.f, 0.f, 0.f, 0.f};
#pragma unroll 8
        for (int kk = 0; kk < 16; ++kk) {
            const f32x4 w = *(const f32x4*)(wp + (size_t)kk * ADAW);
#pragma unroll
            for (int r = 0; r < 5; ++r) acc[r] += w * sact[r * DM + k0 + kk];
        }
#pragma unroll
        for (int r = 0; r < 5; ++r) red[(ksub * 5 + r) * 32 + col4] = acc[r];
        __syncthreads();
        if (tid < 160) {
            const int r = tid >> 5, c4 = tid & 31;
            f32x4 s = (f32x4){0.f, 0.f, 0.f, 0.f};
#pragma unroll
            for (int j = 0; j < 16; ++j) s += red[(j * 5 + r) * 32 + c4];
            *(f32x4*)(PART + ((size_t)kc * 5 + r) * ADAW + nc * 128 + c4 * 4) = s;
        }
        __syncthreads();
    }
}

__device__ __forceinline__ float mod_sum(const float* PART, const float* bada, int r, int n) {
    float s = bada[n];
#pragma unroll
    for (int kc = 0; kc < 8; ++kc) s += PART[((size_t)kc * 5 + r) * ADAW + n];
    return s;
}
__device__ __forceinline__ void phase_modulate(const Args& a, LAS char* lds) {
    const int tid = threadIdx.x, lane = tid & 63, wid = tid >> 6;
    const float* PART = (const float*)(a.ws + WS_PART); const float* bada = a.in[I_BADA];
    float* MOD = (float*)(a.ws + WS_MOD);
    for (int idx = blockIdx.x * NTHREADS + tid; idx < 5 * ADAW; idx += gridDim.x * NTHREADS) MOD[idx] = mod_sum(PART, bada, idx / ADAW, idx % ADAW);
    const int per = (TA + gridDim.x - 1) / gridDim.x;
    const int r0 = blockIdx.x * per, r1 = (r0 + per < TA) ? r0 + per : TA;
    if (r0 >= r1) return;
    const int mrA = (r0 < T) ? r0 / SEQ : 4, mrB = (r1 - 1 < T) ? (r1 - 1) / SEQ : 4;
    LAS float* smod = (LAS float*)lds;
    for (int i = tid; i < 2 * 2 * DM; i += NTHREADS) {
        const int slot = i / (2 * DM), n = i % (2 * DM);
        smod[i] = mod_sum(PART, bada, slot ? mrB : mrA, n);
    }
    __syncthreads();
    h16* A1 = (h16*)(a.ws + WS_A1);
    for (int row = r0 + wid; row < r1; row += 8) {
        const float* xr = (row < T) ? a.in[I_X] + (size_t)row * DM : a.in[I_CTX] + (size_t)(row - T) * DM;
        const int mr = (row < T) ? row / SEQ : 4;
        LAS float* sm = smod + ((mr == mrA) ? 0 : 2 * DM);
        f32x4 v[8]; float s = 0.f;
#pragma unroll
        for (int j = 0; j < 8; ++j) { v[j] = *(const f32x4*)(xr + j * 256 + lane * 4); s += (v[j][0] + v[j][1]) + (v[j][2] + v[j][3]); }
        const float mean = wave_sum(s) * (1.f / DM); float q = 0.f;
#pragma unroll
        for (int j = 0; j < 8; ++j) { v[j] = v[j] - mean; q += (v[j][0] * v[j][0] + v[j][1] * v[j][1]) + (v[j][2] * v[j][2] + v[j][3] * v[j][3]); }
        const float rstd = 1.f / sqrtf(wave_sum(q) * (1.f / DM) + EPS);
#pragma unroll
        for (int j = 0; j < 8; ++j) {
            const int k = j * 256 + lane * 4;
            const f32x4 sh = *(LAS f32x4*)(sm + k), sc = *(LAS f32x4*)(sm + DM + k);
            const f32x4 y = v[j] * rstd * (sc + 1.f) + sh;
            *(h16x4*)(A1 + (size_t)row * DM + k) = cvt4(y);
        }
    }
}

__device__ __forceinline__ void st4(h16* p, f32x4 v) { *(h16x4*)p = cvt4(v); }
__device__ __forceinline__ void rope4(f32x4 x1, f32x4 x2, float pos, int i0, float step, float sc, f32x4& o1, f32x4& o2) {
#pragma unroll
    for (int r = 0; r < 4; ++r) {
        const float invf = exp2f(-(float)(i0 + r) * step);
        const float ang = pos * invf;
        const float s = __sinf(ang), c = __cosf(ang);
        o1[r] = (x1[r] * c - x2[r] * s) * sc; o2[r] = (x1[r] * s + x2[r] * c) * sc;
    }
}
template <int NM>
__device__ __forceinline__ void inproj_epi(const Args& a, const f32x4 (&acc)[NM][4], bool lat, int b, int m0, int l0, int nt, int wn, int g) {
    h16* QR = (h16*)(a.ws + WS_QR); h16* KR = (h16*)(a.ws + WS_KR); h16* VR = (h16*)(a.ws + WS_VR);
    h16* KC = (h16*)(a.ws + WS_KC); h16* VC = (h16*)(a.ws + WS_VC); h16* GS = (h16*)(a.ws + WS_GS);
    h16* CQ = (h16*)(a.ws + WS_CQ); h16* CKV = (h16*)(a.ws + WS_CKV); h16* KPE = (h16*)(a.ws + WS_KPE);
    const int cw = wn * 64 + 4 * g;
    if (nt < 16) {
        const int h = nt & 7; const bool isq = nt < 8;
        h16* dst = isq ? QR : (lat ? KR : KC);
        const float sc = isq ? 1.f : KSCALE;
#pragma unroll
        for (int mi = 0; mi < NM; ++mi) {
            const int l = l0 + mi * 16;
            const size_t ro = lat ? ((size_t)(b * 8 + h) * SEQ + l) * 128 : ((size_t)(b * 8 + h) * LC + l) * 128;
            const float pos = (wn == 0) ? (float)(l >> 6) : (float)(l & 63);
#pragma unroll
            for (int ni = 0; ni < 2; ++ni) {
                f32x4 o1, o2;
                if (lat) rope4(acc[mi][ni], acc[mi][ni + 2], pos, ni * 16 + 4 * g, L2_10000 / 32.f, sc, o1, o2);
                else { o1 = acc[mi][ni] * sc; o2 = acc[mi][ni + 2] * sc; }
                st4(dst + ro + cw + ni * 16, o1); st4(dst + ro + cw + ni * 16 + 32, o2);
            }
        }
    } else if (nt < 24) {
        const int h = nt - 16; h16* dst = lat ? VR : VC;
#pragma unroll
        for (int mi = 0; mi < NM; ++mi) {
            const int l = l0 + mi * 16;
            const size_t ro = lat ? ((size_t)(b * 8 + h) * SEQ + l) * 128 : ((size_t)(b * 8 + h) * LC + l) * 128;
#pragma unroll
            for (int ni = 0; ni < 4; ++ni) st4(dst + ro + cw + ni * 16, acc[mi][ni]);
        }
    } else if (nt < 32) {
#pragma unroll
        for (int mi = 0; mi < NM; ++mi)
#pragma unroll
            for (int ni = 0; ni < 4; ++ni) { f32x4 v = acc[mi][ni];
#pragma unroll
                for (int r = 0; r < 4; ++r) v[r] = silu_f(v[r]);
                st4(GS + (size_t)(m0 + mi * 16) * 1024 + (nt - 24) * 128 + cw + ni * 16, v); }
    } else if (nt < 36) {
#pragma unroll
        for (int mi = 0; mi < NM; ++mi)
#pragma unroll
            for (int ni = 0; ni < 4; ++ni) st4(CQ + (size_t)(m0 + mi * 16) * 512 + (nt - 32) * 128 + cw + ni * 16, acc[mi][ni]);
    } else if (nt < 38) {
#pragma unroll
        for (int mi = 0; mi < NM; ++mi) {
            const int key = (lat ? LC : 0) + l0 + mi * 16;
#pragma unroll
            for (int ni = 0; ni < 4; ++ni) st4(CKV + ((size_t)b * LK + key) * 256 + (nt - 36) * 128 + cw + ni * 16, acc[mi][ni]);
        }
    } else if (nt == 38 && wn == 0) {
#pragma unroll
        for (int mi = 0; mi < NM; ++mi) {
            const int l = l0 + mi * 16, key = (lat ? LC : 0) + l;
            h16* dst = KPE + ((size_t)b * LK + key) * 64 + 4 * g;
#pragma unroll
            for (int hf = 0; hf < 2; ++hf) {
                f32x4 o1, o2; const float pos = hf ? (float)(l & 63) : (float)(l >> 6);
                if (lat) rope4(acc[mi][2 * hf], acc[mi][2 * hf + 1], pos, 4 * g, L2_10000 / 16.f, 1.f, o1, o2);
                else { o1 = acc[mi][2 * hf]; o2 = acc[mi][2 * hf + 1]; }
                st4(dst + hf * 32, o1); st4(dst + hf * 32 + 16, o2);
            }
        }
    }
}
__device__ __forceinline__ void inproj_unit(int list, int p, int& mt, int& nt) {
    if (list == 0) {
        if (p < 352) { const int mg = p / 44, rem = p - mg * 44, ti = rem >> 2; mt = mg * 4 + (rem & 3); nt = (ti < 8) ? 4 + ti : 8 + ti; }
        else if (p < 388) { const int q = p - 352, ti = q >> 2; mt = 32 + (q & 3); nt = (ti < 8) ? 4 + ti : 18; }
        else { const int q = p - 388; mt = q >> 2; nt = q & 3; }
    } else {
        if (p < 4) { mt = 31; nt = p; }
        else if (p < 132) { const int q = p - 4; mt = q >> 2; nt = 12 + (q & 3); }
        else if (p < 164) { mt = p - 132; nt = 19; }
        else { mt = 32 + (p - 164); nt = 19; }
    }
}
constexpr int INPROJ_NU0 = 512, INPROJ_NU1 = 168;
__device__ __forceinline__ void phase_inproj(const Args& a, LAS char* lds, int vcu, int list) {
    GemmThread2 G; G.init();
    const h16* A1 = (const h16*)(a.ws + WS_A1); const h16* W16 = (const h16*)(a.ws + WS_WIN16);
    const int NU = list ? INPROJ_NU1 : INPROJ_NU0;
    for (int p = vcu; p < NU; p += gridDim.x) {
        int mt, nt;
        inproj_unit(list, p, mt, nt);
        f32x4 acc[8][4];
        gemm_tile_g2(lds, G, A1 + (size_t)mt * 256 * DM, DM, W16 + nt * 256, WINP, DM / 64, acc);
        const bool lat = mt < 32;
        const int b = lat ? (mt >> 3) : (mt - 32);
        int r16l = G.r16, gl = G.g;
        asm volatile("" : "+v"(r16l), "+v"(gl));
        const int m0 = mt * 256 + G.wm * 128 + r16l;
        const int l0 = lat ? (m0 & (SEQ - 1)) : (m0 - T - b * LC);
        const int cb = nt * 4 + G.wn;
        inproj_epi<8>(a, acc, lat, b, m0, l0, cb >> 1, cb & 1, gl);
    }
    if (list == 0) {
        const int rounds = (NU + (int)gridDim.x - 1) / (int)gridDim.x, mine = (vcu < NU) ? (NU - vcu + (int)gridDim.x - 1) / (int)gridDim.x : 0;
        if (mine < rounds) wdown_pool(a, lds, 8 * (rounds - mine));
    }
}

__device__ __forceinline__ void qup_unit(const Args& a, LAS char* lds, G3Stream& S, int p, int pn) {
    GemmThread G; G.init(true);
    const h16* CQ = (const h16*)(a.ws + WS_CQ); h16* Q = (h16*)(a.ws + WS_Q);
    LAS float* rs = (LAS float*)(lds + GEMM_ROWS_OFF);
    const int mt = p / 12, nt = p % 12;
    const bool hn = pn >= 0;
    f32x4 acc[4][4];
    gemm_tile_g<true>(lds, G, CQ + (size_t)mt * 256 * 512, 512, (const h16*)(a.ws + WS_WUQ16) + nt * 128, 1536, 512 / 64, acc, S,
                      hn ? CQ + (size_t)(pn / 12) * 256 * 512 : nullptr, hn ? (const h16*)(a.ws + WS_WUQ16) + (pn % 12) * 128 : nullptr);
    const int c0 = nt * 128 + G.wn * 64, head = c0 / 192, d0 = c0 % 192;
#pragma unroll
    for (int mi = 0; mi < 4; ++mi) {
        const int ml = G.wm * 64 + mi * 16 + G.r16, m = mt * 256 + ml;
        const float r = rs[ml];
        const int b = m >> 11, l = m & (SEQ - 1);
        h16* dst = Q + ((size_t)(b * 8 + head) * SEQ + l) * 192 + d0 + 4 * G.g;
        if (d0 < 128) {
#pragma unroll
            for (int ni = 0; ni < 4; ++ni) st4(dst + ni * 16, acc[mi][ni] * r);
        } else {
#pragma unroll
            for (int hf = 0; hf < 2; ++hf) {
                f32x4 o1, o2; const float pos = hf ? (float)(l & 63) : (float)(l >> 6);
                rope4(acc[mi][2 * hf], acc[mi][2 * hf + 1], pos, 4 * G.g, L2_10000 / 16.f, r, o1, o2);
                st4(dst + hf * 32, o1); st4(dst + hf * 32 + 16, o2);
            }
        }
    }
}
__device__ __forceinline__ void kvup_unit(const Args& a, LAS char* lds, G3Stream& S, int p, int pn) {
    GemmThread G; G.init(true);
    const h16* CKV = (const h16*)(a.ws + WS_CKV); h16* KN = (h16*)(a.ws + WS_KN); h16* VV = (h16*)(a.ws + WS_VV);
    LAS float* rs = (LAS float*)(lds + GEMM_ROWS_OFF);
    const int mt = p >> 4, nt = p & 15;
    const bool hn = pn >= 0;
    f32x4 acc[4][4];
    gemm_tile_g<true>(lds, G, CKV + (size_t)mt * 256 * 256, 256, (const h16*)(a.ws + WS_WUKV16) + nt * 128, 2048, 256 / 64, acc, S,
                      hn ? CKV + (size_t)(pn >> 4) * 256 * 256 : nullptr, hn ? (const h16*)(a.ws + WS_WUKV16) + (pn & 15) * 128 : nullptr);
    const int head = nt >> 1; h16* base = (nt & 1) ? VV : KN;
#pragma unroll
    for (int mi = 0; mi < 4; ++mi) {
        const int ml = G.wm * 64 + mi * 16 + G.r16, m = mt * 256 + ml;
        const float r = rs[ml];
        const int b = m / LK, key = m % LK;
        h16* dst = base + ((size_t)(b * 8 + head) * LK + key) * 128 + G.wn * 64 + 4 * G.g;
#pragma unroll
        for (int ni = 0; ni < 4; ++ni) st4(dst + ni * 16, acc[mi][ni] * r);
    }
}

__device__ __forceinline__ float log2_gamma(const float* rdec, int dir, int h) {
    const float x = rdec[dir * 8 + h];
    return -log1pf(__expf(-x)) * 1.4426950408889634f;
}

__device__ __forceinline__ void ret_state_item(const Args& a, LAS char* lds, int it) {
    int tid = threadIdx.x; asm volatile("" : "+v"(tid));
    const int lane = tid & 63, wid = __builtin_amdgcn_readfirstlane(tid >> 6), r16 = lane & 15, g = lane >> 4;
    const h16* KR = (const h16*)(a.ws + WS_KR); const h16* VR = (const h16*)(a.ws + WS_VR);
    const h16* KC = (const h16*)(a.ws + WS_KC); const h16* VC = (const h16*)(a.ws + WS_VC);
    h16* UF = (h16*)(a.ws + WS_UF); h16* UB = (h16*)(a.ws + WS_UB); h16* S0F = (h16*)(a.ws + WS_S0F); h16* S0B = (h16*)(a.ws + WS_S0B);
    LAS char* Kf = lds; LAS char* Kb = lds + 32768; LAS char* Vi = lds + 65536;
    __syncthreads();
    {
        const int bh = it / 17, c = it % 17, h = bh & 7;
        const float lgf = log2_gamma(a.in[I_RDEC], 0, h), lgb = log2_gamma(a.in[I_RDEC], 1, h);
        const bool isctx = (c == 16);
        const int J = isctx ? 256 : 128;
        const h16* Kp = isctx ? KC + (size_t)bh * LC * 128 : KR + ((size_t)bh * SEQ + c * 128) * 128;
        const h16* Vp = isctx ? VC + (size_t)bh * LC * 128 : VR + ((size_t)bh * SEQ + c * 128) * 128;
        f32x4 accf[8], accb[8];
#pragma unroll
        for (int i = 0; i < 8; ++i) { accf[i] = (f32x4){0.f, 0.f, 0.f, 0.f}; accb[i] = (f32x4){0.f, 0.f, 0.f, 0.f}; }
        for (int sub = 0; sub < J / 128; ++sub) {
            if (sub) __syncthreads();
#pragma unroll
            for (int i = 0; i < 4; ++i) {
                const int row = (tid >> 4) + 32 * i, ch = tid & 15, j = sub * 128 + row;
                const h16x8 kv = *(const h16x8*)(Kp + (size_t)j * 128 + ch * 8);
                const h16x8 vv = *(const h16x8*)(Vp + (size_t)j * 128 + ch * 8);
                const float zf = exp2f(lgf * (float)(J - 1 - j)), zb = exp2f(lgb * (float)j);
                h16x8 kf, kb;
#pragma unroll
                for (int e = 0; e < 8; ++e) { const float f = (float)kv[e]; kf[e] = (h16)(f * zf); kb[e] = (h16)(f * zb); }
                const int o = off_b(row, ch);
                *(LAS h16x8*)(Kf + o) = kf; *(LAS h16x8*)(Kb + o) = kb; *(LAS h16x8*)(Vi + o) = vv;
            }
            __syncthreads();
#pragma unroll
            for (int ks = 0; ks < 4; ++ks) {
                const int o0 = tr_addr16(lane, wid, ks, 0), o1 = tr_addr16(lane, wid, ks, 1);
                const h16x8 af = cat8(trrd(Kf + o0), trrd(Kf + o1)), ab = cat8(trrd(Kb + o0), trrd(Kb + o1));
#pragma unroll
                for (int cb = 0; cb < 8; ++cb) {
                    const h16x8 bv = cat8(trrd(Vi + tr_addr16(lane, cb, ks, 0)), trrd(Vi + tr_addr16(lane, cb, ks, 1)));
                    accf[cb] = mfma16(af, bv, accf[cb]); accb[cb] = mfma16(ab, bv, accb[cb]);
                }
            }
        }
        h16* of = isctx ? S0F + (size_t)bh * 16384 : UF + ((size_t)bh * 16 + c) * 16384;
        h16* ob = isctx ? S0B + (size_t)bh * 16384 : UB + ((size_t)bh * 16 + c) * 16384;
#pragma unroll
        for (int cb = 0; cb < 8; ++cb)
#pragma unroll
            for (int r = 0; r < 4; ++r) {
                const int d = wid * 16 + 4 * g + r, e = cb * 16 + r16;
                of[d * 128 + e] = (h16)accf[cb][r]; ob[d * 128 + e] = (h16)accb[cb][r];
            }
        __syncthreads();
    }
}

constexpr int N_ITEMS = 384 + 544 + 576;
__device__ __forceinline__ void phase_mid(const Args& a, LAS char* lds, int vcu) {
    phase_inproj(a, lds, vcu, 1);
    const int Gn = (int)gridDim.x;
    const bool bal = (Gn == 256);
    const int cyc = bal ? 432 : Gn, nseq = (bal && vcu >= INPROJ_NU1) ? 3 : 1;
    G3Stream S; S.gs = 0; S.primed = false;
    int j = 0, t = 0;
    for (;;) {
        const int i = vcu + 88 * t + cyc * j;
        if (i >= N_ITEMS) break;
        int t2 = t + 1, j2 = j; if (t2 == nseq) { t2 = 0; ++j2; }
        const int inext = vcu + 88 * t2 + cyc * j2;
        if (i < 384) qup_unit(a, lds, S, i, (inext < 384) ? inext : -1);
        else if (i < 928) ret_state_item(a, lds, i - 384);
        else kvup_unit(a, lds, S, i - 928, (inext < N_ITEMS) ? inext - 928 : -1);
        t = t2; j = j2;
    }
}

__device__ __forceinline__ void phase_ret_scan(const Args& a) {
    const h16* UF = (const h16*)(a.ws + WS_UF); const h16* UB = (const h16*)(a.ws + WS_UB);
    const h16* S0F = (const h16*)(a.ws + WS_S0F); const h16* S0B = (const h16*)(a.ws + WS_S0B);
    h16* SF = (h16*)(a.ws + WS_SF); h16* SB = (h16*)(a.ws + WS_SB);
    for (int idx = blockIdx.x * NTHREADS + threadIdx.x; idx < 32 * 16384; idx += gridDim.x * NTHREADS) {
        const int bh = idx >> 14, el = idx & 16383, h = bh & 7;
        const float gf = exp2f(128.f * log2_gamma(a.in[I_RDEC], 0, h)), gb = exp2f(128.f * log2_gamma(a.in[I_RDEC], 1, h));
        float sf = (float)S0F[idx], sb = (float)S0B[idx];
        for (int c = 0; c < 16; ++c) {
            SF[((size_t)bh * 16 + c) * 16384 + el] = (h16)sf;
            sf = gf * sf + (float)UF[((size_t)bh * 16 + c) * 16384 + el];
        }
        for (int c = 15; c >= 0; --c) {
            SB[((size_t)bh * 16 + c) * 16384 + el] = (h16)sb;
            sb = gb * sb + (float)UB[((size_t)bh * 16 + c) * 16384 + el];
        }
    }
}

__device__ __forceinline__ void ret_out_item(const Args& a, LAS char* lds, int bh, int c) {
    const int tid = threadIdx.x, lane = tid & 63, wid = __builtin_amdgcn_readfirstlane(tid >> 6), r16 = lane & 15, g = lane >> 4;
    const int b = bh >> 3, h = bh & 7;
    const float lgf = log2_gamma(a.in[I_RDEC], 0, h), lgb = log2_gamma(a.in[I_RDEC], 1, h);
    const h16* QR = (const h16*)(a.ws + WS_QR); const h16* KR = (const h16*)(a.ws + WS_KR); const h16* VR = (const h16*)(a.ws + WS_VR);
    const h16* SF = (const h16*)(a.ws + WS_SF); const h16* SB = (const h16*)(a.ws + WS_SB);
    const h16* GS = (const h16*)(a.ws + WS_GS); h16* MIX = (h16*)(a.ws + WS_MIX);
    LAS char* Qi = lds; LAS char* Ki = lds + 32768; LAS char* Vi = lds + 65536; LAS char* Pi = lds + 98304;
    const size_t src0 = ((size_t)bh * SEQ + c * 128) * 128, st0 = ((size_t)bh * 16 + c) * 16384;
    int ra[4], tbv[8][2];
#pragma unroll
    for (int s = 0; s < 4; ++s) ra[s] = row_addr16(lane, 0, s);
#pragma unroll
    for (int eb = 0; eb < 8; ++eb) { tbv[eb][0] = tr_addr16(lane, eb, 0, 0); tbv[eb][1] = tr_addr16(lane, eb, 0, 1); }
    const int st_o = off_b(tid >> 4, tid & 15);
    u32x4 sfr[4], sbr[4];
    {
        u32x4 qv[4], kv[4], vv[4];
#pragma unroll
        for (int i = 0; i < 4; ++i) {
            const size_t s = src0 + (size_t)((tid >> 4) + 32 * i) * 128 + (tid & 15) * 8;
            qv[i] = *(const u32x4*)(QR + s); kv[i] = *(const u32x4*)(KR + s); vv[i] = *(const u32x4*)(VR + s);
        }
#pragma unroll
        for (int i = 0; i < 4; ++i) {
            const size_t s = st0 + (size_t)((tid >> 4) + 32 * i) * 128 + (tid & 15) * 8;
            sfr[i] = *(const u32x4*)(SF + s); sbr[i] = *(const u32x4*)(SB + s);
        }
#pragma unroll
        for (int i = 0; i < 4; ++i) { *(LAS u32x4*)(Qi + st_o + i * 8192) = qv[i]; *(LAS u32x4*)(Ki + st_o + i * 8192) = kv[i]; *(LAS u32x4*)(Vi + st_o + i * 8192) = vv[i]; }
    }
    __syncthreads();
    h16x8 qf[4];
#pragma unroll
    for (int s = 0; s < 4; ++s) qf[s] = *(LAS h16x8*)(Qi + ra[s] + wid * 4096);
    const int il = 16 * wid + r16;
#pragma unroll
    for (int jb = 0; jb < 8; ++jb) {
        f32x4 sa = (f32x4){0.f, 0.f, 0.f, 0.f};
#pragma unroll
        for (int s = 0; s < 4; ++s) { const h16x8 kf = *(LAS h16x8*)(Ki + ra[s] + jb * 4096); sa = mfma16(kf, qf[s], sa); }
        f32x4 pv;
#pragma unroll
        for (int r = 0; r < 4; ++r) {
            const int dl = il - (16 * jb + 4 * g + r);
            float f = 0.f;
            if (dl >= 0) f += exp2f(lgf * (float)dl);
            if (dl <= 0) f += exp2f(lgb * (float)(-dl));
            pv[r] = sa[r] * f;
        }
        *(LAS h16x4*)(Pi + off_b(il, 2 * jb + (g >> 1)) + (g & 1) * 8) = cvt4(pv);
    }
    __syncthreads();
#pragma unroll
    for (int i = 0; i < 4; ++i) *(LAS u32x4*)(Ki + st_o + i * 8192) = sfr[i];
    __syncthreads();
    const h16 xfh = (h16)exp2f(lgf * (float)(il + 1)), xbh = (h16)exp2f(lgb * (float)(128 - il));
    f32x4 ao[8];
#pragma unroll
    for (int i = 0; i < 8; ++i) ao[i] = (f32x4){0.f, 0.f, 0.f, 0.f};
#pragma unroll
    for (int s = 0; s < 4; ++s) {
        const h16x8 pf = *(LAS h16x8*)(Pi + ra[s] + wid * 4096);
        const h16x8 qsf = qf[s] * xfh;
#pragma unroll
        for (int eb = 0; eb < 8; ++eb) {
            const h16x8 vf = cat8(trrd(Vi + tbv[eb][0] + s * 8192), trrd(Vi + tbv[eb][1] + s * 8192));
            ao[eb] = mfma16(vf, pf, ao[eb]);
            const h16x8 sf = cat8(trrd(Ki + tbv[eb][0] + s * 8192), trrd(Ki + tbv[eb][1] + s * 8192));
            ao[eb] = mfma16(sf, qsf, ao[eb]);
        }
    }
    __syncthreads();
#pragma unroll
    for (int i = 0; i < 4; ++i) *(LAS u32x4*)(Vi + st_o + i * 8192) = sbr[i];
    __syncthreads();
#pragma unroll
    for (int s = 0; s < 4; ++s) {
        const h16x8 qsb = qf[s] * xbh;
#pragma unroll
        for (int eb = 0; eb < 8; ++eb) {
            const h16x8 sf = cat8(trrd(Vi + tbv[eb][0] + s * 8192), trrd(Vi + tbv[eb][1] + s * 8192));
            ao[eb] = mfma16(sf, qsb, ao[eb]);
        }
    }
    float sum = 0.f;
#pragma unroll
    for (int eb = 0; eb < 8; ++eb) sum += (ao[eb][0] + ao[eb][1]) + (ao[eb][2] + ao[eb][3]);
    sum += __shfl_xor(sum, 16); sum += __shfl_xor(sum, 32);
    const float mean = sum * (1.f / 128.f); float q = 0.f;
#pragma unroll
    for (int eb = 0; eb < 8; ++eb) { ao[eb] = ao[eb] - mean; q += (ao[eb][0] * ao[eb][0] + ao[eb][1] * ao[eb][1]) + (ao[eb][2] * ao[eb][2] + ao[eb][3] * ao[eb][3]); }
    q += __shfl_xor(q, 16); q += __shfl_xor(q, 32);
    const float rstd = 1.f / sqrtf(q * (1.f / 128.f) + EPS);
    const int t = b * SEQ + c * 128 + il;
    const float* gw = a.in[I_RGN] + h * 128;
#pragma unroll
    for (int eb = 0; eb < 8; ++eb) {
        const int e = 16 * eb + 4 * g;
        const f32x4 w = *(const f32x4*)(gw + e);
        const h16x4 gs = *(const h16x4*)(GS + (size_t)t * 1024 + h * 128 + e);
        f32x4 o;
#pragma unroll
        for (int r = 0; r < 4; ++r) o[r] = ao[eb][r] * rstd * w[r] * (float)gs[r];
        st4(MIX + (size_t)t * DM + h * 128 + e, o);
    }
    __syncthreads();
}

namespace att {
constexpr float SCALE = 0.07216878364870322f;
constexpr float THR = 8.f;
constexpr int SHM_V = 16384, SHM_K = 16384, SHM_P = 8192;
constexpr int OFF_V = 0, OFF_K = 32768, OFF_P = 65536, OFF_W = 81920, OFF_QP = 83968;
using s16x4 = __attribute__((ext_vector_type(4))) short;
#define KSWZ(row, colB) ((row) * 256 + ((colB) ^ (((row) & 7) << 4)))
#define PSWZ(row, colB) ((row) * 128 + ((colB) ^ (((row) & 7) << 4)))
#define SBAR() __builtin_amdgcn_sched_barrier(0)
__device__ __forceinline__ int crow(int r, int hi) { return (r & 3) + 8 * (r >> 2) + 4 * hi; }
__device__ __forceinline__ unsigned pk2(float lo, float hi) { h16x2 v; v[0] = (h16)lo; v[1] = (h16)hi; return __builtin_bit_cast(unsigned, v); }
__device__ __forceinline__ f32x16 mfma32(h16x8 a, h16x8 b, f32x16 c) { return __builtin_amdgcn_mfma_f32_32x32x16_f16(a, b, c, 0, 0, 0); }
__device__ __forceinline__ void partialSM(f32x16& p0, f32x16& p1, float& m_reg, float& mn, float& alpha) {
    constexpr float C = SCALE * 1.4426950408889634f;
    float pmax = p0[0];
#pragma unroll
    for (int r = 1; r < 16; ++r) pmax = fmaxf(pmax, p0[r]);
#pragma unroll
    for (int r = 0; r < 16; ++r) pmax = fmaxf(pmax, p1[r]);
    { auto rr = __builtin_amdgcn_permlane32_swap(__float_as_uint(pmax), __float_as_uint(pmax), false, false);
      pmax = fmaxf(__uint_as_float(rr[0]), __uint_as_float(rr[1])); }
    if (__builtin_expect(__all(pmax - m_reg <= THR / SCALE), 1)) { mn = m_reg; alpha = 1.f; }
    else { mn = fmaxf(m_reg, pmax); alpha = __builtin_amdgcn_exp2f((m_reg - mn) * C); m_reg = mn; }
    const float mnC = -mn * C;
#pragma unroll
    for (int r = 0; r < 16; ++r) p0[r] = fmaf(p0[r], C, mnC);
#pragma unroll
    for (int r = 0; r < 16; ++r) p1[r] = fmaf(p1[r], C, mnC);
#pragma unroll
    for (int r = 0; r < 16; ++r) p0[r] = __builtin_amdgcn_exp2f(p0[r]);
}
__device__ __forceinline__ void finishSM(f32x16& p0, f32x16& p1, float alpha, float& l_reg, h16x8& pa0, h16x8& pa1, h16x8& pa2, h16x8& pa3) {
#pragma unroll
    for (int r = 0; r < 16; ++r) p1[r] = __builtin_amdgcn_exp2f(p1[r]);
    float ps = 0;
#pragma unroll
    for (int r = 0; r < 16; ++r) ps += p0[r];
#pragma unroll
    for (int r = 0; r < 16; ++r) ps += p1[r];
    { auto rr = __builtin_amdgcn_permlane32_swap(__float_as_uint(ps), __float_as_uint(ps), false, false);
      ps = __uint_as_float(rr[0]) + __uint_as_float(rr[1]); }
    l_reg = l_reg * alpha + ps;
#define PK4(P, BASE, OUT) do { unsigned a0 = pk2(P[BASE + 0], P[BASE + 1]), a1 = pk2(P[BASE + 2], P[BASE + 3]);   \
    unsigned b0 = pk2(P[BASE + 4], P[BASE + 5]), b1 = pk2(P[BASE + 6], P[BASE + 7]);                              \
    auto r0 = __builtin_amdgcn_permlane32_swap(a0, b0, false, false); auto r1 = __builtin_amdgcn_permlane32_swap(a1, b1, false, false); \
    u32x4 w = {r0[0], r1[0], r0[1], r1[1]}; OUT = __builtin_bit_cast(h16x8, w); } while (0)
    PK4(p0, 0, pa0); PK4(p0, 8, pa1); PK4(p1, 0, pa2); PK4(p1, 8, pa3);
#undef PK4
}
__device__ __forceinline__ void qkt(f32x16& p0, f32x16& p1, LAS char* Ks, LAS char* Ps, const h16x8* qr, LAS char* qpl, int r32, int hi) {
    p0 = f32x16{}; p1 = f32x16{};
#pragma unroll
    for (int d0 = 0; d0 < 8; ++d0) { const int cb = (d0 * 16 + hi * 8) * 2;
        const h16x8 b0 = *(LAS h16x8*)(Ks + KSWZ(r32, cb));
        const h16x8 b1 = *(LAS h16x8*)(Ks + KSWZ(32 + r32, cb));
        p0 = mfma32(b0, qr[d0], p0); p1 = mfma32(b1, qr[d0], p1); }
    SBAR();
#pragma unroll
    for (int d0 = 0; d0 < 4; ++d0) { const int cb = (d0 * 16 + hi * 8) * 2;
        const h16x8 b0 = *(LAS h16x8*)(Ps + PSWZ(r32, cb));
        const h16x8 b1 = *(LAS h16x8*)(Ps + PSWZ(32 + r32, cb));
        const h16x8 qv = *(LAS h16x8*)(qpl + PSWZ(r32, cb));
        p0 = mfma32(b0, qv, p0); p1 = mfma32(b1, qv, p1); }
}
__device__ __forceinline__ int v_st(int k, int c) { const int kk = (k & ~0xC) | ((k & 4) << 1) | ((k & 8) >> 1); return ((kk >> 3) * 4 + (c >> 5)) * 512 + ((kk & 7) * 32 + (c & 31)) * 2; }
__device__ __forceinline__ int v_rd_base(int lane) { return ((lane & 3) << 3) | (((lane >> 2) & 3) << 6) | (((lane >> 4) & 1) << 5) | (((lane >> 5) & 1) << 8); }
constexpr int v_rd_off(int d0, int ks, int half) { return d0 * 512 + ks * 4096 + half * 2048; }
template <int OFF> __device__ __forceinline__ s16x4 tr_read(int vb) {
    s16x4 r; asm volatile("ds_read_b64_tr_b16 %0, %1 offset:%2" : "=&v"(r) : "v"(vb), "i"(OFF) : "memory"); return r;
}
template <int D0> __device__ __forceinline__ void pv_one(f32x16& od, int vb, h16x8 pa0, h16x8 pa1, h16x8 pa2, h16x8 pa3) {
    const s16x4 l0 = tr_read<v_rd_off(D0, 0, 0)>(vb), h0 = tr_read<v_rd_off(D0, 0, 1)>(vb), l1 = tr_read<v_rd_off(D0, 1, 0)>(vb), h1 = tr_read<v_rd_off(D0, 1, 1)>(vb);
    const s16x4 l2 = tr_read<v_rd_off(D0, 2, 0)>(vb), h2 = tr_read<v_rd_off(D0, 2, 1)>(vb), l3 = tr_read<v_rd_off(D0, 3, 0)>(vb), h3 = tr_read<v_rd_off(D0, 3, 1)>(vb);
    asm volatile("s_waitcnt lgkmcnt(0)" ::: "memory"); SBAR();
#define PK(L, H) __builtin_bit_cast(h16x8, __builtin_shufflevector(L, H, 0, 1, 2, 3, 4, 5, 6, 7))
    od = mfma32(pa0, PK(l0, h0), od);
    od = mfma32(pa1, PK(l1, h1), od);
    od = mfma32(pa2, PK(l2, h2), od);
    od = mfma32(pa3, PK(l3, h3), od);
#undef PK
}
__device__ __forceinline__ void pv_d0(f32x16* o, int vb, h16x8 pa0, h16x8 pa1, h16x8 pa2, h16x8 pa3) {
    pv_one<0>(o[0], vb, pa0, pa1, pa2, pa3); pv_one<1>(o[1], vb, pa0, pa1, pa2, pa3); pv_one<2>(o[2], vb, pa0, pa1, pa2, pa3); pv_one<3>(o[3], vb, pa0, pa1, pa2, pa3);
}
__device__ __forceinline__ void attn_body(const h16* __restrict__ Qb, const h16* __restrict__ Kh, const h16* __restrict__ Vh, const h16* __restrict__ Ph,
                                          h16* __restrict__ Ob, int seq, LAS char* lds) {
    int tid = threadIdx.x; asm volatile("" : "+v"(tid));
    const int wid = tid >> 6, lane = tid & 63, r32 = lane & 31, hi = lane >> 5;
    LAS char* V_lds = lds + OFF_V; LAS char* K_lds = lds + OFF_K; LAS char* P_lds = lds + OFF_P;
    LAS float* wsf = (LAS float*)(lds + OFF_W) + wid * 64; LAS float* li_l = wsf; LAS float* al_l = wsf + 32;
    float m_reg = -1e30f, l_reg = 0; f32x16 o[4] = {}; h16x8 qr[8];
    LAS char* qp = lds + OFF_QP + wid * 4096;
    const h16* Qw = Qb + (size_t)(wid * 32 + r32) * 192 + hi * 8;
#pragma unroll
    for (int d0 = 0; d0 < 8; ++d0) qr[d0] = *(const h16x8*)(Qw + d0 * 16);
#pragma unroll
    for (int d0 = 0; d0 < 4; ++d0) *(LAS u32x4*)(qp + PSWZ(r32, (d0 * 16 + hi * 8) * 2)) = *(const u32x4*)(Qw + 128 + d0 * 16);
    const int sr = tid >> 4, sc = (tid & 15) * 8, vst0 = v_st(sr, sc), vst1 = v_st(32 + sr, sc);
    const int pr = tid >> 3, pc = (tid & 7) * 8;
    const int vb0 = (int)(uintptr_t)V_lds + v_rd_base(lane);
    struct { u32x4 vs0, vs1, ks0, ks1, ps; } sr_[1];
    const int vo = sr * 256 + sc * 2, po = pr * 128 + pc * 2;
    const __amdgpu_buffer_rsrc_t rsK = __builtin_amdgcn_make_buffer_rsrc((void*)Kh, (short)0, seq * 256, 0x00020000);
    const __amdgpu_buffer_rsrc_t rsV = __builtin_amdgcn_make_buffer_rsrc((void*)Vh, (short)0, seq * 256, 0x00020000);
    const __amdgpu_buffer_rsrc_t rsP = __builtin_amdgcn_make_buffer_rsrc((void*)Ph, (short)0, seq * 128, 0x00020000);
#define SLOAD(i, k0) do { const int so_ = (k0) * 256; \
    sr_[i].vs0 = __builtin_bit_cast(u32x4, __builtin_amdgcn_raw_buffer_load_b128(rsV, vo, so_, 0)); sr_[i].vs1 = __builtin_bit_cast(u32x4, __builtin_amdgcn_raw_buffer_load_b128(rsV, vo, so_ + 8192, 0)); \
    sr_[i].ks0 = __builtin_bit_cast(u32x4, __builtin_amdgcn_raw_buffer_load_b128(rsK, vo, so_, 0)); sr_[i].ks1 = __builtin_bit_cast(u32x4, __builtin_amdgcn_raw_buffer_load_b128(rsK, vo, so_ + 8192, 0)); \
    sr_[i].ps = __builtin_bit_cast(u32x4, __builtin_amdgcn_raw_buffer_load_b128(rsP, po, (k0) * 128, 0)); } while (0)
#define SWRITE(b, i) do { *(LAS u32x4*)(V_lds + (b) * SHM_V + vst0) = sr_[i].vs0;          \
    *(LAS u32x4*)(V_lds + (b) * SHM_V + vst1) = sr_[i].vs1; const int kc = sc * 2;               \
    *(LAS u32x4*)(K_lds + (b) * SHM_K + KSWZ(sr, kc)) = sr_[i].ks0;                       \
    *(LAS u32x4*)(K_lds + (b) * SHM_K + KSWZ(32 + sr, kc)) = sr_[i].ks1;                  \
    *(LAS u32x4*)(P_lds + (b) * SHM_P + PSWZ(pr, pc * 2)) = sr_[i].ps; } while (0)
#define SWAIT() asm volatile("s_waitcnt vmcnt(0)" ::: "memory")
#define RESC(a) do { if (__any((a) < 1.f)) { if (hi == 0) al_l[r32] = (a); asm volatile("s_waitcnt lgkmcnt(0)" ::: "memory"); \
    _Pragma("unroll") for (int d = 0; d < 4; ++d) _Pragma("unroll") for (int r = 0; r < 16; ++r) o[d][r] *= al_l[crow(r, hi)]; } } while (0)
    f32x16 pA0, pA1, pB0, pB1; float mnA, mnB, alA, alB; h16x8 pa0, pa1, pa2, pa3; const int NT = seq / 64;
    constexpr int SE = 0, SO = 0;
    SLOAD(SE, 0); asm volatile("s_waitcnt vmcnt(0)" ::: "memory"); SWRITE(0, SE); __syncthreads();
    qkt(pA0, pA1, K_lds, P_lds, qr, qp, r32, hi); partialSM(pA0, pA1, m_reg, mnA, alA);
    SLOAD(SO, 64);
    SWAIT(); SWRITE(1, SO); __syncthreads();
    for (int j = 1; j + 1 < NT; j += 2) {
        SBAR(); qkt(pB0, pB1, K_lds + SHM_K, P_lds + SHM_P, qr, qp, r32, hi);
        finishSM(pA0, pA1, alA, l_reg, pa0, pa1, pa2, pa3); SBAR();
        SLOAD(SO, (j + 1) * 64); SBAR();
        pv_d0(o, vb0, pa0, pa1, pa2, pa3); partialSM(pB0, pB1, m_reg, mnB, alB);
        __syncthreads(); SWAIT(); SWRITE(0, SE);
        RESC(alB); __syncthreads();
        SBAR(); qkt(pA0, pA1, K_lds, P_lds, qr, qp, r32, hi);
        finishSM(pB0, pB1, alB, l_reg, pa0, pa1, pa2, pa3); SBAR();
        SLOAD(SE, (j + 2) * 64); SBAR();
        pv_d0(o, vb0 + SHM_V, pa0, pa1, pa2, pa3); partialSM(pA0, pA1, m_reg, mnA, alA);
        __syncthreads(); SWAIT(); SWRITE(1, SO);
        RESC(alA); __syncthreads();
    }
    SBAR(); qkt(pB0, pB1, K_lds + SHM_K, P_lds + SHM_P, qr, qp, r32, hi);
    finishSM(pA0, pA1, alA, l_reg, pa0, pa1, pa2, pa3); SBAR();
    pv_d0(o, vb0, pa0, pa1, pa2, pa3); partialSM(pB0, pB1, m_reg, mnB, alB);
    __syncthreads(); RESC(alB);
    finishSM(pB0, pB1, alB, l_reg, pa0, pa1, pa2, pa3); SBAR();
    pv_d0(o, vb0 + SHM_V, pa0, pa1, pa2, pa3);
    if (hi == 0) li_l[r32] = l_reg; asm volatile("s_waitcnt lgkmcnt(0)" ::: "memory");
    float rli[16];
#pragma unroll
    for (int r = 0; r < 16; ++r) rli[r] = __builtin_amdgcn_rcpf(li_l[crow(r, hi)]);
    h16* Ow = Ob + (size_t)(wid * 32) * DM;
#pragma unroll
    for (int r = 0; r < 16; ++r) { const int orow = crow(r, hi);
#pragma unroll
        for (int d0 = 0; d0 < 4; ++d0) Ow[(size_t)orow * DM + d0 * 32 + r32] = (h16)(o[d0][r] * rli[r]); }
    __syncthreads();
#undef SLOAD
#undef SWRITE
#undef SWAIT
#undef RESC
}
#undef KSWZ
#undef PSWZ
}

__device__ __forceinline__ void phase_attn(const Args& a, LAS char* lds, int vcu) {
    const h16* Q = (const h16*)(a.ws + WS_Q); const h16* KN = (const h16*)(a.ws + WS_KN); const h16* VV = (const h16*)(a.ws + WS_VV);
    const h16* KPE = (const h16*)(a.ws + WS_KPE); h16* MIX = (h16*)(a.ws + WS_MIX);
    for (int it = vcu; it < 256; it += gridDim.x) {
        const int bh = it >> 3, qb = it & 7, b = bh >> 3, h = bh & 7;
        att::attn_body(Q + ((size_t)bh * SEQ + qb * 256) * 192, KN + (size_t)bh * LK * 128, VV + (size_t)bh * LK * 128, KPE + (size_t)b * LK * 64,
                       MIX + ((size_t)b * SEQ + qb * 256) * DM + 1024 + h * 128, LK, lds);
    }
}
__device__ __forceinline__ void phase_retout(const Args& a, LAS char* lds, int vcu) {
    for (int it = vcu; it < 512; it += gridDim.x) ret_out_item(a, lds, it >> 4, it & 15);
}

__device__ __forceinline__ void phase_oproj(const Args& a, LAS char* lds, int vcu) {
    GemmThread2 G; G.init();
    const h16* MIX = (const h16*)(a.ws + WS_MIX); const float* MOD = (const float*)(a.ws + WS_MOD); h16* U = (h16*)(a.ws + WS_U);
    const float* X = a.in[I_X];
    for (int p = vcu; p < 32 * 8; p += gridDim.x) {
        const int mg = p >> 5, rem = p & 31, nt = rem >> 2, mt = mg * 4 + (rem & 3);
        f32x4 acc[8][4];
        gemm_tile_g2(lds, G, MIX + (size_t)mt * 256 * DM, DM, (const h16*)(a.ws + WS_WO16) + nt * 256, DM, DM / 64, acc);
        const int b = mt >> 3, c0 = nt * 256 + G.wn * 64 + 4 * G.g;
        const float* g1 = MOD + (size_t)b * ADAW + 2 * DM + c0;
        f32x4 gv[4];
#pragma unroll
        for (int ni = 0; ni < 4; ++ni) gv[ni] = *(const f32x4*)(g1 + ni * 16);
        const size_t ro0 = (size_t)(mt * 256 + G.wm * 128 + G.r16) * DM + c0;
        f32x4 xn[4];
#pragma unroll
        for (int ni = 0; ni < 4; ++ni) xn[ni] = *(const f32x4*)(X + ro0 + ni * 16);
#pragma unroll
        for (int mi = 0; mi < 8; ++mi) {
            const size_t ro = ro0 + (size_t)mi * 16 * DM;
            f32x4 xv[4];
#pragma unroll
            for (int ni = 0; ni < 4; ++ni) xv[ni] = xn[ni];
            if (mi < 7) {
#pragma unroll
                for (int ni = 0; ni < 4; ++ni) xn[ni] = *(const f32x4*)(X + ro + (size_t)16 * DM + ni * 16);
            }
            __builtin_amdgcn_sched_barrier(0);
#pragma unroll
            for (int ni = 0; ni < 4; ++ni) st4(U + ro + ni * 16, xv[ni] * ALPHA + gv[ni] * acc[mi][ni]);
        }
    }
}

__device__ __forceinline__ int rt_off(int m, int c) { return m * 4096 + ((c ^ (m & 15)) << 4); }
__device__ __forceinline__ void phase_router(const Args& a, LAS char* lds) {
    const int tid = threadIdx.x, lane = tid & 63, wid = __builtin_amdgcn_readfirstlane(tid >> 6), r16 = lane & 15, g = lane >> 4;
    const h16* U = (const h16*)(a.ws + WS_U); const float* MOD = (const float*)(a.ws + WS_MOD);
    h16* H = (h16*)(a.ws + WS_H); unsigned char* A2q = (unsigned char*)(a.ws + WS_A2);
    int* LIST = (int*)(a.ws + WS_LIST); float* WL = (float*)(a.ws + WS_WL); unsigned* CNT = (unsigned*)(a.ws + WS_CTL) + CW_CNT;
    const h16* WRH = (const h16*)(a.ws + WS_WRH);
    const float* ln1w = a.in[I_LN1W]; const float* ln1b = a.in[I_LN1B];
    LAS char* THI = lds;
    LAS f32x4* red = (LAS f32x4*)lds;
    LAS float* lg = (LAS float*)(lds + 65536);
    LAS int* asg_e = (LAS int*)(lds + LDS_MAP + 2048); LAS int* asg_t = asg_e + 64; LAS float* asg_w = (LAS float*)(asg_e + 128);
    for (int base = blockIdx.x * 32; base < T; base += gridDim.x * 32) {
#pragma unroll 1
        for (int rr = 0; rr < 4; rr += 2) {
            const int m = 4 * wid + rr, row = base + m, b = row >> 11;
            f32x4 v[2][8]; float s[2] = {0.f, 0.f};
#pragma unroll
            for (int r = 0; r < 2; ++r)
#pragma unroll
                for (int j = 0; j < 8; ++j) { const h16x4 u4 = *(const h16x4*)(U + (size_t)(row + r) * DM + j * 256 + lane * 4);
#pragma unroll
                    for (int e = 0; e < 4; ++e) v[r][j][e] = (float)u4[e];
                    s[r] += (v[r][j][0] + v[r][j][1]) + (v[r][j][2] + v[r][j][3]); }
            float mean[2], q[2] = {0.f, 0.f}, rstd[2];
#pragma unroll
            for (int r = 0; r < 2; ++r) mean[r] = wave_sum(s[r]) * (1.f / DM);
#pragma unroll
            for (int r = 0; r < 2; ++r)
#pragma unroll
                for (int j = 0; j < 8; ++j) { v[r][j] = v[r][j] - mean[r]; q[r] += (v[r][j][0] * v[r][j][0] + v[r][j][1] * v[r][j][1]) + (v[r][j][2] * v[r][j][2] + v[r][j][3] * v[r][j][3]); }
#pragma unroll
            for (int r = 0; r < 2; ++r) { rstd[r] = 1.f / sqrtf(wave_sum(q[r]) * (1.f / DM) + EPS); s[r] = 0.f; }
#pragma unroll
            for (int j = 0; j < 8; ++j) {
                const int k = j * 256 + lane * 4;
                const f32x4 lw = *(const f32x4*)(ln1w + k), lb = *(const f32x4*)(ln1b + k);
#pragma unroll
                for (int r = 0; r < 2; ++r) {
                    v[r][j] = v[r][j] * rstd[r] * lw + lb;
                    *(h16x4*)(H + (size_t)(row + r) * DM + k) = cvt4(v[r][j]);
                    s[r] += (v[r][j][0] + v[r][j][1]) + (v[r][j][2] + v[r][j][3]);
                }
            }
#pragma unroll
            for (int r = 0; r < 2; ++r) { mean[r] = wave_sum(s[r]) * (1.f / DM); q[r] = 0.f; }
#pragma unroll
            for (int r = 0; r < 2; ++r)
#pragma unroll
                for (int j = 0; j < 8; ++j) { v[r][j] = v[r][j] - mean[r]; q[r] += (v[r][j][0] * v[r][j][0] + v[r][j][1] * v[r][j][1]) + (v[r][j][2] * v[r][j][2] + v[r][j][3] * v[r][j][3]); }
#pragma unroll
            for (int r = 0; r < 2; ++r) rstd[r] = 1.f / sqrtf(wave_sum(q[r]) * (1.f / DM) + EPS);
#pragma unroll
            for (int j = 0; j < 8; ++j) {
                const int k = j * 256 + lane * 4;
                const f32x4 sh = *(const f32x4*)(MOD + (size_t)b * ADAW + 3 * DM + k), sc = *(const f32x4*)(MOD + (size_t)b * ADAW + 4 * DM + k);
#pragma unroll
                for (int r = 0; r < 2; ++r) {
                    const f32x4 tt = v[r][j] * rstd[r] * (sc + 1.f) + sh;
                    const h16x4 hi = cvt4(tt);
                    int w8 = __builtin_amdgcn_cvt_pk_fp8_f32(tt[0], tt[1], 0, false); w8 = __builtin_amdgcn_cvt_pk_fp8_f32(tt[2], tt[3], w8, true);
                    *(int*)(A2q + (size_t)(row + r) * DM + k) = w8;
                    *(LAS h16x4*)(THI + rt_off(m + r, j * 32 + (lane >> 1)) + (lane & 1) * 8) = hi;
                }
            }
        }
        __syncthreads();
        f32x4 acc[2][3];
#pragma unroll
        for (int mt = 0; mt < 2; ++mt)
#pragma unroll
            for (int nt = 0; nt < 3; ++nt) acc[mt][nt] = (f32x4){0.f, 0.f, 0.f, 0.f};
#pragma unroll 4
        for (int s8 = 0; s8 < 8; ++s8) {
            const int c = wid * 32 + s8 * 4 + g;
            const h16x8 t0 = *(LAS h16x8*)(THI + rt_off(r16, c)), t1 = *(LAS h16x8*)(THI + rt_off(16 + r16, c));
#pragma unroll
            for (int nt = 0; nt < 3; ++nt) {
                const h16x8 wh = *(const h16x8*)(WRH + (size_t)(16 * nt + r16) * DM + c * 8);
                acc[0][nt] = mfma16(wh, t0, acc[0][nt]); acc[1][nt] = mfma16(wh, t1, acc[1][nt]);
            }
        }
        __syncthreads();
#pragma unroll
        for (int mt = 0; mt < 2; ++mt)
#pragma unroll
            for (int nt = 0; nt < 3; ++nt) red[(wid * 6 + mt * 3 + nt) * 64 + lane] = acc[mt][nt];
        __syncthreads();
        if (tid < 384) {
            const int t6 = tid >> 6, l2 = tid & 63, mt = t6 / 3, nt = t6 - 3 * mt;
            f32x4 sum = (f32x4){0.f, 0.f, 0.f, 0.f};
#pragma unroll
            for (int w = 0; w < 8; ++w) sum += red[(w * 6 + t6) * 64 + l2];
#pragma unroll
            for (int r = 0; r < 4; ++r) lg[(16 * mt + (l2 & 15)) * 48 + 16 * nt + 4 * (l2 >> 4) + r] = sum[r] * (1.f / 1024.f);
        }
        __syncthreads();
        if (tid < 32) {
            const int row = base + tid;
            const float* bg = a.in[I_RGB]; const float* be = a.in[I_REB];
            float glv[4];
#pragma unroll
            for (int c = 0; c < 4; ++c) glv[c] = lg[tid * 48 + c] + bg[c];
            int gs = 0; float gm = glv[0];
#pragma unroll
            for (int c = 1; c < 4; ++c) if (glv[c] > gm) { gm = glv[c]; gs = c; }
            float gden = 0.f;
#pragma unroll
            for (int c = 0; c < 4; ++c) gden += __expf(glv[c] - gm);
            const float gp = 1.f / gden;
            float el[8];
#pragma unroll
            for (int c = 0; c < 8; ++c) el[c] = lg[tid * 48 + 4 + gs * 8 + c] + be[gs * 8 + c];
            int i0 = 0; float v0 = el[0];
#pragma unroll
            for (int c = 1; c < 8; ++c) if (el[c] > v0) { v0 = el[c]; i0 = c; }
            int i1 = -1; float v1 = -3.0e38f;
#pragma unroll
            for (int c = 0; c < 8; ++c) if (c != i0 && el[c] > v1) { v1 = el[c]; i1 = c; }
            const float ex = __expf(v1 - v0), w0 = gp / (1.f + ex), w1 = gp * ex / (1.f + ex);
            asg_e[2 * tid] = gs * 8 + i0; asg_t[2 * tid] = row * 2; asg_w[2 * tid] = w0;
            asg_e[2 * tid + 1] = gs * 8 + i1; asg_t[2 * tid + 1] = row * 2 + 1; asg_w[2 * tid + 1] = w1;
        }
        __syncthreads();
        if (tid < NEXP) {
            int c = 0;
#pragma unroll 4
            for (int i = 0; i < 64; ++i) c += (asg_e[i] == tid) ? 1 : 0;
            if (c) {
                const int sub = tid * 8 + (blockIdx.x & 7);
                unsigned pos = atomicAdd(&CNT[sub], (unsigned)c);
                for (int i = 0; i < 64; ++i) if (asg_e[i] == tid) { LIST[(size_t)sub * SUBCAP + pos] = asg_t[i]; WL[(size_t)sub * SUBCAP + pos] = asg_w[i]; ++pos; }
            }
        }
        __syncthreads();
    }
}

struct MoeMap { int upre[NEXP + 1]; int rpre[NEXP + 1]; };
__device__ __forceinline__ void moe_map(const Args& a, LAS int* mp, int units_per_mtile) {
    const unsigned* CNT = (const unsigned*)(a.ws + WS_CTL) + CW_CNT;
    LAS int* c8 = mp + 448;
    if (threadIdx.x < NEXP * 8) c8[threadIdx.x] = (int)__hip_atomic_load(&CNT[threadIdx.x], __ATOMIC_RELAXED, __HIP_MEMORY_SCOPE_AGENT);
    __syncthreads();
    if (threadIdx.x < NEXP) {
        int acc = 0;
        for (int x = 0; x < 8; ++x) { mp[128 + 9 * threadIdx.x + x] = acc; acc += c8[threadIdx.x * 8 + x]; }
        mp[128 + 9 * threadIdx.x + 8] = acc; mp[66 + threadIdx.x] = acc;
    }
    __syncthreads();
    if (threadIdx.x == 0) {
        int up = 0, rp = 0;
        for (int e = 0; e < NEXP; ++e) {
            const int c = mp[66 + e];
            const int ntm = (c + 255) >> 8;
            mp[e] = up; mp[33 + e] = rp;
            up += ntm * units_per_mtile; rp += ntm * 256;
        }
        mp[32] = up; mp[65] = rp;
    }
    __syncthreads();
}
__device__ __forceinline__ int moe_pos(const LAS int* mp, int e, int idx) {
    const LAS int* sp = mp + 128 + 9 * e;
    int x = 0;
#pragma unroll
    for (int i = 1; i < 8; ++i) x += (idx >= sp[i]) ? 1 : 0;
    return (e * 8 + x) * SUBCAP + idx - sp[x];
}
__device__ __forceinline__ void wdown_pool(const Args& a, LAS char* lds, int budget);
__device__ __forceinline__ void phase_moe1(const Args& a, LAS char* lds, int vcu) {
    GemmThread G; G.init();
    LAS int* mp = (LAS int*)(lds + LDS_MAP);
    moe_map(a, mp, 8);
    const unsigned char* A2q = (const unsigned char*)(a.ws + WS_A2); const int* LIST = (const int*)(a.ws + WS_LIST); h16* HID = (h16*)(a.ws + WS_HID);
    const int NU = mp[32];
    auto unit_tokens = [&](int p, int (&tok)[2]) __attribute__((always_inline)) {
        int e = 0;
        while (p >= mp[e + 1]) ++e;
        const int q = p - mp[e], cnt = mp[66 + e], ntm = (cnt + 255) >> 8, mt = q % ntm;
#pragma unroll
        for (int i = 0; i < 2; ++i) {
            const int idx = mt * 256 + (G.tid >> 2) + 128 * i;
            tok[i] = (idx < cnt) ? (LIST[moe_pos(mp, e, idx)] >> 1) : 0;
        }
    };
    int tokc[2] = {0, 0};
    if (vcu < NU) unit_tokens(vcu, tokc);
    for (int p = vcu; p < NU; p += gridDim.x) {
        int e = 0;
        while (p >= mp[e + 1]) ++e;
        const int q = p - mp[e], cnt = mp[66 + e], ntm = (cnt + 255) >> 8, nt = q / ntm, mt = q % ntm;
        const unsigned char* arow[2];
#pragma unroll
        for (int i = 0; i < 2; ++i) arow[i] = A2q + (size_t)tokc[i] * DM + (G.tid & 3) * 16;
        if (p + (int)gridDim.x < NU) unit_tokens(p + (int)gridDim.x, tokc);
        const int c = (G.tid & 31) * 4, wnc = c >> 6, within = c & 63;
        const float* wsrc = (within >= 32) ? a.in[I_EWU] : a.in[I_EWG];
        const float* bcol = wsrc + (size_t)e * DM * DE + (size_t)(G.tid >> 5) * DE + nt * 64 + wnc * 32 + (within & 31);
        f32x4 acc[4][4];
        gemm_tile(lds, G, arow, bcol, (size_t)DE, DM / 64, acc);
        {
#pragma unroll
            for (int mi = 0; mi < 4; ++mi) {
                const int rowp = mp[33 + e] + mt * 256 + G.wm * 64 + mi * 16 + G.r16;
                h16* dst = HID + (size_t)rowp * DE + nt * 64 + G.wn * 32 + 4 * G.g;
#pragma unroll
                for (int ni = 0; ni < 2; ++ni) {
                    f32x4 o;
#pragma unroll
                    for (int r = 0; r < 4; ++r) o[r] = silu_f(acc[mi][ni][r]) * acc[mi][ni + 2][r];
                    st4(dst + ni * 16, o);
                }
            }
        }
    }
    wdown_pool(a, lds, 1 << 20);
}
constexpr int POOL_ITEMS = (NEXP * DE * DM / 8) / (NTHREADS * 8);
__device__ __forceinline__ void wdown_pool(const Args& a, LAS char* lds, int budget) {
    unsigned* head = (unsigned*)(a.ws + WS_CTL) + CW_POOL;
    const float* W = a.in[I_EWD]; h16* O = (h16*)(a.ws + WS_WD16);
    LAS unsigned* slot = (LAS unsigned*)(lds + LDS_MAP + 400);
    for (int it = 0; it < budget; ++it) {
        __syncthreads();
        if (threadIdx.x == 0) *slot = atomicAdd(head, 1u);
        __syncthreads();
        const unsigned item = *slot;
        if (item >= (unsigned)POOL_ITEMS) break;
        const size_t base = (size_t)item * (NTHREADS * 8) + threadIdx.x;
        f32x4 v[8][2];
#pragma unroll
        for (int j = 0; j < 8; ++j) { const float* p = W + (base + (size_t)j * NTHREADS) * 8; v[j][0] = *(const f32x4*)p; v[j][1] = *(const f32x4*)(p + 4); }
#pragma unroll
        for (int j = 0; j < 8; ++j) {
            h16x8 o;
#pragma unroll
            for (int e = 0; e < 4; ++e) { o[e] = (h16)v[j][0][e]; o[4 + e] = (h16)v[j][1][e]; }
            *(h16x8*)(O + (base + (size_t)j * NTHREADS) * 8) = o;
        }
    }
}
__device__ __forceinline__ void phase_moe2(const Args& a, LAS char* lds, int vcu) {
    GemmThread G; G.init();
    LAS int* mp = (LAS int*)(lds + LDS_MAP);
    moe_map(a, mp, 16);
    const h16* HID = (const h16*)(a.ws + WS_HID); const int* LIST = (const int*)(a.ws + WS_LIST); const float* WL = (const float*)(a.ws + WS_WL);
    const h16* WD16 = (const h16*)(a.ws + WS_WD16); h16* Y = (h16*)(a.ws + WS_Y);
    const int NU = mp[32];
    G3Stream S; S.gs = 0; S.primed = false;
    for (int p = vcu; p < NU; p += gridDim.x) {
        int e = 0;
        while (p >= mp[e + 1]) ++e;
        const int q = p - mp[e], cnt = mp[66 + e], ntm = (cnt + 255) >> 8, nt = q / ntm, mt = q % ntm;
        const int pn = p + (int)gridDim.x; const bool hn = pn < NU;
        const h16* nA = nullptr; const h16* nB = nullptr;
        if (hn) { int e2 = e; while (pn >= mp[e2 + 1]) ++e2;
            const int q2 = pn - mp[e2], ntm2 = (mp[66 + e2] + 255) >> 8, nt2 = q2 / ntm2, mt2 = q2 % ntm2;
            nA = HID + (size_t)(mp[33 + e2] + mt2 * 256) * DE; nB = WD16 + (size_t)e2 * DE * DM + nt2 * 128; }
        f32x4 acc[4][4];
        gemm_tile_g<false>(lds, G, HID + (size_t)(mp[33 + e] + mt * 256) * DE, DE, WD16 + (size_t)e * DE * DM + nt * 128, DM, DE / 64, acc, S, nA, nB);
        {
#pragma unroll
            for (int mi = 0; mi < 4; ++mi) {
                const int idx = mt * 256 + G.wm * 64 + mi * 16 + G.r16;
                if (idx < cnt) {
                    const int lp = moe_pos(mp, e, idx); const int slot = LIST[lp]; const float w = WL[lp];
                    h16* dst = Y + (size_t)slot * DM + nt * 128 + G.wn * 64 + 4 * G.g;
#pragma unroll
                    for (int ni = 0; ni < 4; ++ni) st4(dst + ni * 16, acc[mi][ni] * w);
                }
            }
        }
    }
}

__device__ __forceinline__ void phase_final(const Args& a) {
    const int tid = threadIdx.x, lane = tid & 63, wid = tid >> 6;
    const h16* H = (const h16*)(a.ws + WS_H); const h16* Y = (const h16*)(a.ws + WS_Y); const float* MOD = (const float*)(a.ws + WS_MOD);
    const float* w2 = a.in[I_LN2W]; const float* b2 = a.in[I_LN2B];
    for (int row = blockIdx.x * 16 + 2 * wid; row < T; row += gridDim.x * 16) {
        const int b = row >> 11;
        f32x4 v[2][8]; float s[2] = {0.f, 0.f};
#pragma unroll
        for (int j = 0; j < 8; ++j) {
            const int k = j * 256 + lane * 4;
            const f32x4 g2 = *(const f32x4*)(MOD + (size_t)b * ADAW + 5 * DM + k);
#pragma unroll
            for (int r = 0; r < 2; ++r) {
                const h16x4 h4 = *(const h16x4*)(H + (size_t)(row + r) * DM + k);
                const h16x4 y0 = *(const h16x4*)(Y + (size_t)((row + r) * 2) * DM + k), y1 = *(const h16x4*)(Y + (size_t)((row + r) * 2 + 1) * DM + k);
                f32x4 hv, yv;
#pragma unroll
                for (int e = 0; e < 4; ++e) { hv[e] = (float)h4[e]; yv[e] = (float)y0[e] + (float)y1[e]; }
                v[r][j] = hv * ALPHA + g2 * yv;
                s[r] += (v[r][j][0] + v[r][j][1]) + (v[r][j][2] + v[r][j][3]);
            }
            if (j == 3) __builtin_amdgcn_sched_barrier(0);
        }
        float mean[2], q[2] = {0.f, 0.f}, rstd[2];
#pragma unroll
        for (int r = 0; r < 2; ++r) mean[r] = wave_sum(s[r]) * (1.f / DM);
#pragma unroll
        for (int r = 0; r < 2; ++r)
#pragma unroll
            for (int j = 0; j < 8; ++j) { v[r][j] = v[r][j] - mean[r]; q[r] += (v[r][j][0] * v[r][j][0] + v[r][j][1] * v[r][j][1]) + (v[r][j][2] * v[r][j][2] + v[r][j][3] * v[r][j][3]); }
#pragma unroll
        for (int r = 0; r < 2; ++r) rstd[r] = 1.f / sqrtf(wave_sum(q[r]) * (1.f / DM) + EPS);
#pragma unroll
        for (int j = 0; j < 8; ++j) {
            const int k = j * 256 + lane * 4;
            const f32x4 lw = *(const f32x4*)(w2 + k), lb = *(const f32x4*)(b2 + k);
#pragma unroll
            for (int r = 0; r < 2; ++r) *(f32x4*)(a.out + (size_t)(row + r) * DM + k) = v[r][j] * rstd[r] * lw + lb;
        }
    }
}

constexpr int NPHASE = 13;
#ifndef REP_PHASE
#define REP_PHASE -1
#endif
#ifndef ONE_LAUNCH
#define ONE_LAUNCH 1
#endif
__global__ void __launch_bounds__(NTHREADS, 2) mega(Args a) {
    extern __shared__ __attribute__((aligned(16))) unsigned char lds_raw[];
    LAS char* lds = (LAS char*)lds_raw;
    volatile LAS unsigned* misc = (volatile LAS unsigned*)(lds + LDS_MISC);
    if (threadIdx.x < 64) misc[threadIdx.x] = 0u;
    __syncthreads();
    const int G_ = gridDim.x, bx = blockIdx.x;
    const int vcu = (G_ % 8 == 0) ? (bx % 8) * (G_ / 8) + bx / 8 : bx;
    XcdBarrier bar; bar.bar = (unsigned*)(a.ws + WS_CTL) + CW_BAR; bar.x = 0; bar.st = misc + 8;
    if (ONE_LAUNCH) bar = xcd_barrier_post((unsigned*)(a.ws + WS_CTL) + CW_BAR, misc + 8);
    const int lo = a.ph_lo, hi = a.ph_hi;
#ifndef PH_MASK
#define PH_MASK 0x1fff
#endif
#define IN(k) (((PH_MASK >> (k)) & 1) && lo <= (k) && (k) < hi)
#define SEAM(k) do { if (IN(k) && IN((k) + 1)) xcd_barrier(bar); } while (0)
    if (IN(0)) { phase_cvt(a); phase_adaln(a, lds); }
    SEAM(0);
    if (IN(1)) phase_modulate(a, lds);
    SEAM(1);
    if (IN(2)) phase_inproj(a, lds, vcu, 0);
    SEAM(2);
    if (IN(3)) phase_mid(a, lds, vcu);
    if (IN(3) && IN(4)) xcd_barrier(bar);
    if (IN(5)) phase_ret_scan(a);
    SEAM(5);
    if (IN(6)) phase_attn(a, lds, vcu);
    if (IN(7)) phase_retout(a, lds, vcu);
    SEAM(7);
    if (IN(8)) phase_oproj(a, lds, vcu);
    SEAM(8);
    if (IN(9)) phase_router(a, lds);
    SEAM(9);
    if (IN(10)) phase_moe1(a, lds, vcu);
    SEAM(10);
    if (IN(11)) phase_moe2(a, lds, vcu);
    SEAM(11);
    if (IN(12)) phase_final(a);
}

extern "C" void kernel_launch(void* const* d_in, const int* in_sizes, int n_in, void* d_out, int out_size, void* d_ws, size_t ws_size, hipStream_t stream) {
    static int grid = 0;
    if (grid == 0) {
        if (n_in != 25 || out_size != T * DM || ws_size < WS_END) { fprintf(stderr, "kernel_launch: unexpected shapes: n_in %d out %d ws %zu (need %zu)\n", n_in, out_size, ws_size, (size_t)WS_END); grid = -1; return; }
        int dev = 0, cus = 0, per_cu = 0;
        if (hipGetDevice(&dev) != hipSuccess || hipDeviceGetAttribute(&cus, hipDeviceAttributeMultiprocessorCount, dev) != hipSuccess) { grid = -1; return; }
        if (hipFuncSetAttribute((const void*)mega, hipFuncAttributeMaxDynamicSharedMemorySize, LDS_BYTES) != hipSuccess) { fprintf(stderr, "kernel_launch: hipFuncSetAttribute failed\n"); grid = -1; return; }
        if (hipOccupancyMaxActiveBlocksPerMultiprocessor(&per_cu, (const void*)mega, NTHREADS, LDS_BYTES) != hipSuccess || per_cu < 1) { fprintf(stderr, "kernel_launch: occupancy query says %d blocks per CU\n", per_cu); }
        (void)hipGetLastError();
        grid = cus;
    }
    if (grid < 0) return;
    (void)hipMemsetAsync((char*)d_ws + WS_CTL, 0, CTL_BYTES, stream);
    Args a{};
    for (int i = 0; i < 25; ++i) a.in[i] = (const float*)d_in[i];
    a.out = (float*)d_out; a.ws = (unsigned char*)d_ws;
    if (ONE_LAUNCH) {
        a.ph_lo = 0; a.ph_hi = NPHASE;
        hipLaunchKernelGGL(mega, dim3(grid), dim3(NTHREADS), LDS_BYTES, stream, a);
    } else {
        for (int p = 0; p < NPHASE; ++p) { a.ph_lo = p; a.ph_hi = p + 1;
            for (int r = 0; r < 1 + (p == REP_PHASE); ++r) {
                if (p == 9) (void)hipMemsetAsync((char*)d_ws + WS_CTL, 0, CTL_BYTES, stream);
                hipLaunchKernelGGL(mega, dim3(grid), dim3(NTHREADS), LDS_BYTES, stream, a); } }
    }
    const hipError_t le = hipPeekAtLastError();
    if (le != hipSuccess) fprintf(stderr, "kernel_launch: launch failed: %s\n", hipGetErrorName(le));
}
```

```cpp
#include <hip/hip_runtime.h>
#include <cstdio>
#include <cstdint>

#ifndef REP_MASK
#define REP_MASK 0
#endif
#define REP(k) ((REP_MASK >> (k)) & 1)
#define LAS __attribute__((address_space(3)))
#define GAS __attribute__((address_space(1)))
typedef _Float16 h16;
typedef _Float16 h16x8 __attribute__((ext_vector_type(8)));
typedef _Float16 h16x4 __attribute__((ext_vector_type(4)));
typedef _Float16 h16x2 __attribute__((ext_vector_type(2)));
typedef float f32x4 __attribute__((ext_vector_type(4)));
typedef float f32x2 __attribute__((ext_vector_type(2)));
typedef float f32x16 __attribute__((ext_vector_type(16)));
typedef unsigned u32x4 __attribute__((ext_vector_type(4)));
typedef unsigned u32x2 __attribute__((ext_vector_type(2)));
typedef short s16x4v __attribute__((__vector_size__(8)));

constexpr int DM = 2048, NB = 4, SEQ = 2048, LC = 256, LK = LC + SEQ;
constexpr int T = NB * SEQ, TCX = NB * LC, TA = T + TCX;
constexpr int INW = 4928, NEXP = 32, DE = 512;
constexpr int ADAW = 6 * DM;
constexpr float EPS = 1e-6f, ALPHA = 1.189207115002721f;
constexpr float KSCALE = 0.08838834764831845f;
constexpr float L2_10000 = 13.287712379549449f;
constexpr int NTHREADS = 512;

constexpr size_t al256(size_t x) { return (x + 255) / 256 * 256; }
constexpr size_t WS_CTL = 0, CTL_BYTES = 65536;
constexpr size_t WS_PART = WS_CTL + CTL_BYTES;
constexpr size_t WS_MOD = WS_PART + al256((size_t)8 * 5 * ADAW * 4);
constexpr size_t WS_A1 = WS_MOD + al256((size_t)5 * ADAW * 4);
constexpr size_t WS_QR = WS_A1 + al256((size_t)TA * DM * 2);
constexpr size_t WS_KR = WS_QR + al256((size_t)T * 1024 * 2);
constexpr size_t WS_VR = WS_KR + al256((size_t)T * 1024 * 2);
constexpr size_t WS_KC = WS_VR + al256((size_t)T * 1024 * 2);
constexpr size_t WS_VC = WS_KC + al256((size_t)TCX * 1024 * 2);
constexpr size_t WS_GS = WS_VC + al256((size_t)TCX * 1024 * 2);
constexpr size_t WS_CQ = WS_GS + al256((size_t)T * 1024 * 2);
constexpr size_t WS_CKV = WS_CQ + al256((size_t)T * 512 * 2);
constexpr size_t WS_KPE = WS_CKV + al256((size_t)NB * LK * 256 * 2);
constexpr size_t WS_Q = WS_KPE + al256((size_t)NB * LK * 64 * 2);
constexpr size_t WS_KN = WS_Q + al256((size_t)T * 1536 * 2);
constexpr size_t WS_VV = WS_KN + al256((size_t)NB * 8 * LK * 128 * 2);
constexpr size_t WS_UF = WS_VV + al256((size_t)NB * 8 * LK * 128 * 2);
constexpr size_t WS_UB = WS_UF + al256((size_t)32 * 16 * 16384 * 4);
constexpr size_t WS_S0F = WS_UB + al256((size_t)32 * 16 * 16384 * 4);
constexpr size_t WS_S0B = WS_S0F + al256((size_t)32 * 16384 * 4);
constexpr size_t WS_SF = WS_S0B + al256((size_t)32 * 16384 * 4);
constexpr size_t WS_SB = WS_SF + al256((size_t)32 * 16 * 16384 * 2);
constexpr size_t WS_MIX = WS_SB + al256((size_t)32 * 16 * 16384 * 2);
constexpr size_t WS_U = WS_MIX + al256((size_t)T * DM * 2);
constexpr size_t WS_H = WS_U + al256((size_t)T * DM * 2);
constexpr size_t WS_A2 = WS_H + al256((size_t)T * DM * 2);
constexpr int SUBCAP = 2048;
constexpr size_t WS_LIST = WS_A2 + al256((size_t)T * DM * 2);
constexpr size_t WS_WL = WS_LIST + al256((size_t)NEXP * 8 * SUBCAP * 4);
constexpr int HID_ROWS = 2 * T + NEXP * 256;
constexpr size_t WS_HID = WS_WL + al256((size_t)NEXP * 8 * SUBCAP * 4);
constexpr size_t WS_Y = WS_HID + al256((size_t)HID_ROWS * DE * 2);
constexpr int WINP = 5120;
constexpr size_t WS_WIN16 = WS_Y + al256((size_t)2 * T * DM * 2);
constexpr size_t WS_WO16 = WS_WIN16 + al256((size_t)DM * WINP * 2);
constexpr size_t WS_WUQ16 = WS_WO16 + al256((size_t)DM * DM * 2);
constexpr size_t WS_WUKV16 = WS_WUQ16 + al256((size_t)512 * 1536 * 2);
constexpr size_t WS_WRH = WS_WUKV16 + al256((size_t)256 * 2048 * 2);
constexpr size_t WS_WRL = WS_WRH + al256((size_t)48 * DM * 2);
constexpr size_t WS_WD16 = WS_WRL + al256((size_t)48 * DM * 2);
constexpr size_t WS_END = WS_WD16 + al256((size_t)NEXP * DE * DM * 2);

constexpr int CW_CNT = 256;
constexpr int CW_POOL = 128;
constexpr int CW_BAR = 1024;

constexpr int LDS_BYTES = 151808;
constexpr int LDS_ROWS = 147456;
constexpr int LDS_MAP = 148480;
constexpr int LDS_MISC = 151552;

template <int M> __device__ __forceinline__ float swz_xor(float v) {
    return __int_as_float(__builtin_amdgcn_ds_swizzle(__float_as_int(v), 0x1F | (M << 10)));
}
__device__ __forceinline__ float wave_sum(float v) {
    v += swz_xor<1>(v); v += swz_xor<2>(v); v += swz_xor<4>(v); v += swz_xor<8>(v); v += swz_xor<16>(v);
    { auto rr = __builtin_amdgcn_permlane32_swap(__float_as_uint(v), __float_as_uint(v), false, false); v = __uint_as_float(rr[0]) + __uint_as_float(rr[1]); }
    return v;
}
__device__ __forceinline__ float silu_f(float x) { return x / (1.f + __expf(-x)); }
__device__ __forceinline__ h16x4 cvt4(f32x4 v) { h16x4 r; r[0] = (h16)v[0]; r[1] = (h16)v[1]; r[2] = (h16)v[2]; r[3] = (h16)v[3]; return r; }
__device__ __forceinline__ h16x4 trrd(LAS char* p) { s16x4v t = __builtin_amdgcn_ds_read_tr16_b64_v4i16((LAS s16x4v*)p); return __builtin_bit_cast(h16x4, t); }
__device__ __forceinline__ h16x8 cat8(h16x4 a, h16x4 b) { return __builtin_shufflevector(a, b, 0, 1, 2, 3, 4, 5, 6, 7); }
__device__ __forceinline__ f32x4 mfma16(h16x8 a, h16x8 b, f32x4 c) { return __builtin_amdgcn_mfma_f32_16x16x32_f16(a, b, c, 0, 0, 0); }

__device__ __forceinline__ int a_off(int row, int ch) { return row * 128 + ((ch ^ (row & 7)) << 4); }
__device__ __forceinline__ int off_b(int row, int ch) { return 256 * row + 16 * (ch ^ (((row & 3) << 2) | ((row >> 2) & 3))); }
__device__ __forceinline__ int tr_addr16(int lane, int c, int ks, int t) {
    const int g = lane >> 4, q = (lane & 15) >> 2, p = lane & 3;
    return off_b(32 * ks + 8 * g + 4 * t + q, 2 * c + (p >> 1)) + 8 * (p & 1);
}
__device__ __forceinline__ int row_addr16(int lane, int rb, int s) { return off_b((lane & 15) + 16 * rb, 4 * s + (lane >> 4)); }

#define XB_TMO      128
#define XB_XCNT(j)  (256  + 64 * (j))
#define XB_XSUB(j)  (1280 + 64 * (j))
#define XB_XGEN(j)  (2304 + 64 * (j))
#define XB_TOP      3328
#define XB_TOPGEN   3392
#define XCD_BAR_WORDS 3456
#define XB_SPIN_CAP (1u << 22)
__device__ __forceinline__ unsigned xb_ld(unsigned* p)              { return __hip_atomic_load(p, __ATOMIC_RELAXED, __HIP_MEMORY_SCOPE_AGENT); }
__device__ __forceinline__ unsigned xb_add(unsigned* p, unsigned v) { return __hip_atomic_fetch_add(p, v, __ATOMIC_RELAXED, __HIP_MEMORY_SCOPE_AGENT); }
__device__ __forceinline__ unsigned xb_xcc_id() { return (unsigned)__builtin_amdgcn_s_getreg((3 << 11) | 20) & 0xFu; }
#define XB_SPIN(cond, bar) do { unsigned _sp = 0; while (cond) { __builtin_amdgcn_s_sleep(1); \
    if ((++_sp & 255u) == 0u) { if (xb_ld(&(bar)[XB_TMO])) break; if (_sp > XB_SPIN_CAP) { atomicAdd(&(bar)[XB_TMO], 1u); break; } } } } while (0)
struct XcdBarrier { unsigned* bar; unsigned x; volatile LAS unsigned* st; };
__device__ __forceinline__ XcdBarrier xcd_barrier_post(unsigned* bar, volatile LAS unsigned* st) {
    XcdBarrier b; b.bar = bar; b.x = xb_xcc_id(); b.st = st;
    if (threadIdx.x == 0) (void)xb_add(&bar[XB_XCNT(b.x)], 1u);
    return b;
}
__device__ __forceinline__ void xcd_barrier_complete(unsigned* bar, unsigned x, unsigned& nloc, unsigned& nx) {
    const unsigned G = gridDim.x * gridDim.y * gridDim.z;
    unsigned sum, cnt, mine, sp = 0u;
    for (;;) {
        sum = 0u; cnt = 0u; mine = 0u;
#pragma unroll
        for (unsigned j = 0; j < 16; ++j) { const unsigned c = xb_ld(&bar[XB_XCNT(j)]); sum += c; cnt += (c > 0u) ? 1u : 0u; mine = (j == x) ? c : mine; }
        if (sum == G) break;
        __builtin_amdgcn_s_sleep(1);
        if ((++sp & 255u) == 0u) { if (xb_ld(&bar[XB_TMO])) break; if (sp > XB_SPIN_CAP) { atomicAdd(&bar[XB_TMO], 1u); break; } }
    }
    nloc = mine > 0u ? mine : 1u; nx = cnt > 0u ? cnt : 1u;
}
__device__ __forceinline__ void xcd_barrier(const XcdBarrier& b) {
    asm volatile("s_waitcnt vmcnt(0)" ::: "memory");
    __syncthreads();
    if (threadIdx.x == 0) {
        unsigned* bar = b.bar;
        __builtin_amdgcn_s_waitcnt(0);
        unsigned nloc = b.st[0], nx = b.st[1];
        if (nloc == 0u) { xcd_barrier_complete(bar, b.x, nloc, nx); b.st[0] = nloc; b.st[1] = nx; }
        const unsigned old = xb_add(&bar[XB_XSUB(b.x)], 1u);
        const unsigned gen = old / nloc;
        if (old + 1u == (gen + 1u) * nloc) {
            __builtin_amdgcn_fence(__ATOMIC_RELEASE, "agent");
            asm volatile("s_waitcnt vmcnt(0)" ::: "memory");
            const unsigned og = xb_add(&bar[XB_TOP], 1u);
            const unsigned tg = og / nx;
            if (og + 1u == (tg + 1u) * nx) xb_add(&bar[XB_TOPGEN], 1u);
            else XB_SPIN(xb_ld(&bar[XB_TOPGEN]) == tg, bar);
            __builtin_amdgcn_fence(__ATOMIC_ACQUIRE, "agent");
            xb_add(&bar[XB_XGEN(b.x)], 1u);
            asm volatile("s_waitcnt vmcnt(0)" ::: "memory");
        } else {
            XB_SPIN(xb_ld(&bar[XB_XGEN(b.x)]) == gen, bar);
            __builtin_amdgcn_fence(__ATOMIC_ACQUIRE, "agent");
            asm volatile("s_waitcnt vmcnt(0)" ::: "memory");
        }
    }
    __syncthreads();
}

struct Args {
    const float* in[25];
    float* out;
    unsigned char* ws;
    int ph_lo, ph_hi;
};
enum { I_X = 0, I_C, I_CTX, I_CCTX, I_WADA, I_BADA, I_WIN, I_RDEC, I_RGN, I_QNORM, I_KVNORM, I_WUQ, I_WUKV, I_WO, I_LN1W, I_LN1B,
       I_RGW, I_RGB, I_REW, I_REB, I_EWG, I_EWU, I_EWD, I_LN2W, I_LN2B };

__device__ __forceinline__ void wdown_pool(const Args& a, LAS char* lds, int budget);
constexpr int GEMM_STAGE = 49152, GEMM_ROWS_OFF = LDS_ROWS;
struct GemmThread {
    int tid, lane, wid, wm, wn, r16, g;
    int a_st;
    int b_st;
    int ta[2];
    int tb[4][2];
    __device__ __forceinline__ void init(bool opaque = false) {
        tid = threadIdx.x; if (opaque) asm volatile("" : "+v"(tid));
        lane = tid & 63; wid = __builtin_amdgcn_readfirstlane(tid >> 6); wm = wid >> 1; wn = wid & 1; r16 = lane & 15; g = lane >> 4;
        a_st = a_off(tid >> 3, tid & 7);
        const int nq = tid & 31, kk = tid >> 5;
        b_st = off_b(kk, nq >> 1) + (nq & 1) * 8;
#pragma unroll
        for (int ks = 0; ks < 2; ++ks) ta[ks] = a_off(wm * 64 + r16, ks * 4 + g);
#pragma unroll
        for (int ni = 0; ni < 4; ++ni)
#pragma unroll
            for (int t = 0; t < 2; ++t) tb[ni][t] = tr_addr16(lane, wn * 4 + ni, 0, t);
    }
};

typedef _Float16 h16x2v __attribute__((ext_vector_type(2)));
__device__ __forceinline__ h16x8 fp8x8_to_h16(unsigned w0, unsigned w1) {
    const h16x2v a = __builtin_amdgcn_cvt_scalef32_pk_f16_fp8((int)w0, 1.0f, false), b = __builtin_amdgcn_cvt_scalef32_pk_f16_fp8((int)w0, 1.0f, true);
    const h16x2v c = __builtin_amdgcn_cvt_scalef32_pk_f16_fp8((int)w1, 1.0f, false), d = __builtin_amdgcn_cvt_scalef32_pk_f16_fp8((int)w1, 1.0f, true);
    h16x8 r; r[0] = a[0]; r[1] = a[1]; r[2] = b[0]; r[3] = b[1]; r[4] = c[0]; r[5] = c[1]; r[6] = d[0]; r[7] = d[1];
    return r;
}
__device__ __forceinline__ void gemm_tile(LAS char* lds, const GemmThread& G, const unsigned char* const (&arow)[2], const float* bcol, size_t ldb,
                                          int nk, f32x4 (&acc)[4][4]) {
#pragma unroll
    for (int i = 0; i < 4; ++i)
#pragma unroll
        for (int j = 0; j < 4; ++j) acc[i][j] = (f32x4){0.f, 0.f, 0.f, 0.f};
    u32x4 ar0[2], ar1[2]; f32x4 br0[4], br1[4];
    const int aq0 = a_off(G.tid >> 2, 2 * (G.tid & 3)), aq1 = a_off(G.tid >> 2, 2 * (G.tid & 3) + 1);
#define GT_LOAD(AR, BR, kt) do { _Pragma("unroll") for (int i = 0; i < 2; ++i) AR[i] = *(const u32x4*)(arow[i] + (size_t)(kt) * 64); \
        _Pragma("unroll") for (int i = 0; i < 4; ++i) BR[i] = *(const f32x4*)(bcol + (size_t)((kt) * 64 + 16 * i) * ldb); } while (0)
#define GT_STORE(AR, BR, buf) do { LAS char* Ab_ = lds + (buf) * GEMM_STAGE; _Pragma("unroll") for (int i = 0; i < 2; ++i) { \
        *(LAS h16x8*)(Ab_ + aq0 + i * 16384) = fp8x8_to_h16(AR[i][0], AR[i][1]); *(LAS h16x8*)(Ab_ + aq1 + i * 16384) = fp8x8_to_h16(AR[i][2], AR[i][3]); } \
        _Pragma("unroll") for (int i = 0; i < 4; ++i) *(LAS h16x4*)(Ab_ + 32768 + G.b_st + i * 4096) = cvt4(BR[i]); } while (0)
#define GT_COMP(buf) do { LAS char* Ab = lds + (buf) * GEMM_STAGE; LAS char* Bb = Ab + 32768; \
        _Pragma("unroll") for (int ks = 0; ks < 2; ++ks) { h16x8 bf[4], af[4]; \
            _Pragma("unroll") for (int ni = 0; ni < 4; ++ni) bf[ni] = cat8(trrd(Bb + G.tb[ni][0] + ks * 8192), trrd(Bb + G.tb[ni][1] + ks * 8192)); \
            _Pragma("unroll") for (int mi = 0; mi < 4; ++mi) af[mi] = *(LAS h16x8*)(Ab + G.ta[ks] + mi * 2048); \
            _Pragma("unroll") for (int mi = 0; mi < 4; ++mi) _Pragma("unroll") for (int ni = 0; ni < 4; ++ni) acc[mi][ni] = mfma16(bf[ni], af[mi], acc[mi][ni]); } } while (0)
    __syncthreads();
    GT_LOAD(ar0, br0, 0);
    GT_LOAD(ar1, br1, 1);
    GT_STORE(ar0, br0, 0);
    __syncthreads();
    int kt = 0;
    for (; kt + 2 < nk; kt += 2) {
        GT_LOAD(ar0, br0, kt + 2); __builtin_amdgcn_sched_barrier(0);
        GT_COMP(0); __builtin_amdgcn_sched_barrier(0);
        GT_STORE(ar1, br1, 1);
        __syncthreads();
        GT_LOAD(ar1, br1, kt + 3); __builtin_amdgcn_sched_barrier(0);
        GT_COMP(1); __builtin_amdgcn_sched_barrier(0);
        GT_STORE(ar0, br0, 0);
        __syncthreads();
    }
    GT_COMP(0);
    GT_STORE(ar1, br1, 1);
    __syncthreads();
    GT_COMP(1);
#undef GT_LOAD
#undef GT_STORE
#undef GT_COMP
}

typedef short s16x4 __attribute__((ext_vector_type(4)));
template <int OFF> __device__ __forceinline__ s16x4 asm_tr(int addr) { s16x4 r; asm volatile("ds_read_b64_tr_b16 %0, %1 offset:%2" : "=v"(r) : "v"(addr), "i"(OFF) : "memory"); return r; }
template <int OFF> __device__ __forceinline__ h16x8 asm_rd128(int addr) { h16x8 r; asm volatile("ds_read_b128 %0, %1 offset:%2" : "=v"(r) : "v"(addr), "i"(OFF) : "memory"); return r; }
#define LGKM0() do { asm volatile("s_waitcnt lgkmcnt(0)" ::: "memory"); __builtin_amdgcn_sched_barrier(0); } while (0)
__device__ __forceinline__ h16x8 cat8s(s16x4 a, s16x4 b) { return __builtin_bit_cast(h16x8, __builtin_shufflevector(a, b, 0, 1, 2, 3, 4, 5, 6, 7)); }
struct G3Stream { int gs; bool primed; };
template <bool RMS>
__device__ __forceinline__ void gemm_tile_g(LAS char* lds, const GemmThread& G, const h16* Ab, int lda, const h16* Bb, int ldb, int nk, f32x4 (&acc)[4][4],
                                            G3Stream& S, const h16* nAb, const h16* nBb) {
#pragma unroll
    for (int i = 0; i < 4; ++i)
#pragma unroll
        for (int j = 0; j < 4; ++j) acc[i][j] = (f32x4){0.f, 0.f, 0.f, 0.f};
    float ss[4] = {0.f, 0.f, 0.f, 0.f};
    const size_t a_i = (size_t)64 * lda, b_i = (size_t)32 * ldb, b_k = (size_t)64 * ldb;
    const size_t lane_a = (size_t)(8 * G.wid + (G.lane >> 3)) * lda + (((G.lane & 7) ^ (G.lane >> 3)) << 3);
    const size_t lane_b = (size_t)(4 * G.wid + (G.lane >> 4)) * ldb + (((G.lane & 15) ^ (((G.lane >> 4) << 2) | (G.wid & 3))) << 3);
    const bool has_next = (nAb != nullptr);
    const h16* asrc = Ab + lane_a; const h16* bsrc = Bb + lane_b;
    const h16* nasrc = (has_next ? nAb : Ab) + lane_a; const h16* nbsrc = (has_next ? nBb : Bb) + lane_b;
    LAS char* wbase = lds + G.wid * 1024;
    const int lbase = (int)(uintptr_t)lds;
#define G3_ISSUE_(AS, BS, kt, st) do { LAS char* sb_ = wbase + (st) * GEMM_STAGE; \
        _Pragma("unroll") for (int i = 0; i < 4; ++i) __builtin_amdgcn_global_load_lds((const unsigned*)((AS) + i * a_i + (size_t)(kt) * 64), (LAS unsigned*)(sb_ + i * 8192), 16, 0, 0); \
        _Pragma("unroll") for (int i = 0; i < 2; ++i) __builtin_amdgcn_global_load_lds((const unsigned*)((BS) + i * b_i + (size_t)(kt) * b_k), (LAS unsigned*)(sb_ + 32768 + i * 8192), 16, 0, 0); } while (0)
#define G3_ISSUE(kt, st) G3_ISSUE_(asrc, bsrc, kt, st)
#define G3_READ(BF, AF, KS) do { \
        BF[0] = cat8s(asm_tr<32768 + (KS) * 8192>(sbase + G.tb[0][0]), asm_tr<32768 + (KS) * 8192>(sbase + G.tb[0][1])); \
        BF[1] = cat8s(asm_tr<32768 + (KS) * 8192>(sbase + G.tb[1][0]), asm_tr<32768 + (KS) * 8192>(sbase + G.tb[1][1])); \
        BF[2] = cat8s(asm_tr<32768 + (KS) * 8192>(sbase + G.tb[2][0]), asm_tr<32768 + (KS) * 8192>(sbase + G.tb[2][1])); \
        BF[3] = cat8s(asm_tr<32768 + (KS) * 8192>(sbase + G.tb[3][0]), asm_tr<32768 + (KS) * 8192>(sbase + G.tb[3][1])); \
        AF[0] = asm_rd128<0>(sbase + G.ta[KS]); AF[1] = asm_rd128<2048>(sbase + G.ta[KS]); AF[2] = asm_rd128<4096>(sbase + G.ta[KS]); AF[3] = asm_rd128<6144>(sbase + G.ta[KS]); } while (0)
#define G3_MMA(BF, AF) do { _Pragma("unroll") for (int mi = 0; mi < 4; ++mi) _Pragma("unroll") for (int ni = 0; ni < 4; ++ni) acc[mi][ni] = mfma16(BF[ni], AF[mi], acc[mi][ni]); } while (0)
    int sc = S.gs, si = (S.gs == 0) ? 2 : S.gs - 1;
    if (!S.primed) {
        asm volatile("s_waitcnt vmcnt(0)" ::: "memory");
        __builtin_amdgcn_s_barrier();
        asm volatile("" ::: "memory");
        G3_ISSUE(0, sc);
        G3_ISSUE(1, (sc == 2) ? 0 : sc + 1);
    }
    for (int kt = 0; kt < nk; ++kt) {
        if ((kt == 0 && S.primed) || !(kt + 1 < nk || has_next)) asm volatile("s_waitcnt vmcnt(0)" ::: "memory"); else asm volatile("s_waitcnt vmcnt(6)" ::: "memory");
        __builtin_amdgcn_s_barrier();
        asm volatile("" ::: "memory");
        if (kt + 2 < nk) G3_ISSUE(kt + 2, si);
        else if (has_next) G3_ISSUE_(nasrc, nbsrc, kt + 2 - nk, si);
        const int sbase = lbase + sc * GEMM_STAGE;
        h16x8 bf0[4], af0[4], bf1[4], af1[4];
        G3_READ(bf0, af0, 0);
        if (RMS) {
            h16x8 hv[4];
            hv[0] = asm_rd128<0>(sbase + G.a_st); hv[1] = asm_rd128<8192>(sbase + G.a_st); hv[2] = asm_rd128<16384>(sbase + G.a_st); hv[3] = asm_rd128<24576>(sbase + G.a_st);
            LGKM0();
#pragma unroll
            for (int i = 0; i < 4; ++i)
#pragma unroll
                for (int e = 0; e < 8; ++e) { const float f = (float)hv[i][e]; ss[i] += f * f; }
        } else LGKM0();
        G3_READ(bf1, af1, 1);
        G3_MMA(bf0, af0);
        LGKM0();
        G3_MMA(bf1, af1);
        sc = (sc == 2) ? 0 : sc + 1; si = (si == 2) ? 0 : si + 1;
    }
#undef G3_ISSUE
#undef G3_ISSUE_
#undef G3_READ
#undef G3_MMA
    S.gs = sc; S.primed = has_next;
    if (RMS) {
        LAS float* rs = (LAS float*)(lds + GEMM_ROWS_OFF);
#pragma unroll
        for (int i = 0; i < 4; ++i) {
            float s = ss[i]; s += __shfl_xor(s, 1); s += __shfl_xor(s, 2); s += __shfl_xor(s, 4);
            if ((G.tid & 7) == 0) rs[(G.tid >> 3) + 64 * i] = __builtin_amdgcn_rsqf(s / (float)(nk * 64) + EPS);
        }
        asm volatile("s_waitcnt lgkmcnt(0)" ::: "memory");
        __builtin_amdgcn_s_barrier();
        asm volatile("" ::: "memory");
    }
}

constexpr int G2_STAGE = 65536;
struct GemmThread2 {
    int tid, lane, wid, wm, wn, r16, g;
    int ta[2];
    int tb[4][2];
    __device__ __forceinline__ void init() {
        tid = threadIdx.x; lane = tid & 63; wid = __builtin_amdgcn_readfirstlane(tid >> 6); wm = wid >> 2; wn = wid & 3; r16 = lane & 15; g = lane >> 4;
#pragma unroll
        for (int ks = 0; ks < 2; ++ks) ta[ks] = a_off(wm * 128 + r16, ks * 4 + g);
#pragma unroll
        for (int ni = 0; ni < 4; ++ni)
#pragma unroll
            for (int t = 0; t < 2; ++t) tb[ni][t] = 32768 + (wn >> 1) * 16384 + tr_addr16(lane, (wn & 1) * 4 + ni, 0, t);
    }
};
__device__ __forceinline__ void gemm_tile_g2(LAS char* lds, const GemmThread2& G, const h16* Ab, int lda, const h16* Bb, int ldb, int nk, f32x4 (&acc)[8][4]) {
#pragma unroll
    for (int i = 0; i < 8; ++i)
#pragma unroll
        for (int j = 0; j < 4; ++j) acc[i][j] = (f32x4){0.f, 0.f, 0.f, 0.f};
    const h16* asrc = Ab + (size_t)(8 * G.wid + (G.lane >> 3)) * lda + (((G.lane & 7) ^ (G.lane >> 3)) << 3);
    const h16* bsrc = Bb + (size_t)(4 * G.wid + (G.lane >> 4)) * ldb + (((G.lane & 15) ^ (((G.lane >> 4) << 2) | (G.wid & 3))) << 3);
    const size_t a_i = (size_t)64 * lda, b_i = (size_t)32 * ldb, b_k = (size_t)64 * ldb;
    LAS char* wbase = lds + G.wid * 1024;
    const int lbase = (int)(uintptr_t)lds;
#define G2_ISSUE(kt, st) do { LAS char* sb_ = wbase + (st) * G2_STAGE; \
        _Pragma("unroll") for (int i = 0; i < 4; ++i) __builtin_amdgcn_global_load_lds((const unsigned*)(asrc + i * a_i + (size_t)(kt) * 64), (LAS unsigned*)(sb_ + i * 8192), 16, 0, 0); \
        _Pragma("unroll") for (int i = 0; i < 4; ++i) __builtin_amdgcn_global_load_lds((const unsigned*)(bsrc + (i & 1) * b_i + (i >> 1) * 128 + (size_t)(kt) * b_k), (LAS unsigned*)(sb_ + 32768 + (i >> 1) * 16384 + (i & 1) * 8192), 16, 0, 0); } while (0)
#define G2_RB(BF, KS) do { \
        BF[0] = cat8s(asm_tr<(KS) * 8192>(sbase + G.tb[0][0]), asm_tr<(KS) * 8192>(sbase + G.tb[0][1])); \
        BF[1] = cat8s(asm_tr<(KS) * 8192>(sbase + G.tb[1][0]), asm_tr<(KS) * 8192>(sbase + G.tb[1][1])); \
        BF[2] = cat8s(asm_tr<(KS) * 8192>(sbase + G.tb[2][0]), asm_tr<(KS) * 8192>(sbase + G.tb[2][1])); \
        BF[3] = cat8s(asm_tr<(KS) * 8192>(sbase + G.tb[3][0]), asm_tr<(KS) * 8192>(sbase + G.tb[3][1])); } while (0)
#define G2_RA(AF, KS, H) do { AF[0] = asm_rd128<(H) * 8192>(sbase + G.ta[KS]); AF[1] = asm_rd128<(H) * 8192 + 2048>(sbase + G.ta[KS]); \
        AF[2] = asm_rd128<(H) * 8192 + 4096>(sbase + G.ta[KS]); AF[3] = asm_rd128<(H) * 8192 + 6144>(sbase + G.ta[KS]); } while (0)
#define G2_MMA(BF, AF, H) do { _Pragma("unroll") for (int mi = 0; mi < 4; ++mi) _Pragma("unroll") for (int ni = 0; ni < 4; ++ni) \
        acc[(H) * 4 + mi][ni] = mfma16(BF[ni], AF[mi], acc[(H) * 4 + mi][ni]); } while (0)
    asm volatile("s_waitcnt vmcnt(0)" ::: "memory");
    __builtin_amdgcn_s_barrier();
    asm volatile("" ::: "memory");
    G2_ISSUE(0, 0);
    for (int kt = 0; kt < nk; ++kt) {
        asm volatile("s_waitcnt vmcnt(0)" ::: "memory");
        __builtin_amdgcn_s_barrier();
        asm volatile("" ::: "memory");
        if (kt + 1 < nk) G2_ISSUE(kt + 1, (kt + 1) & 1);
        const int sbase = lbase + (kt & 1) * G2_STAGE;
        h16x8 bf0[4], bf1[4], afx[4], afy[4];
        G2_RB(bf0, 0); G2_RA(afx, 0, 0);
        LGKM0();
        G2_RA(afy, 0, 1); G2_RB(bf1, 1);
        G2_MMA(bf0, afx, 0);
        LGKM0();
        G2_RA(afx, 1, 0);
        G2_MMA(bf0, afy, 1);
        LGKM0();
        G2_RA(afy, 1, 1);
        G2_MMA(bf1, afx, 0);
        LGKM0();
        G2_MMA(bf1, afy, 1);
    }
#undef G2_ISSUE
#undef G2_RB
#undef G2_RA
#undef G2_MMA
}

template <int OFF> __device__ __forceinline__ u32x2 asm_rd64(int addr) { u32x2 r; asm volatile("ds_read_b64 %0, %1 offset:%2" : "=v"(r) : "v"(addr), "i"(OFF) : "memory"); return r; }
__device__ __forceinline__ void gemm_tile_g8(LAS char* lds, const GemmThread& G, const unsigned char* Ab, int lda, const h16* Bb, int ldb, int nk, f32x4 (&acc)[4][4],
                                             G3Stream& S, const unsigned char* nAb, const h16* nBb) {
#pragma unroll
    for (int i = 0; i < 4; ++i)
#pragma unroll
        for (int j = 0; j < 4; ++j) acc[i][j] = (f32x4){0.f, 0.f, 0.f, 0.f};
    const size_t a_i = (size_t)128 * 64, b_i = (size_t)32 * ldb, b_k = (size_t)64 * ldb;
    const size_t lane_a = (size_t)(16 * G.wid + (G.lane >> 2)) * 64 + (((G.lane & 3) ^ ((G.lane >> 4) & 3)) << 4);
    const size_t lane_b = (size_t)(4 * G.wid + (G.lane >> 4)) * ldb + (((G.lane & 15) ^ (((G.lane >> 4) << 2) | (G.wid & 3))) << 3);
    const bool has_next = (nAb != nullptr);
    const unsigned char* asrc = Ab + lane_a; const h16* bsrc = Bb + lane_b;
    const unsigned char* nasrc = (has_next ? nAb : Ab) + lane_a; const h16* nbsrc = (has_next ? nBb : Bb) + lane_b;
    LAS char* wbase = lds + G.wid * 1024;
    const int lbase = (int)(uintptr_t)lds;
    int ta8[2];
    { const int x2 = 2 * ((G.r16 >> 2) & 3);
#pragma unroll
      for (int ks = 0; ks < 2; ++ks) ta8[ks] = (G.wm * 64 + G.r16) * 64 + (((4 * ks + G.g) ^ x2) << 3); }
#define G8_ISSUE_(AS, BS, kt, st) do { LAS char* sb_ = wbase + (st) * GEMM_STAGE; \
        _Pragma("unroll") for (int i = 0; i < 2; ++i) __builtin_amdgcn_global_load_lds((const unsigned*)((AS) + i * a_i + (size_t)(kt) * 16384), (LAS unsigned*)(sb_ + i * 8192), 16, 0, 0); \
        _Pragma("unroll") for (int i = 0; i < 2; ++i) __builtin_amdgcn_global_load_lds((const unsigned*)((BS) + i * b_i + (size_t)(kt) * b_k), (LAS unsigned*)(sb_ + 32768 + i * 8192), 16, 0, 0); } while (0)
#define G8_ISSUE(kt, st) G8_ISSUE_(asrc, bsrc, kt, st)
#define G8_READ(BF, AR, KS) do { \
        BF[0] = cat8s(asm_tr<32768 + (KS) * 8192>(sbase + G.tb[0][0]), asm_tr<32768 + (KS) * 8192>(sbase + G.tb[0][1])); \
        BF[1] = cat8s(asm_tr<32768 + (KS) * 8192>(sbase + G.tb[1][0]), asm_tr<32768 + (KS) * 8192>(sbase + G.tb[1][1])); \
        BF[2] = cat8s(asm_tr<32768 + (KS) * 8192>(sbase + G.tb[2][0]), asm_tr<32768 + (KS) * 8192>(sbase + G.tb[2][1])); \
        BF[3] = cat8s(asm_tr<32768 + (KS) * 8192>(sbase + G.tb[3][0]), asm_tr<32768 + (KS) * 8192>(sbase + G.tb[3][1])); \
        AR[0] = asm_rd64<0>(sbase + ta8[KS]); AR[1] = asm_rd64<1024>(sbase + ta8[KS]); AR[2] = asm_rd64<2048>(sbase + ta8[KS]); AR[3] = asm_rd64<3072>(sbase + ta8[KS]); } while (0)
#define G8_MMA(BF, AR) do { h16x8 af_[4]; _Pragma("unroll") for (int mi = 0; mi < 4; ++mi) af_[mi] = fp8x8_to_h16(AR[mi][0], AR[mi][1]); \
        _Pragma("unroll") for (int mi = 0; mi < 4; ++mi) _Pragma("unroll") for (int ni = 0; ni < 4; ++ni) acc[mi][ni] = mfma16(BF[ni], af_[mi], acc[mi][ni]); } while (0)
    int sc = S.gs, si = (S.gs == 0) ? 2 : S.gs - 1;
    if (!S.primed) {
        asm volatile("s_waitcnt vmcnt(0)" ::: "memory");
        __builtin_amdgcn_s_barrier();
        asm volatile("" ::: "memory");
        G8_ISSUE(0, sc);
        G8_ISSUE(1, (sc == 2) ? 0 : sc + 1);
    }
    for (int kt = 0; kt < nk; ++kt) {
        if ((kt == 0 && S.primed) || !(kt + 1 < nk || has_next)) asm volatile("s_waitcnt vmcnt(0)" ::: "memory"); else asm volatile("s_waitcnt vmcnt(4)" ::: "memory");
        __builtin_amdgcn_s_barrier();
        asm volatile("" ::: "memory");
        if (kt + 2 < nk) G8_ISSUE(kt + 2, si);
        else if (has_next) G8_ISSUE_(nasrc, nbsrc, kt + 2 - nk, si);
        const int sbase = lbase + sc * GEMM_STAGE;
        h16x8 bf0[4], bf1[4]; u32x2 ar0[4], ar1[4];
        G8_READ(bf0, ar0, 0);
        LGKM0();
        G8_READ(bf1, ar1, 1);
        G8_MMA(bf0, ar0);
        LGKM0();
        G8_MMA(bf1, ar1);
        sc = (sc == 2) ? 0 : sc + 1; si = (si == 2) ? 0 : si + 1;
    }
#undef G8_ISSUE
#undef G8_ISSUE_
#undef G8_READ
#undef G8_MMA
    S.gs = sc; S.primed = has_next;
}

__device__ __forceinline__ void cvt_weight(const float* W, const float* rowscale, h16* O, int K, int N, int NP, int gtid, int gthreads) {
    const int cpr = NP >> 3;
    for (int idx = gtid; idx < K * cpr; idx += gthreads) {
        const int k = idx / cpr, c = (idx - k * cpr) << 3;
        h16x8 o;
        if (c < N) {
            f32x4 v0 = *(const f32x4*)(W + (size_t)k * N + c), v1 = *(const f32x4*)(W + (size_t)k * N + c + 4);
            if (rowscale) { const float r = rowscale[k]; v0 = v0 * r; v1 = v1 * r; }
#pragma unroll
            for (int e = 0; e < 4; ++e) { o[e] = (h16)v0[e]; o[4 + e] = (h16)v1[e]; }
        } else {
#pragma unroll
            for (int e = 0; e < 8; ++e) o[e] = (h16)0.f;
        }
        *(h16x8*)(O + (size_t)k * NP + c) = o;
    }
}
__device__ __forceinline__ void phase_cvt(const Args& a) {
    const int gtid = blockIdx.x * NTHREADS + threadIdx.x, gth = gridDim.x * NTHREADS;
    cvt_weight(a.in[I_WIN], nullptr, (h16*)(a.ws + WS_WIN16), DM, INW, WINP, gtid, gth);
    cvt_weight(a.in[I_WO], nullptr, (h16*)(a.ws + WS_WO16), DM, DM, DM, gtid, gth);
    cvt_weight(a.in[I_WUQ], a.in[I_QNORM], (h16*)(a.ws + WS_WUQ16), 512, 1536, 1536, gtid, gth);
    cvt_weight(a.in[I_WUKV], a.in[I_KVNORM], (h16*)(a.ws + WS_WUKV16), 256, 2048, 2048, gtid, gth);
    h16* WRH = (h16*)(a.ws + WS_WRH); h16* WRL = (h16*)(a.ws + WS_WRL);
    for (int idx = gtid; idx < 48 * DM; idx += gth) {
        const int n = idx / DM, k = idx - n * DM;
        float w = 0.f;
        if (n < 4) w = a.in[I_RGW][k * 4 + n];
        else if (n < 36) w = a.in[I_REW][(size_t)((n - 4) >> 3) * DM * 8 + (size_t)k * 8 + ((n - 4) & 7)];
        w *= 1024.f;
        const h16 hi = (h16)w; const h16 lo = (h16)(w - (float)hi);
        WRH[idx] = hi; WRL[idx] = lo;
    }
}

__device__ __forceinline__ void phase_adaln(const Args& a, LAS char* lds) {
    const int tid = threadIdx.x;
    LAS float* sact = (LAS float*)lds;
    LAS f32x4* red = (LAS f32x4*)(lds + 40960);
    const float* c = a.in[I_C]; const float* cc = a.in[I_CCTX]; const float* W = a.in[I_WADA];
    float* PART = (float*)(a.ws + WS_PART);
    for (int i = tid; i < 5 * DM; i += NTHREADS) { const float v = (i < 4 * DM) ? c[i] : cc[i - 4 * DM]; sact[i] = silu_f(v); }
    __syncthreads();
    const int col4 = tid & 31, ksub = tid >> 5;
    for (int u = blockIdx.x; u < 768; u += gridDim.x) {
        const int nc = u % 96, kc = u / 96;
        const int k0 = kc * 256 + ksub * 16;
        const float* wp = W + (size_t)k0 * ADAW + nc * 128 + col4 * 4;
        f32x4 acc[5];
#pragma unroll
        for (int r = 0; r < 5; ++r) acc[r] = (f32x4){0.f, 0.f, 0.f, 0.f};
#pragma unroll 8
        for (int kk = 0; kk < 16; ++kk) {
            const f32x4 w = *(const f32x4*)(wp + (size_t)kk * ADAW);
#pragma unroll
            for (int r = 0; r < 5; ++r) acc[r] += w * sact[r * DM + k0 + kk];
        }
#pragma unroll
        for (int r = 0; r < 5; ++r) red[(ksub * 5 + r) * 32 + col4] = acc[r];
        __syncthreads();
        if (tid < 160) {
            const int r = tid >> 5, c4 = tid & 31;
            f32x4 s = (f32x4){0.f, 0.f, 0.f, 0.f};
#pragma unroll
            for (int j = 0; j < 16; ++j) s += red[(j * 5 + r) * 32 + c4];
            *(f32x4*)(PART + ((size_t)kc * 5 + r) * ADAW + nc * 128 + c4 * 4) = s;
        }
        __syncthreads();
    }
}

__device__ __forceinline__ float mod_sum(const float* PART, const float* bada, int r, int n) {
    float s = bada[n];
#pragma unroll
    for (int kc = 0; kc < 8; ++kc) s += PART[((size_t)kc * 5 + r) * ADAW + n];
    return s;
}
__device__ __forceinline__ void phase_modulate(const Args& a, LAS char* lds) {
    const int tid = threadIdx.x, lane = tid & 63, wid = tid >> 6;
    const float* PART = (const float*)(a.ws + WS_PART); const float* bada = a.in[I_BADA];
    float* MOD = (float*)(a.ws + WS_MOD);
    for (int idx = blockIdx.x * NTHREADS + tid; idx < 5 * ADAW; idx += gridDim.x * NTHREADS) MOD[idx] = mod_sum(PART, bada, idx / ADAW, idx % ADAW);
    const int per = (TA + gridDim.x - 1) / gridDim.x;
    const int r0 = blockIdx.x * per, r1 = (r0 + per < TA) ? r0 + per : TA;
    if (r0 >= r1) return;
    const int mrA = (r0 < T) ? r0 / SEQ : 4, mrB = (r1 - 1 < T) ? (r1 - 1) / SEQ : 4;
    LAS float* smod = (LAS float*)lds;
    for (int i = tid; i < 2 * 2 * DM; i += NTHREADS) {
        const int slot = i / (2 * DM), n = i % (2 * DM);
        smod[i] = mod_sum(PART, bada, slot ? mrB : mrA, n);
    }
    __syncthreads();
    h16* A1 = (h16*)(a.ws + WS_A1);
    for (int row = r0 + wid; row < r1; row += 8) {
        const float* xr = (row < T) ? a.in[I_X] + (size_t)row * DM : a.in[I_CTX] + (size_t)(row - T) * DM;
        const int mr = (row < T) ? row / SEQ : 4;
        LAS float* sm = smod + ((mr == mrA) ? 0 : 2 * DM);
        f32x4 v[8]; float s = 0.f;
#pragma unroll
        for (int j = 0; j < 8; ++j) { v[j] = *(const f32x4*)(xr + j * 256 + lane * 4); s += (v[j][0] + v[j][1]) + (v[j][2] + v[j][3]); }
        const float mean = wave_sum(s) * (1.f / DM); float q = 0.f;
#pragma unroll
        for (int j = 0; j < 8; ++j) { v[j] = v[j] - mean; q += (v[j][0] * v[j][0] + v[j][1] * v[j][1]) + (v[j][2] * v[j][2] + v[j][3] * v[j][3]); }
        const float rstd = 1.f / sqrtf(wave_sum(q) * (1.f / DM) + EPS);
#pragma unroll
        for (int j = 0; j < 8; ++j) {
            const int k = j * 256 + lane * 4;
            const f32x4 sh = *(LAS f32x4*)(sm + k), sc = *(LAS f32x4*)(sm + DM + k);
            const f32x4 y = v[j] * rstd * (sc + 1.f) + sh;
            *(h16x4*)(A1 + (size_t)row * DM + k) = cvt4(y);
        }
    }
}

__device__ __forceinline__ void acc_rows16(const f32x4 (&c)[4], float w, u32x4 (&v)[2]) {
    u32x2 x[4];
#pragma unroll
    for (int ni = 0; ni < 4; ++ni) x[ni] = __builtin_bit_cast(u32x2, cvt4(c[ni] * w));
#pragma unroll
    for (int n1 = 0; n1 < 2; ++n1) {
#pragma unroll
        for (int d = 0; d < 2; ++d) {
            auto p = __builtin_amdgcn_permlane32_swap(x[2 * n1][d], x[2 * n1 + 1][d], false, false);
            auto q = __builtin_amdgcn_permlane16_swap(p[0], p[1], false, false);
            x[2 * n1][d] = q[0]; x[2 * n1 + 1][d] = q[1];
        }
        v[n1] = (u32x4){x[2 * n1][0], x[2 * n1][1], x[2 * n1 + 1][0], x[2 * n1 + 1][1]};
    }
}
__device__ __forceinline__ void st_rows16(h16* rowp, const f32x4 (&c)[4], float w, int g) {
    u32x4 v[2];
    acc_rows16(c, w, v);
    *(u32x4*)(rowp + 8 * g) = v[0]; *(u32x4*)(rowp + 8 * g + 32) = v[1];
}
__device__ __forceinline__ void st4(h16* p, f32x4 v) { *(h16x4*)p = cvt4(v); }
__device__ __forceinline__ void rope4(f32x4 x1, f32x4 x2, float pos, int i0, float step, float sc, f32x4& o1, f32x4& o2) {
#pragma unroll
    for (int r = 0; r < 4; ++r) {
        const float invf = exp2f(-(float)(i0 + r) * step);
        const float ang = pos * invf;
        const float s = __sinf(ang), c = __cosf(ang);
        o1[r] = (x1[r] * c - x2[r] * s) * sc; o2[r] = (x1[r] * s + x2[r] * c) * sc;
    }
}
template <int NM>
__device__ __forceinline__ void inproj_epi(const Args& a, const f32x4 (&acc)[NM][4], bool lat, int b, int m0, int l0, int nt, int wn, int g) {
    h16* QR = (h16*)(a.ws + WS_QR); h16* KR = (h16*)(a.ws + WS_KR); h16* VR = (h16*)(a.ws + WS_VR);
    h16* KC = (h16*)(a.ws + WS_KC); h16* VC = (h16*)(a.ws + WS_VC); h16* GS = (h16*)(a.ws + WS_GS);
    h16* CQ = (h16*)(a.ws + WS_CQ); h16* CKV = (h16*)(a.ws + WS_CKV); h16* KPE = (h16*)(a.ws + WS_KPE);
    const int cw = wn * 64;
    if (nt < 16) {
        const int h = nt & 7; const bool isq = nt < 8;
        h16* dst = isq ? QR : (lat ? KR : KC);
        const float sc = isq ? 1.f : KSCALE;
#pragma unroll
        for (int mi = 0; mi < NM; ++mi) {
            const int l = l0 + mi * 16;
            const size_t ro = lat ? ((size_t)(b * 8 + h) * SEQ + l) * 128 : ((size_t)(b * 8 + h) * LC + l) * 128;
            const float pos = (wn == 0) ? (float)(l >> 6) : (float)(l & 63);
            f32x4 c[4];
#pragma unroll
            for (int ni = 0; ni < 2; ++ni) {
                if (lat) rope4(acc[mi][ni], acc[mi][ni + 2], pos, ni * 16 + 4 * g, L2_10000 / 32.f, sc, c[ni], c[ni + 2]);
                else { c[ni] = acc[mi][ni] * sc; c[ni + 2] = acc[mi][ni + 2] * sc; }
            }
            st_rows16(dst + ro + cw, c, 1.f, g);
        }
    } else if (nt < 24) {
        const int h = nt - 16; h16* dst = lat ? VR : VC;
#pragma unroll
        for (int mi = 0; mi < NM; ++mi) {
            const int l = l0 + mi * 16;
            const size_t ro = lat ? ((size_t)(b * 8 + h) * SEQ + l) * 128 : ((size_t)(b * 8 + h) * LC + l) * 128;
            st_rows16(dst + ro + cw, acc[mi], 1.f, g);
        }
    } else if (nt < 32) {
#pragma unroll
        for (int mi = 0; mi < NM; ++mi) {
            f32x4 c[4];
#pragma unroll
            for (int ni = 0; ni < 4; ++ni)
#pragma unroll
                for (int r = 0; r < 4; ++r) c[ni][r] = silu_f(acc[mi][ni][r]);
            st_rows16(GS + (size_t)(m0 + mi * 16) * 1024 + (nt - 24) * 128 + cw, c, 1.f, g);
        }
    } else if (nt < 36) {
#pragma unroll
        for (int mi = 0; mi < NM; ++mi) st_rows16(CQ + (size_t)(m0 + mi * 16) * 512 + (nt - 32) * 128 + cw, acc[mi], 1.f, g);
    } else if (nt < 38) {
#pragma unroll
        for (int mi = 0; mi < NM; ++mi) {
            const int key = (lat ? LC : 0) + l0 + mi * 16;
            st_rows16(CKV + ((size_t)b * LK + key) * 256 + (nt - 36) * 128 + cw, acc[mi], 1.f, g);
        }
    } else if (nt == 38 && wn == 0) {
#pragma unroll
        for (int mi = 0; mi < NM; ++mi) {
            const int l = l0 + mi * 16, key = (lat ? LC : 0) + l;
            f32x4 c[4];
#pragma unroll
            for (int hf = 0; hf < 2; ++hf) {
                const float pos = hf ? (float)(l & 63) : (float)(l >> 6);
                if (lat) rope4(acc[mi][2 * hf], acc[mi][2 * hf + 1], pos, 4 * g, L2_10000 / 16.f, 1.f, c[2 * hf], c[2 * hf + 1]);
                else { c[2 * hf] = acc[mi][2 * hf]; c[2 * hf + 1] = acc[mi][2 * hf + 1]; }
            }
            st_rows16(KPE + ((size_t)b * LK + key) * 64, c, 1.f, g);
        }
    }
}
__device__ __forceinline__ void inproj_unit(int list, int p, int& mt, int& nt) {
    if (list == 0) {
        if (p < 352) { const int mg = p / 44, rem = p - mg * 44, ti = rem >> 2; mt = mg * 4 + (rem & 3); nt = (ti < 8) ? 4 + ti : 8 + ti; }
        else if (p < 388) { const int q = p - 352, ti = q >> 2; mt = 32 + (q & 3); nt = (ti < 8) ? 4 + ti : 18; }
        else { const int q = p - 388; mt = q >> 2; nt = q & 3; }
    } else {
        if (p < 4) { mt = 31; nt = p; }
        else if (p < 132) { const int q = p - 4; mt = q >> 2; nt = 12 + (q & 3); }
        else if (p < 164) { mt = p - 132; nt = 19; }
        else { mt = 32 + (p - 164); nt = 19; }
    }
}
constexpr int INPROJ_NU0 = 512, INPROJ_NU1 = 168;
__device__ __forceinline__ void phase_inproj(const Args& a, LAS char* lds, int vcu, int list) {
    GemmThread2 G; G.init();
    const h16* A1 = (const h16*)(a.ws + WS_A1); const h16* W16 = (const h16*)(a.ws + WS_WIN16);
    const int NU = list ? INPROJ_NU1 : INPROJ_NU0;
    for (int p = vcu; p < NU; p += gridDim.x) {
        int mt, nt;
        inproj_unit(list, p, mt, nt);
        f32x4 acc[8][4];
        gemm_tile_g2(lds, G, A1 + (size_t)mt * 256 * DM, DM, W16 + nt * 256, WINP, DM / 64, acc);
        const bool lat = mt < 32;
        const int b = lat ? (mt >> 3) : (mt - 32);
        int r16l = G.r16, gl = G.g;
        asm volatile("" : "+v"(r16l), "+v"(gl));
        const int m0 = mt * 256 + G.wm * 128 + r16l;
        const int l0 = lat ? (m0 & (SEQ - 1)) : (m0 - T - b * LC);
        const int cb = nt * 4 + G.wn;
        inproj_epi<8>(a, acc, lat, b, m0, l0, cb >> 1, cb & 1, gl);
    }
    if (list == 0) {
        const int rounds = (NU + (int)gridDim.x - 1) / (int)gridDim.x, mine = (vcu < NU) ? (NU - vcu + (int)gridDim.x - 1) / (int)gridDim.x : 0;
        if (mine < rounds) wdown_pool(a, lds, 8 * (rounds - mine));
    }
}

__device__ __forceinline__ void qup_unit(const Args& a, LAS char* lds, G3Stream& S, int p, int pn) {
    GemmThread G; G.init(true);
    const h16* CQ = (const h16*)(a.ws + WS_CQ); h16* Q = (h16*)(a.ws + WS_Q);
    LAS float* rs = (LAS float*)(lds + GEMM_ROWS_OFF);
    const int mt = p / 12, nt = p % 12;
    const bool hn = pn >= 0;
    f32x4 acc[4][4];
    gemm_tile_g<true>(lds, G, CQ + (size_t)mt * 256 * 512, 512, (const h16*)(a.ws + WS_WUQ16) + nt * 128, 1536, 512 / 64, acc, S,
                      hn ? CQ + (size_t)(pn / 12) * 256 * 512 : nullptr, hn ? (const h16*)(a.ws + WS_WUQ16) + (pn % 12) * 128 : nullptr);
    const int c0 = nt * 128 + G.wn * 64, head = c0 / 192, d0 = c0 % 192;
#pragma unroll
    for (int mi = 0; mi < 4; ++mi) {
        const int ml = G.wm * 64 + mi * 16 + G.r16, m = mt * 256 + ml;
        const float r = rs[ml];
        const int b = m >> 11, l = m & (SEQ - 1);
        h16* dst = Q + ((size_t)(b * 8 + head) * SEQ + l) * 192 + d0;
        if (d0 < 128) st_rows16(dst, acc[mi], r, G.g);
        else {
            f32x4 c[4];
#pragma unroll
            for (int hf = 0; hf < 2; ++hf) {
                const float pos = hf ? (float)(l & 63) : (float)(l >> 6);
                rope4(acc[mi][2 * hf], acc[mi][2 * hf + 1], pos, 4 * G.g, L2_10000 / 16.f, r, c[2 * hf], c[2 * hf + 1]);
            }
            st_rows16(dst, c, 1.f, G.g);
        }
    }
}
__device__ __forceinline__ void kvup_unit(const Args& a, LAS char* lds, G3Stream& S, int p, int pn) {
    GemmThread G; G.init(true);
    const h16* CKV = (const h16*)(a.ws + WS_CKV); h16* KN = (h16*)(a.ws + WS_KN); h16* VV = (h16*)(a.ws + WS_VV);
    LAS float* rs = (LAS float*)(lds + GEMM_ROWS_OFF);
    const int mt = p >> 4, nt = p & 15;
    const bool hn = pn >= 0;
    f32x4 acc[4][4];
    gemm_tile_g<true>(lds, G, CKV + (size_t)mt * 256 * 256, 256, (const h16*)(a.ws + WS_WUKV16) + nt * 128, 2048, 256 / 64, acc, S,
                      hn ? CKV + (size_t)(pn >> 4) * 256 * 256 : nullptr, hn ? (const h16*)(a.ws + WS_WUKV16) + (pn & 15) * 128 : nullptr);
    const int head = nt >> 1; h16* base = (nt & 1) ? VV : KN;
#pragma unroll
    for (int mi = 0; mi < 4; ++mi) {
        const int ml = G.wm * 64 + mi * 16 + G.r16, m = mt * 256 + ml;
        const float r = rs[ml];
        const int b = m / LK, key = m % LK;
        st_rows16(base + ((size_t)(b * 8 + head) * LK + key) * 128 + G.wn * 64, acc[mi], r, G.g);
    }
}

__device__ __forceinline__ float log2_gamma(const float* rdec, int dir, int h) {
    const float x = rdec[dir * 8 + h];
    return -log1pf(__expf(-x)) * 1.4426950408889634f;
}

__device__ __forceinline__ void ret_state_item(const Args& a, LAS char* lds, int it) {
    int tid = threadIdx.x; asm volatile("" : "+v"(tid));
    const int lane = tid & 63, wid = __builtin_amdgcn_readfirstlane(tid >> 6), r16 = lane & 15, g = lane >> 4;
    const h16* KR = (const h16*)(a.ws + WS_KR); const h16* VR = (const h16*)(a.ws + WS_VR);
    const h16* KC = (const h16*)(a.ws + WS_KC); const h16* VC = (const h16*)(a.ws + WS_VC);
    h16* UF = (h16*)(a.ws + WS_UF); h16* UB = (h16*)(a.ws + WS_UB); h16* S0F = (h16*)(a.ws + WS_S0F); h16* S0B = (h16*)(a.ws + WS_S0B);
    LAS char* Kf = lds; LAS char* Kb = lds + 32768; LAS char* Vi = lds + 65536;
    __syncthreads();
    {
        const int bh = it / 17, c = it % 17, h = bh & 7;
        const float lgf = log2_gamma(a.in[I_RDEC], 0, h), lgb = log2_gamma(a.in[I_RDEC], 1, h);
        const bool isctx = (c == 16);
        const int J = isctx ? 256 : 128;
        const h16* Kp = isctx ? KC + (size_t)bh * LC * 128 : KR + ((size_t)bh * SEQ + c * 128) * 128;
        const h16* Vp = isctx ? VC + (size_t)bh * LC * 128 : VR + ((size_t)bh * SEQ + c * 128) * 128;
        f32x4 accf[8], accb[8];
#pragma unroll
        for (int i = 0; i < 8; ++i) { accf[i] = (f32x4){0.f, 0.f, 0.f, 0.f}; accb[i] = (f32x4){0.f, 0.f, 0.f, 0.f}; }
        for (int sub = 0; sub < J / 128; ++sub) {
            if (sub) __syncthreads();
#pragma unroll
            for (int i = 0; i < 4; ++i) {
                const int row = (tid >> 4) + 32 * i, ch = tid & 15, j = sub * 128 + row;
                const h16x8 kv = *(const h16x8*)(Kp + (size_t)j * 128 + ch * 8);
                const h16x8 vv = *(const h16x8*)(Vp + (size_t)j * 128 + ch * 8);
                const float zf = exp2f(lgf * (float)(J - 1 - j)), zb = exp2f(lgb * (float)j);
                h16x8 kf, kb;
#pragma unroll
                for (int e = 0; e < 8; ++e) { const float f = (float)kv[e]; kf[e] = (h16)(f * zf); kb[e] = (h16)(f * zb); }
                const int o = off_b(row, ch);
                *(LAS h16x8*)(Kf + o) = kf; *(LAS h16x8*)(Kb + o) = kb; *(LAS h16x8*)(Vi + o) = vv;
            }
            __syncthreads();
#pragma unroll
            for (int ks = 0; ks < 4; ++ks) {
                const int o0 = tr_addr16(lane, wid, ks, 0), o1 = tr_addr16(lane, wid, ks, 1);
                const h16x8 af = cat8(trrd(Kf + o0), trrd(Kf + o1)), ab = cat8(trrd(Kb + o0), trrd(Kb + o1));
#pragma unroll
                for (int cb = 0; cb < 8; ++cb) {
                    const h16x8 bv = cat8(trrd(Vi + tr_addr16(lane, cb, ks, 0)), trrd(Vi + tr_addr16(lane, cb, ks, 1)));
                    accf[cb] = mfma16(af, bv, accf[cb]); accb[cb] = mfma16(ab, bv, accb[cb]);
                }
            }
        }
        h16* of = isctx ? S0F + (size_t)bh * 16384 : UF + ((size_t)bh * 16 + c) * 16384;
        h16* ob = isctx ? S0B + (size_t)bh * 16384 : UB + ((size_t)bh * 16 + c) * 16384;
#pragma unroll
        for (int cb = 0; cb < 8; ++cb)
#pragma unroll
            for (int r = 0; r < 4; ++r) {
                const int d = wid * 16 + 4 * g + r, e = cb * 16 + r16;
                of[d * 128 + e] = (h16)accf[cb][r]; ob[d * 128 + e] = (h16)accb[cb][r];
            }
        __syncthreads();
    }
}

constexpr int N_ITEMS = 384 + 544 + 576;
__device__ __forceinline__ void phase_mid(const Args& a, LAS char* lds, int vcu) {
    phase_inproj(a, lds, vcu, 1);
    const int Gn = (int)gridDim.x;
    const bool bal = (Gn == 256);
    const int cyc = bal ? 432 : Gn, nseq = (bal && vcu >= INPROJ_NU1) ? 3 : 1;
    G3Stream S; S.gs = 0; S.primed = false;
    int j = 0, t = 0;
    for (;;) {
        const int i = vcu + 88 * t + cyc * j;
        if (i >= N_ITEMS) break;
        int t2 = t + 1, j2 = j; if (t2 == nseq) { t2 = 0; ++j2; }
        const int inext = vcu + 88 * t2 + cyc * j2;
        if (i < 384) qup_unit(a, lds, S, i, (inext < 384) ? inext : -1);
        else if (i < 928) ret_state_item(a, lds, i - 384);
        else kvup_unit(a, lds, S, i - 928, (inext < N_ITEMS) ? inext - 928 : -1);
        t = t2; j = j2;
    }
}

__device__ __forceinline__ void phase_ret_scan(const Args& a) {
    const h16* UF = (const h16*)(a.ws + WS_UF); const h16* UB = (const h16*)(a.ws + WS_UB);
    const h16* S0F = (const h16*)(a.ws + WS_S0F); const h16* S0B = (const h16*)(a.ws + WS_S0B);
    h16* SF = (h16*)(a.ws + WS_SF); h16* SB = (h16*)(a.ws + WS_SB);
    for (int idx = blockIdx.x * NTHREADS + threadIdx.x; idx < 32 * 16384; idx += gridDim.x * NTHREADS) {
        const int bh = idx >> 14, el = idx & 16383, h = bh & 7;
        const float gf = exp2f(128.f * log2_gamma(a.in[I_RDEC], 0, h)), gb = exp2f(128.f * log2_gamma(a.in[I_RDEC], 1, h));
        float sf = (float)S0F[idx], sb = (float)S0B[idx];
        for (int c = 0; c < 16; ++c) {
            SF[((size_t)bh * 16 + c) * 16384 + el] = (h16)sf;
            sf = gf * sf + (float)UF[((size_t)bh * 16 + c) * 16384 + el];
        }
        for (int c = 15; c >= 0; --c) {
            SB[((size_t)bh * 16 + c) * 16384 + el] = (h16)sb;
            sb = gb * sb + (float)UB[((size_t)bh * 16 + c) * 16384 + el];
        }
    }
}

__device__ __forceinline__ void ret_out_item(const Args& a, LAS char* lds, int bh, int c) {
    const int tid = threadIdx.x, lane = tid & 63, wid = __builtin_amdgcn_readfirstlane(tid >> 6), r16 = lane & 15, g = lane >> 4;
    const int b = bh >> 3, h = bh & 7;
    const float lgf = log2_gamma(a.in[I_RDEC], 0, h), lgb = log2_gamma(a.in[I_RDEC], 1, h);
    const h16* QR = (const h16*)(a.ws + WS_QR); const h16* KR = (const h16*)(a.ws + WS_KR); const h16* VR = (const h16*)(a.ws + WS_VR);
    const h16* SF = (const h16*)(a.ws + WS_SF); const h16* SB = (const h16*)(a.ws + WS_SB);
    const h16* GS = (const h16*)(a.ws + WS_GS); h16* MIX = (h16*)(a.ws + WS_MIX);
    LAS char* Qi = lds; LAS char* Ki = lds + 32768; LAS char* Vi = lds + 65536; LAS char* Pi = lds + 98304;
    const size_t src0 = ((size_t)bh * SEQ + c * 128) * 128, st0 = ((size_t)bh * 16 + c) * 16384;
    int ra[4], tbv[8][2];
#pragma unroll
    for (int s = 0; s < 4; ++s) ra[s] = row_addr16(lane, 0, s);
#pragma unroll
    for (int eb = 0; eb < 8; ++eb) { tbv[eb][0] = tr_addr16(lane, eb, 0, 0); tbv[eb][1] = tr_addr16(lane, eb, 0, 1); }
    const int st_o = off_b(tid >> 4, tid & 15);
    u32x4 sfr[4], sbr[4];
    {
        u32x4 qv[4], kv[4], vv[4];
#pragma unroll
        for (int i = 0; i < 4; ++i) {
            const size_t s = src0 + (size_t)((tid >> 4) + 32 * i) * 128 + (tid & 15) * 8;
            qv[i] = *(const u32x4*)(QR + s); kv[i] = *(const u32x4*)(KR + s); vv[i] = *(const u32x4*)(VR + s);
        }
#pragma unroll
        for (int i = 0; i < 4; ++i) {
            const size_t s = st0 + (size_t)((tid >> 4) + 32 * i) * 128 + (tid & 15) * 8;
            sfr[i] = *(const u32x4*)(SF + s); sbr[i] = *(const u32x4*)(SB + s);
        }
#pragma unroll
        for (int i = 0; i < 4; ++i) { *(LAS u32x4*)(Qi + st_o + i * 8192) = qv[i]; *(LAS u32x4*)(Ki + st_o + i * 8192) = kv[i]; *(LAS u32x4*)(Vi + st_o + i * 8192) = vv[i]; }
    }
    __syncthreads();
    h16x8 qf[4];
#pragma unroll
    for (int s = 0; s < 4; ++s) qf[s] = *(LAS h16x8*)(Qi + ra[s] + wid * 4096);
    const int il = 16 * wid + r16;
#pragma unroll
    for (int jb = 0; jb < 8; ++jb) {
        f32x4 sa = (f32x4){0.f, 0.f, 0.f, 0.f};
#pragma unroll
        for (int s = 0; s < 4; ++s) { const h16x8 kf = *(LAS h16x8*)(Ki + ra[s] + jb * 4096); sa = mfma16(kf, qf[s], sa); }
        f32x4 pv;
#pragma unroll
        for (int r = 0; r < 4; ++r) {
            const int dl = il - (16 * jb + 4 * g + r);
            float f = 0.f;
            if (dl >= 0) f += exp2f(lgf * (float)dl);
            if (dl <= 0) f += exp2f(lgb * (float)(-dl));
            pv[r] = sa[r] * f;
        }
        *(LAS h16x4*)(Pi + off_b(il, 2 * jb + (g >> 1)) + (g & 1) * 8) = cvt4(pv);
    }
    __syncthreads();
#pragma unroll
    for (int i = 0; i < 4; ++i) *(LAS u32x4*)(Ki + st_o + i * 8192) = sfr[i];
    __syncthreads();
    const h16 xfh = (h16)exp2f(lgf * (float)(il + 1)), xbh = (h16)exp2f(lgb * (float)(128 - il));
    f32x4 ao[8];
#pragma unroll
    for (int i = 0; i < 8; ++i) ao[i] = (f32x4){0.f, 0.f, 0.f, 0.f};
#pragma unroll
    for (int s = 0; s < 4; ++s) {
        const h16x8 pf = *(LAS h16x8*)(Pi + ra[s] + wid * 4096);
        const h16x8 qsf = qf[s] * xfh;
#pragma unroll
        for (int eb = 0; eb < 8; ++eb) {
            const h16x8 vf = cat8(trrd(Vi + tbv[eb][0] + s * 8192), trrd(Vi + tbv[eb][1] + s * 8192));
            ao[eb] = mfma16(vf, pf, ao[eb]);
            const h16x8 sf = cat8(trrd(Ki + tbv[eb][0] + s * 8192), trrd(Ki + tbv[eb][1] + s * 8192));
            ao[eb] = mfma16(sf, qsf, ao[eb]);
        }
    }
    __syncthreads();
#pragma unroll
    for (int i = 0; i < 4; ++i) *(LAS u32x4*)(Vi + st_o + i * 8192) = sbr[i];
    __syncthreads();
#pragma unroll
    for (int s = 0; s < 4; ++s) {
        const h16x8 qsb = qf[s] * xbh;
#pragma unroll
        for (int eb = 0; eb < 8; ++eb) {
            const h16x8 sf = cat8(trrd(Vi + tbv[eb][0] + s * 8192), trrd(Vi + tbv[eb][1] + s * 8192));
            ao[eb] = mfma16(sf, qsb, ao[eb]);
        }
    }
    float sum = 0.f;
#pragma unroll
    for (int eb = 0; eb < 8; ++eb) sum += (ao[eb][0] + ao[eb][1]) + (ao[eb][2] + ao[eb][3]);
    sum += __shfl_xor(sum, 16); sum += __shfl_xor(sum, 32);
    const float mean = sum * (1.f / 128.f); float q = 0.f;
#pragma unroll
    for (int eb = 0; eb < 8; ++eb) { ao[eb] = ao[eb] - mean; q += (ao[eb][0] * ao[eb][0] + ao[eb][1] * ao[eb][1]) + (ao[eb][2] * ao[eb][2] + ao[eb][3] * ao[eb][3]); }
    q += __shfl_xor(q, 16); q += __shfl_xor(q, 32);
    const float rstd = 1.f / sqrtf(q * (1.f / 128.f) + EPS);
    const int t = b * SEQ + c * 128 + il;
    const float* gw = a.in[I_RGN] + h * 128;
#pragma unroll
    for (int eb = 0; eb < 8; ++eb) {
        const int e = 16 * eb + 4 * g;
        const f32x4 w = *(const f32x4*)(gw + e);
        const h16x4 gs = *(const h16x4*)(GS + (size_t)t * 1024 + h * 128 + e);
        f32x4 o;
#pragma unroll
        for (int r = 0; r < 4; ++r) o[r] = ao[eb][r] * rstd * w[r] * (float)gs[r];
        st4(MIX + (size_t)t * DM + h * 128 + e, o);
    }
    __syncthreads();
}

namespace att {
constexpr float SCALE = 0.07216878364870322f;
constexpr float THR = 8.f;
constexpr int SHM_V = 16384, SHM_K = 16384, SHM_P = 8192;
constexpr int OFF_V = 0, OFF_K = 32768, OFF_P = 65536, OFF_W = 81920, OFF_QP = 83968;
using s16x4 = __attribute__((ext_vector_type(4))) short;
#define KSWZ(row, colB) ((row) * 256 + ((colB) ^ (((row) & 7) << 4)))
#define PSWZ(row, colB) ((row) * 128 + ((colB) ^ (((row) & 7) << 4)))
#define SBAR() __builtin_amdgcn_sched_barrier(0)
__device__ __forceinline__ int crow(int r, int hi) { return (r & 3) + 8 * (r >> 2) + 4 * hi; }
__device__ __forceinline__ unsigned pk2(float lo, float hi) { h16x2 v; v[0] = (h16)lo; v[1] = (h16)hi; return __builtin_bit_cast(unsigned, v); }
__device__ __forceinline__ f32x16 mfma32(h16x8 a, h16x8 b, f32x16 c) { return __builtin_amdgcn_mfma_f32_32x32x16_f16(a, b, c, 0, 0, 0); }
__device__ __forceinline__ void partialSM(f32x16& p0, f32x16& p1, float& m_reg, float& mn, float& alpha) {
    constexpr float C = SCALE * 1.4426950408889634f;
    float pmax = p0[0];
#pragma unroll
    for (int r = 1; r < 16; ++r) pmax = fmaxf(pmax, p0[r]);
#pragma unroll
    for (int r = 0; r < 16; ++r) pmax = fmaxf(pmax, p1[r]);
    { auto rr = __builtin_amdgcn_permlane32_swap(__float_as_uint(pmax), __float_as_uint(pmax), false, false);
      pmax = fmaxf(__uint_as_float(rr[0]), __uint_as_float(rr[1])); }
    if (__builtin_expect(__all(pmax - m_reg <= THR / SCALE), 1)) { mn = m_reg; alpha = 1.f; }
    else { mn = fmaxf(m_reg, pmax); alpha = __builtin_amdgcn_exp2f((m_reg - mn) * C); m_reg = mn; }
    const float mnC = -mn * C;
#pragma unroll
    for (int r = 0; r < 16; ++r) p0[r] = fmaf(p0[r], C, mnC);
#pragma unroll
    for (int r = 0; r < 16; ++r) p1[r] = fmaf(p1[r], C, mnC);
#pragma unroll
    for (int r = 0; r < 16; ++r) p0[r] = __builtin_amdgcn_exp2f(p0[r]);
}
__device__ __forceinline__ void finishSM(f32x16& p0, f32x16& p1, float alpha, float& l_reg, h16x8& pa0, h16x8& pa1, h16x8& pa2, h16x8& pa3) {
#pragma unroll
    for (int r = 0; r < 16; ++r) p1[r] = __builtin_amdgcn_exp2f(p1[r]);
    float ps = 0;
#pragma unroll
    for (int r = 0; r < 16; ++r) ps += p0[r];
#pragma unroll
    for (int r = 0; r < 16; ++r) ps += p1[r];
    { auto rr = __builtin_amdgcn_permlane32_swap(__float_as_uint(ps), __float_as_uint(ps), false, false);
      ps = __uint_as_float(rr[0]) + __uint_as_float(rr[1]); }
    l_reg = l_reg * alpha + ps;
#define PK4(P, BASE, OUT) do { unsigned a0 = pk2(P[BASE + 0], P[BASE + 1]), a1 = pk2(P[BASE + 2], P[BASE + 3]);   \
    unsigned b0 = pk2(P[BASE + 4], P[BASE + 5]), b1 = pk2(P[BASE + 6], P[BASE + 7]);                              \
    auto r0 = __builtin_amdgcn_permlane32_swap(a0, b0, false, false); auto r1 = __builtin_amdgcn_permlane32_swap(a1, b1, false, false); \
    u32x4 w = {r0[0], r1[0], r0[1], r1[1]}; OUT = __builtin_bit_cast(h16x8, w); } while (0)
    PK4(p0, 0, pa0); PK4(p0, 8, pa1); PK4(p1, 0, pa2); PK4(p1, 8, pa3);
#undef PK4
}
__device__ __forceinline__ void qkt(f32x16& p0, f32x16& p1, LAS char* Ks, LAS char* Ps, const h16x8* qr, LAS char* qpl, int r32, int hi) {
    p0 = f32x16{}; p1 = f32x16{};
#pragma unroll
    for (int d0 = 0; d0 < 8; ++d0) { const int cb = (d0 * 16 + hi * 8) * 2;
        const h16x8 b0 = *(LAS h16x8*)(Ks + KSWZ(r32, cb));
        const h16x8 b1 = *(LAS h16x8*)(Ks + KSWZ(32 + r32, cb));
        p0 = mfma32(b0, qr[d0], p0); p1 = mfma32(b1, qr[d0], p1); }
    SBAR();
#pragma unroll
    for (int d0 = 0; d0 < 4; ++d0) { const int cb = (d0 * 16 + hi * 8) * 2;
        const h16x8 b0 = *(LAS h16x8*)(Ps + PSWZ(r32, cb));
        const h16x8 b1 = *(LAS h16x8*)(Ps + PSWZ(32 + r32, cb));
        const h16x8 qv = *(LAS h16x8*)(qpl + PSWZ(r32, cb));
        p0 = mfma32(b0, qv, p0); p1 = mfma32(b1, qv, p1); }
}
__device__ __forceinline__ int v_st(int k, int c) { const int kk = (k & ~0xC) | ((k & 4) << 1) | ((k & 8) >> 1); return ((kk >> 3) * 4 + (c >> 5)) * 512 + ((kk & 7) * 32 + (c & 31)) * 2; }
__device__ __forceinline__ int v_rd_base(int lane) { return ((lane & 3) << 3) | (((lane >> 2) & 3) << 6) | (((lane >> 4) & 1) << 5) | (((lane >> 5) & 1) << 8); }
constexpr int v_rd_off(int d0, int ks, int half) { return d0 * 512 + ks * 4096 + half * 2048; }
template <int OFF> __device__ __forceinline__ s16x4 tr_read(int vb) {
    s16x4 r; asm volatile("ds_read_b64_tr_b16 %0, %1 offset:%2" : "=&v"(r) : "v"(vb), "i"(OFF) : "memory"); return r;
}
template <int D0> __device__ __forceinline__ void pv_one(f32x16& od, int vb, h16x8 pa0, h16x8 pa1, h16x8 pa2, h16x8 pa3) {
    const s16x4 l0 = tr_read<v_rd_off(D0, 0, 0)>(vb), h0 = tr_read<v_rd_off(D0, 0, 1)>(vb), l1 = tr_read<v_rd_off(D0, 1, 0)>(vb), h1 = tr_read<v_rd_off(D0, 1, 1)>(vb);
    const s16x4 l2 = tr_read<v_rd_off(D0, 2, 0)>(vb), h2 = tr_read<v_rd_off(D0, 2, 1)>(vb), l3 = tr_read<v_rd_off(D0, 3, 0)>(vb), h3 = tr_read<v_rd_off(D0, 3, 1)>(vb);
    asm volatile("s_waitcnt lgkmcnt(0)" ::: "memory"); SBAR();
#define PK(L, H) __builtin_bit_cast(h16x8, __builtin_shufflevector(L, H, 0, 1, 2, 3, 4, 5, 6, 7))
    od = mfma32(pa0, PK(l0, h0), od);
    od = mfma32(pa1, PK(l1, h1), od);
    od = mfma32(pa2, PK(l2, h2), od);
    od = mfma32(pa3, PK(l3, h3), od);
#undef PK
}
__device__ __forceinline__ void pv_d0(f32x16* o, int vb, h16x8 pa0, h16x8 pa1, h16x8 pa2, h16x8 pa3) {
    pv_one<0>(o[0], vb, pa0, pa1, pa2, pa3); pv_one<1>(o[1], vb, pa0, pa1, pa2, pa3); pv_one<2>(o[2], vb, pa0, pa1, pa2, pa3); pv_one<3>(o[3], vb, pa0, pa1, pa2, pa3);
}
__device__ __forceinline__ void attn_body(const h16* __restrict__ Qb, const h16* __restrict__ Kh, const h16* __restrict__ Vh, const h16* __restrict__ Ph,
                                          h16* __restrict__ Ob, int seq, LAS char* lds) {
    int tid = threadIdx.x; asm volatile("" : "+v"(tid));
    const int wid = tid >> 6, lane = tid & 63, r32 = lane & 31, hi = lane >> 5;
    LAS char* V_lds = lds + OFF_V; LAS char* K_lds = lds + OFF_K; LAS char* P_lds = lds + OFF_P;
    LAS float* wsf = (LAS float*)(lds + OFF_W) + wid * 64; LAS float* li_l = wsf; LAS float* al_l = wsf + 32;
    float m_reg = -1e30f, l_reg = 0; f32x16 o[4] = {}; h16x8 qr[8];
    LAS char* qp = lds + OFF_QP + wid * 4096;
    const h16* Qw = Qb + (size_t)(wid * 32 + r32) * 192 + hi * 8;
#pragma unroll
    for (int d0 = 0; d0 < 8; ++d0) qr[d0] = *(const h16x8*)(Qw + d0 * 16);
#pragma unroll
    for (int d0 = 0; d0 < 4; ++d0) *(LAS u32x4*)(qp + PSWZ(r32, (d0 * 16 + hi * 8) * 2)) = *(const u32x4*)(Qw + 128 + d0 * 16);
    const int sr = tid >> 4, sc = (tid & 15) * 8, vst0 = v_st(sr, sc), vst1 = v_st(32 + sr, sc);
    const int pr = tid >> 3, pc = (tid & 7) * 8;
    const int vb0 = (int)(uintptr_t)V_lds + v_rd_base(lane);
    struct { u32x4 vs0, vs1, ks0, ks1, ps; } sr_[1];
    const int vo = sr * 256 + sc * 2, po = pr * 128 + pc * 2;
    const __amdgpu_buffer_rsrc_t rsK = __builtin_amdgcn_make_buffer_rsrc((void*)Kh, (short)0, seq * 256, 0x00020000);
    const __amdgpu_buffer_rsrc_t rsV = __builtin_amdgcn_make_buffer_rsrc((void*)Vh, (short)0, seq * 256, 0x00020000);
    const __amdgpu_buffer_rsrc_t rsP = __builtin_amdgcn_make_buffer_rsrc((void*)Ph, (short)0, seq * 128, 0x00020000);
#define SLOAD(i, k0) do { const int so_ = (k0) * 256; \
    sr_[i].vs0 = __builtin_bit_cast(u32x4, __builtin_amdgcn_raw_buffer_load_b128(rsV, vo, so_, 0)); sr_[i].vs1 = __builtin_bit_cast(u32x4, __builtin_amdgcn_raw_buffer_load_b128(rsV, vo, so_ + 8192, 0)); \
    sr_[i].ks0 = __builtin_bit_cast(u32x4, __builtin_amdgcn_raw_buffer_load_b128(rsK, vo, so_, 0)); sr_[i].ks1 = __builtin_bit_cast(u32x4, __builtin_amdgcn_raw_buffer_load_b128(rsK, vo, so_ + 8192, 0)); \
    sr_[i].ps = __builtin_bit_cast(u32x4, __builtin_amdgcn_raw_buffer_load_b128(rsP, po, (k0) * 128, 0)); } while (0)
#define SWRITE(b, i) do { *(LAS u32x4*)(V_lds + (b) * SHM_V + vst0) = sr_[i].vs0;          \
    *(LAS u32x4*)(V_lds + (b) * SHM_V + vst1) = sr_[i].vs1; const int kc = sc * 2;               \
    *(LAS u32x4*)(K_lds + (b) * SHM_K + KSWZ(sr, kc)) = sr_[i].ks0;                       \
    *(LAS u32x4*)(K_lds + (b) * SHM_K + KSWZ(32 + sr, kc)) = sr_[i].ks1;                  \
    *(LAS u32x4*)(P_lds + (b) * SHM_P + PSWZ(pr, pc * 2)) = sr_[i].ps; } while (0)
#define SWAIT() asm volatile("s_waitcnt vmcnt(0)" ::: "memory")
#define RESC(a) do { if (__any((a) < 1.f)) { if (hi == 0) al_l[r32] = (a); asm volatile("s_waitcnt lgkmcnt(0)" ::: "memory"); \
    _Pragma("unroll") for (int d = 0; d < 4; ++d) _Pragma("unroll") for (int r = 0; r < 16; ++r) o[d][r] *= al_l[crow(r, hi)]; } } while (0)
    f32x16 pA0, pA1, pB0, pB1; float mnA, mnB, alA, alB; h16x8 pa0, pa1, pa2, pa3; const int NT = seq / 64;
    constexpr int SE = 0, SO = 0;
    SLOAD(SE, 0); asm volatile("s_waitcnt vmcnt(0)" ::: "memory"); SWRITE(0, SE); __syncthreads();
    qkt(pA0, pA1, K_lds, P_lds, qr, qp, r32, hi); partialSM(pA0, pA1, m_reg, mnA, alA);
    SLOAD(SO, 64);
    SWAIT(); SWRITE(1, SO); __syncthreads();
    for (int j = 1; j + 1 < NT; j += 2) {
        SBAR(); qkt(pB0, pB1, K_lds + SHM_K, P_lds + SHM_P, qr, qp, r32, hi);
        finishSM(pA0, pA1, alA, l_reg, pa0, pa1, pa2, pa3); SBAR();
        SLOAD(SO, (j + 1) * 64); SBAR();
        pv_d0(o, vb0, pa0, pa1, pa2, pa3); partialSM(pB0, pB1, m_reg, mnB, alB);
        __syncthreads(); SWAIT(); SWRITE(0, SE);
        RESC(alB); __syncthreads();
        SBAR(); qkt(pA0, pA1, K_lds, P_lds, qr, qp, r32, hi);
        finishSM(pB0, pB1, alB, l_reg, pa0, pa1, pa2, pa3); SBAR();
        SLOAD(SE, (j + 2) * 64); SBAR();
        pv_d0(o, vb0 + SHM_V, pa0, pa1, pa2, pa3); partialSM(pA0, pA1, m_reg, mnA, alA);
        __syncthreads(); SWAIT(); SWRITE(1, SO);
        RESC(alA); __syncthreads();
    }
    SBAR(); qkt(pB0, pB1, K_lds + SHM_K, P_lds + SHM_P, qr, qp, r32, hi);
    finishSM(pA0, pA1, alA, l_reg, pa0, pa1, pa2, pa3); SBAR();
    pv_d0(o, vb0, pa0, pa1, pa2, pa3); partialSM(pB0, pB1, m_reg, mnB, alB);
    __syncthreads(); RESC(alB);
    finishSM(pB0, pB1, alB, l_reg, pa0, pa1, pa2, pa3); SBAR();
    pv_d0(o, vb0 + SHM_V, pa0, pa1, pa2, pa3);
    if (hi == 0) li_l[r32] = l_reg; asm volatile("s_waitcnt lgkmcnt(0)" ::: "memory");
    float rli[16];
#pragma unroll
    for (int r = 0; r < 16; ++r) rli[r] = __builtin_amdgcn_rcpf(li_l[crow(r, hi)]);
    h16* Ow = Ob + (size_t)(wid * 32) * DM;
#pragma unroll
    for (int r = 0; r < 16; ++r) { const int orow = crow(r, hi);
#pragma unroll
        for (int d0 = 0; d0 < 4; ++d0) Ow[(size_t)orow * DM + d0 * 32 + r32] = (h16)(o[d0][r] * rli[r]); }
    __syncthreads();
#undef SLOAD
#undef SWRITE
#undef SWAIT
#undef RESC
}
#undef KSWZ
#undef PSWZ
}

__device__ __forceinline__ void phase_attn(const Args& a, LAS char* lds, int vcu) {
    const h16* Q = (const h16*)(a.ws + WS_Q); const h16* KN = (const h16*)(a.ws + WS_KN); const h16* VV = (const h16*)(a.ws + WS_VV);
    const h16* KPE = (const h16*)(a.ws + WS_KPE); h16* MIX = (h16*)(a.ws + WS_MIX);
    for (int it = vcu; it < 256; it += gridDim.x) {
        const int bh = it >> 3, qb = it & 7, b = bh >> 3, h = bh & 7;
        att::attn_body(Q + ((size_t)bh * SEQ + qb * 256) * 192, KN + (size_t)bh * LK * 128, VV + (size_t)bh * LK * 128, KPE + (size_t)b * LK * 64,
                       MIX + ((size_t)b * SEQ + qb * 256) * DM + 1024 + h * 128, LK, lds);
    }
}
__device__ __forceinline__ void phase_retout(const Args& a, LAS char* lds, int vcu) {
    for (int it = vcu; it < 512; it += gridDim.x) ret_out_item(a, lds, it >> 4, it & 15);
}

__device__ __forceinline__ void phase_oproj(const Args& a, LAS char* lds, int vcu) {
    GemmThread2 G; G.init();
    const h16* MIX = (const h16*)(a.ws + WS_MIX); const float* MOD = (const float*)(a.ws + WS_MOD); h16* U = (h16*)(a.ws + WS_U);
    const float* X = a.in[I_X];
    for (int p = vcu; p < 32 * 8; p += gridDim.x) {
        const int mg = p >> 5, rem = p & 31, nt = rem >> 2, mt = mg * 4 + (rem & 3);
        f32x4 acc[8][4];
        gemm_tile_g2(lds, G, MIX + (size_t)mt * 256 * DM, DM, (const h16*)(a.ws + WS_WO16) + nt * 256, DM, DM / 64, acc);
        const int b = mt >> 3, c0 = nt * 256 + G.wn * 64 + 4 * G.g;
        const float* g1 = MOD + (size_t)b * ADAW + 2 * DM + c0;
        f32x4 gv[4];
#pragma unroll
        for (int ni = 0; ni < 4; ++ni) gv[ni] = *(const f32x4*)(g1 + ni * 16);
        const size_t ro0 = (size_t)(mt * 256 + G.wm * 128 + G.r16) * DM + c0;
        f32x4 xn[4];
#pragma unroll
        for (int ni = 0; ni < 4; ++ni) xn[ni] = *(const f32x4*)(X + ro0 + ni * 16);
#pragma unroll
        for (int mi = 0; mi < 8; ++mi) {
            const size_t ro = ro0 + (size_t)mi * 16 * DM;
            f32x4 xv[4];
#pragma unroll
            for (int ni = 0; ni < 4; ++ni) xv[ni] = xn[ni];
            if (mi < 7) {
#pragma unroll
                for (int ni = 0; ni < 4; ++ni) xn[ni] = *(const f32x4*)(X + ro + (size_t)16 * DM + ni * 16);
            }
            __builtin_amdgcn_sched_barrier(0);
            f32x4 c[4];
#pragma unroll
            for (int ni = 0; ni < 4; ++ni) c[ni] = xv[ni] * ALPHA + gv[ni] * acc[mi][ni];
            st_rows16(U + ro - 4 * G.g, c, 1.f, G.g);
        }
    }
}

__device__ __forceinline__ int rt_off(int m, int c) { return m * 4096 + ((c ^ (m & 15)) << 4); }
__device__ __forceinline__ void phase_router(const Args& a, LAS char* lds) {
    const int tid = threadIdx.x, lane = tid & 63, wid = __builtin_amdgcn_readfirstlane(tid >> 6), r16 = lane & 15, g = lane >> 4;
    const h16* U = (const h16*)(a.ws + WS_U); const float* MOD = (const float*)(a.ws + WS_MOD);
    h16* H = (h16*)(a.ws + WS_H); unsigned char* A2q = (unsigned char*)(a.ws + WS_A2);
    int* LIST = (int*)(a.ws + WS_LIST); float* WL = (float*)(a.ws + WS_WL); unsigned* CNT = (unsigned*)(a.ws + WS_CTL) + CW_CNT;
    const h16* WRH = (const h16*)(a.ws + WS_WRH);
    const float* ln1w = a.in[I_LN1W]; const float* ln1b = a.in[I_LN1B];
    LAS char* THI = lds;
    LAS f32x4* red = (LAS f32x4*)lds;
    LAS float* lg = (LAS float*)(lds + 65536);
    LAS int* asg_e = (LAS int*)(lds + LDS_MAP + 2048); LAS int* asg_t = asg_e + 64; LAS float* asg_w = (LAS float*)(asg_e + 128);
    for (int base = blockIdx.x * 32; base < T; base += gridDim.x * 32) {
#pragma unroll 1
        for (int rr = 0; rr < 4; rr += 2) {
            const int m = 4 * wid + rr, row = base + m, b = row >> 11;
            f32x4 v[2][8]; float s[2] = {0.f, 0.f};
#pragma unroll
            for (int r = 0; r < 2; ++r)
#pragma unroll
                for (int j = 0; j < 8; ++j) { const h16x4 u4 = *(const h16x4*)(U + (size_t)(row + r) * DM + j * 256 + lane * 4);
#pragma unroll
                    for (int e = 0; e < 4; ++e) v[r][j][e] = (float)u4[e];
                    s[r] += (v[r][j][0] + v[r][j][1]) + (v[r][j][2] + v[r][j][3]); }
            float mean[2], q[2] = {0.f, 0.f}, rstd[2];
#pragma unroll
            for (int r = 0; r < 2; ++r) mean[r] = wave_sum(s[r]) * (1.f / DM);
#pragma unroll
            for (int r = 0; r < 2; ++r)
#pragma unroll
                for (int j = 0; j < 8; ++j) { v[r][j] = v[r][j] - mean[r]; q[r] += (v[r][j][0] * v[r][j][0] + v[r][j][1] * v[r][j][1]) + (v[r][j][2] * v[r][j][2] + v[r][j][3] * v[r][j][3]); }
#pragma unroll
            for (int r = 0; r < 2; ++r) { rstd[r] = 1.f / sqrtf(wave_sum(q[r]) * (1.f / DM) + EPS); s[r] = 0.f; }
#pragma unroll
            for (int j = 0; j < 8; ++j) {
                const int k = j * 256 + lane * 4;
                const f32x4 lw = *(const f32x4*)(ln1w + k), lb = *(const f32x4*)(ln1b + k);
#pragma unroll
                for (int r = 0; r < 2; ++r) {
                    v[r][j] = v[r][j] * rstd[r] * lw + lb;
                    *(h16x4*)(H + (size_t)(row + r) * DM + k) = cvt4(v[r][j]);
                    s[r] += (v[r][j][0] + v[r][j][1]) + (v[r][j][2] + v[r][j][3]);
                }
            }
#pragma unroll
            for (int r = 0; r < 2; ++r) { mean[r] = wave_sum(s[r]) * (1.f / DM); q[r] = 0.f; }
#pragma unroll
            for (int r = 0; r < 2; ++r)
#pragma unroll
                for (int j = 0; j < 8; ++j) { v[r][j] = v[r][j] - mean[r]; q[r] += (v[r][j][0] * v[r][j][0] + v[r][j][1] * v[r][j][1]) + (v[r][j][2] * v[r][j][2] + v[r][j][3] * v[r][j][3]); }
#pragma unroll
            for (int r = 0; r < 2; ++r) rstd[r] = 1.f / sqrtf(wave_sum(q[r]) * (1.f / DM) + EPS);
#pragma unroll
            for (int j = 0; j < 8; ++j) {
                const int k = j * 256 + lane * 4;
                const f32x4 sh = *(const f32x4*)(MOD + (size_t)b * ADAW + 3 * DM + k), sc = *(const f32x4*)(MOD + (size_t)b * ADAW + 4 * DM + k);
#pragma unroll
                for (int r = 0; r < 2; ++r) {
                    const f32x4 tt = v[r][j] * rstd[r] * (sc + 1.f) + sh;
                    const h16x4 hi = cvt4(tt);
                    int w8 = __builtin_amdgcn_cvt_pk_fp8_f32(tt[0], tt[1], 0, false); w8 = __builtin_amdgcn_cvt_pk_fp8_f32(tt[2], tt[3], w8, true);
                    *(int*)(A2q + (size_t)(row + r) * DM + k) = w8;
                    *(LAS h16x4*)(THI + rt_off(m + r, j * 32 + (lane >> 1)) + (lane & 1) * 8) = hi;
                }
            }
        }
        __syncthreads();
        f32x4 acc[2][3];
#pragma unroll
        for (int mt = 0; mt < 2; ++mt)
#pragma unroll
            for (int nt = 0; nt < 3; ++nt) acc[mt][nt] = (f32x4){0.f, 0.f, 0.f, 0.f};
#pragma unroll 4
        for (int s8 = 0; s8 < 8; ++s8) {
            const int c = wid * 32 + s8 * 4 + g;
            const h16x8 t0 = *(LAS h16x8*)(THI + rt_off(r16, c)), t1 = *(LAS h16x8*)(THI + rt_off(16 + r16, c));
#pragma unroll
            for (int nt = 0; nt < 3; ++nt) {
                const h16x8 wh = *(const h16x8*)(WRH + (size_t)(16 * nt + r16) * DM + c * 8);
                acc[0][nt] = mfma16(wh, t0, acc[0][nt]); acc[1][nt] = mfma16(wh, t1, acc[1][nt]);
            }
        }
        __syncthreads();
#pragma unroll
        for (int mt = 0; mt < 2; ++mt)
#pragma unroll
            for (int nt = 0; nt < 3; ++nt) red[(wid * 6 + mt * 3 + nt) * 64 + lane] = acc[mt][nt];
        __syncthreads();
        if (tid < 384) {
            const int t6 = tid >> 6, l2 = tid & 63, mt = t6 / 3, nt = t6 - 3 * mt;
            f32x4 sum = (f32x4){0.f, 0.f, 0.f, 0.f};
#pragma unroll
            for (int w = 0; w < 8; ++w) sum += red[(w * 6 + t6) * 64 + l2];
#pragma unroll
            for (int r = 0; r < 4; ++r) lg[(16 * mt + (l2 & 15)) * 48 + 16 * nt + 4 * (l2 >> 4) + r] = sum[r] * (1.f / 1024.f);
        }
        __syncthreads();
        if (tid < 32) {
            const int row = base + tid;
            const float* bg = a.in[I_RGB]; const float* be = a.in[I_REB];
            float glv[4];
#pragma unroll
            for (int c = 0; c < 4; ++c) glv[c] = lg[tid * 48 + c] + bg[c];
            int gs = 0; float gm = glv[0];
#pragma unroll
            for (int c = 1; c < 4; ++c) if (glv[c] > gm) { gm = glv[c]; gs = c; }
            float gden = 0.f;
#pragma unroll
            for (int c = 0; c < 4; ++c) gden += __expf(glv[c] - gm);
            const float gp = 1.f / gden;
            float el[8];
#pragma unroll
            for (int c = 0; c < 8; ++c) el[c] = lg[tid * 48 + 4 + gs * 8 + c] + be[gs * 8 + c];
            int i0 = 0; float v0 = el[0];
#pragma unroll
            for (int c = 1; c < 8; ++c) if (el[c] > v0) { v0 = el[c]; i0 = c; }
            int i1 = -1; float v1 = -3.0e38f;
#pragma unroll
            for (int c = 0; c < 8; ++c) if (c != i0 && el[c] > v1) { v1 = el[c]; i1 = c; }
            const float ex = __expf(v1 - v0), w0 = gp / (1.f + ex), w1 = gp * ex / (1.f + ex);
            asg_e[2 * tid] = gs * 8 + i0; asg_t[2 * tid] = row * 2; asg_w[2 * tid] = w0;
            asg_e[2 * tid + 1] = gs * 8 + i1; asg_t[2 * tid + 1] = row * 2 + 1; asg_w[2 * tid + 1] = w1;
        }
        __syncthreads();
        if (tid < NEXP) {
            int c = 0;
#pragma unroll 4
            for (int i = 0; i < 64; ++i) c += (asg_e[i] == tid) ? 1 : 0;
            if (c) {
                const int sub = tid * 8 + (blockIdx.x & 7);
                unsigned pos = atomicAdd(&CNT[sub], (unsigned)c);
                for (int i = 0; i < 64; ++i) if (asg_e[i] == tid) { LIST[(size_t)sub * SUBCAP + pos] = asg_t[i]; WL[(size_t)sub * SUBCAP + pos] = asg_w[i]; ++pos; }
            }
        }
        __syncthreads();
    }
}

struct MoeMap { int upre[NEXP + 1]; int rpre[NEXP + 1]; };
__device__ __forceinline__ void moe_map(const Args& a, LAS int* mp, int units_per_mtile) {
    const unsigned* CNT = (const unsigned*)(a.ws + WS_CTL) + CW_CNT;
    LAS int* c8 = mp + 448;
    if (threadIdx.x < NEXP * 8) c8[threadIdx.x] = (int)__hip_atomic_load(&CNT[threadIdx.x], __ATOMIC_RELAXED, __HIP_MEMORY_SCOPE_AGENT);
    __syncthreads();
    if (threadIdx.x < NEXP) {
        int acc = 0;
        for (int x = 0; x < 8; ++x) { mp[128 + 9 * threadIdx.x + x] = acc; acc += c8[threadIdx.x * 8 + x]; }
        mp[128 + 9 * threadIdx.x + 8] = acc; mp[66 + threadIdx.x] = acc;
    }
    __syncthreads();
    if (threadIdx.x == 0) {
        int up = 0, rp = 0;
        for (int e = 0; e < NEXP; ++e) {
            const int c = mp[66 + e];
            const int ntm = (c + 255) >> 8;
            mp[e] = up; mp[33 + e] = rp;
            up += ntm * units_per_mtile; rp += ntm * 256;
        }
        mp[32] = up; mp[65] = rp;
    }
    __syncthreads();
}
__device__ __forceinline__ int moe_pos(const LAS int* mp, int e, int idx) {
    const LAS int* sp = mp + 128 + 9 * e;
    int x = 0;
#pragma unroll
    for (int i = 1; i < 8; ++i) x += (idx >= sp[i]) ? 1 : 0;
    return (e * 8 + x) * SUBCAP + idx - sp[x];
}
__device__ __forceinline__ void wdown_pool(const Args& a, LAS char* lds, int budget);
__device__ __forceinline__ void phase_moe1(const Args& a, LAS char* lds, int vcu) {
    GemmThread G; G.init();
    LAS int* mp = (LAS int*)(lds + LDS_MAP);
    moe_map(a, mp, 8);
    const unsigned char* A2q = (const unsigned char*)(a.ws + WS_A2); const int* LIST = (const int*)(a.ws + WS_LIST); unsigned char* HID = (unsigned char*)(a.ws + WS_HID);
    const int NU = mp[32];
    for (int p = vcu; p < NU; p += gridDim.x) {
        int e = 0;
        while (p >= mp[e + 1]) ++e;
        const int q = p - mp[e], cnt = mp[66 + e], ntm = (cnt + 255) >> 8, nt = q / ntm, mt = q % ntm;
        const unsigned char* arow[2];
#pragma unroll
        for (int i = 0; i < 2; ++i) {
            const int idx = mt * 256 + (G.tid >> 2) + 128 * i;
            const int tok = (idx < cnt) ? (LIST[moe_pos(mp, e, idx)] >> 1) : 0;
            arow[i] = A2q + (size_t)tok * DM + (G.tid & 3) * 16;
        }
        const int c = (G.tid & 31) * 4, wnc = c >> 6, within = c & 63;
        const float* wsrc = (within >= 32) ? a.in[I_EWU] : a.in[I_EWG];
        const float* bcol = wsrc + (size_t)e * DM * DE + (size_t)(G.tid >> 5) * DE + nt * 64 + wnc * 32 + (within & 31);
        f32x4 acc[4][4];
        gemm_tile(lds, G, arow, bcol, (size_t)DE, DM / 64, acc);
        {
#pragma unroll
            for (int mi = 0; mi < 4; ++mi) {
                unsigned char* dst = HID + (size_t)(mp[33 + e] + mt * 256) * DE + nt * 16384 + (G.wm * 64 + mi * 16 + G.r16) * 64 + G.wn * 32 + 4 * G.g;
#pragma unroll
                for (int ni = 0; ni < 2; ++ni) {
                    f32x4 o;
#pragma unroll
                    for (int r = 0; r < 4; ++r) o[r] = silu_f(acc[mi][ni][r]) * acc[mi][ni + 2][r];
                    int w8 = __builtin_amdgcn_cvt_pk_fp8_f32(o[0], o[1], 0, false); w8 = __builtin_amdgcn_cvt_pk_fp8_f32(o[2], o[3], w8, true);
                    *(int*)(dst + ni * 16) = w8;
                }
            }
        }
    }
    wdown_pool(a, lds, 1 << 20);
}
constexpr int POOL_ITEMS = (NEXP * DE * DM / 8) / (NTHREADS * 8);
__device__ __forceinline__ void wdown_pool(const Args& a, LAS char* lds, int budget) {
    unsigned* head = (unsigned*)(a.ws + WS_CTL) + CW_POOL;
    const float* W = a.in[I_EWD]; h16* O = (h16*)(a.ws + WS_WD16);
    LAS unsigned* slot = (LAS unsigned*)(lds + LDS_MAP + 400);
    for (int it = 0; it < budget; ++it) {
        __syncthreads();
        if (threadIdx.x == 0) *slot = atomicAdd(head, 1u);
        __syncthreads();
        const unsigned item = *slot;
        if (item >= (unsigned)POOL_ITEMS) break;
        const size_t base = (size_t)item * (NTHREADS * 8) + threadIdx.x;
        f32x4 v[8][2];
#pragma unroll
        for (int j = 0; j < 8; ++j) { const float* p = W + (base + (size_t)j * NTHREADS) * 8; v[j][0] = *(const f32x4*)p; v[j][1] = *(const f32x4*)(p + 4); }
#pragma unroll
        for (int j = 0; j < 8; ++j) {
            h16x8 o;
#pragma unroll
            for (int e = 0; e < 4; ++e) { o[e] = (h16)v[j][0][e]; o[4 + e] = (h16)v[j][1][e]; }
            *(h16x8*)(O + (base + (size_t)j * NTHREADS) * 8) = o;
        }
    }
}
__device__ __forceinline__ void phase_moe2(const Args& a, LAS char* lds, int vcu) {
    GemmThread G; G.init();
    LAS int* mp = (LAS int*)(lds + LDS_MAP);
    moe_map(a, mp, 16);
    const unsigned char* HID = (const unsigned char*)(a.ws + WS_HID); const int* LIST = (const int*)(a.ws + WS_LIST); const float* WL = (const float*)(a.ws + WS_WL);
    const h16* WD16 = (const h16*)(a.ws + WS_WD16); h16* Y = (h16*)(a.ws + WS_Y);
    const int NU = mp[32];
    G3Stream S; S.gs = 0; S.primed = false;
    for (int p = vcu; p < NU; p += gridDim.x) {
        int e = 0;
        while (p >= mp[e + 1]) ++e;
        const int q = p - mp[e], cnt = mp[66 + e], ntm = (cnt + 255) >> 8, nt = q / ntm, mt = q % ntm;
        const int pn = p + (int)gridDim.x; const bool hn = pn < NU;
        const unsigned char* nA = nullptr; const h16* nB = nullptr;
        if (hn) { int e2 = e; while (pn >= mp[e2 + 1]) ++e2;
            const int q2 = pn - mp[e2], ntm2 = (mp[66 + e2] + 255) >> 8, nt2 = q2 / ntm2, mt2 = q2 % ntm2;
            nA = HID + (size_t)(mp[33 + e2] + mt2 * 256) * DE; nB = WD16 + (size_t)e2 * DE * DM + nt2 * 128; }
        f32x4 acc[4][4];
        gemm_tile_g8(lds, G, HID + (size_t)(mp[33 + e] + mt * 256) * DE, DE, WD16 + (size_t)e * DE * DM + nt * 128, DM, DE / 64, acc, S, nA, nB);
        {
#pragma unroll
            for (int mi = 0; mi < 4; ++mi) {
                const int idx = mt * 256 + G.wm * 64 + mi * 16 + G.r16;
                const bool ok = idx < cnt;
                const int lp = moe_pos(mp, e, ok ? idx : 0); const int slot = LIST[lp]; const float w = WL[lp];
                u32x4 v[2];
                acc_rows16(acc[mi], w, v);
                if (ok) {
                    h16* dst = Y + (size_t)slot * DM + nt * 128 + G.wn * 64 + 8 * G.g;
                    *(u32x4*)dst = v[0]; *(u32x4*)(dst + 32) = v[1];
                }
            }
        }
    }
}

__device__ __forceinline__ void phase_final(const Args& a) {
    const int tid = threadIdx.x, lane = tid & 63, wid = tid >> 6;
    const h16* H = (const h16*)(a.ws + WS_H); const h16* Y = (const h16*)(a.ws + WS_Y); const float* MOD = (const float*)(a.ws + WS_MOD);
    const float* w2 = a.in[I_LN2W]; const float* b2 = a.in[I_LN2B];
    for (int row = blockIdx.x * 16 + 2 * wid; row < T; row += gridDim.x * 16) {
        const int b = row >> 11;
        f32x4 v[2][8]; float s[2] = {0.f, 0.f};
#pragma unroll
        for (int j = 0; j < 8; ++j) {
            const int k = j * 256 + lane * 4;
            const f32x4 g2 = *(const f32x4*)(MOD + (size_t)b * ADAW + 5 * DM + k);
#pragma unroll
            for (int r = 0; r < 2; ++r) {
                const h16x4 h4 = *(const h16x4*)(H + (size_t)(row + r) * DM + k);
                const h16x4 y0 = *(const h16x4*)(Y + (size_t)((row + r) * 2) * DM + k), y1 = *(const h16x4*)(Y + (size_t)((row + r) * 2 + 1) * DM + k);
                f32x4 hv, yv;
#pragma unroll
                for (int e = 0; e < 4; ++e) { hv[e] = (float)h4[e]; yv[e] = (float)y0[e] + (float)y1[e]; }
                v[r][j] = hv * ALPHA + g2 * yv;
                s[r] += (v[r][j][0] + v[r][j][1]) + (v[r][j][2] + v[r][j][3]);
            }
            if (j == 3) __builtin_amdgcn_sched_barrier(0);
        }
        float mean[2], q[2] = {0.f, 0.f}, rstd[2];
#pragma unroll
        for (int r = 0; r < 2; ++r) mean[r] = wave_sum(s[r]) * (1.f / DM);
#pragma unroll
        for (int r = 0; r < 2; ++r)
#pragma unroll
            for (int j = 0; j < 8; ++j) { v[r][j] = v[r][j] - mean[r]; q[r] += (v[r][j][0] * v[r][j][0] + v[r][j][1] * v[r][j][1]) + (v[r][j][2] * v[r][j][2] + v[r][j][3] * v[r][j][3]); }
#pragma unroll
        for (int r = 0; r < 2; ++r) rstd[r] = 1.f / sqrtf(wave_sum(q[r]) * (1.f / DM) + EPS);
#pragma unroll
        for (int j = 0; j < 8; ++j) {
            const int k = j * 256 + lane * 4;
            const f32x4 lw = *(const f32x4*)(w2 + k), lb = *(const f32x4*)(b2 + k);
#pragma unroll
            for (int r = 0; r < 2; ++r) *(f32x4*)(a.out + (size_t)(row + r) * DM + k) = v[r][j] * rstd[r] * lw + lb;
        }
    }
}

constexpr int NPHASE = 13;
#ifndef REP_PHASE
#define REP_PHASE -1
#endif
#ifndef ONE_LAUNCH
#define ONE_LAUNCH 1
#endif
__global__ void __launch_bounds__(NTHREADS, 2) mega(Args a) {
    extern __shared__ __attribute__((aligned(16))) unsigned char lds_raw[];
    LAS char* lds = (LAS char*)lds_raw;
    volatile LAS unsigned* misc = (volatile LAS unsigned*)(lds + LDS_MISC);
    if (threadIdx.x < 64) misc[threadIdx.x] = 0u;
    __syncthreads();
    const int G_ = gridDim.x, bx = blockIdx.x;
    const int vcu = (G_ % 8 == 0) ? (bx % 8) * (G_ / 8) + bx / 8 : bx;
    XcdBarrier bar; bar.bar = (unsigned*)(a.ws + WS_CTL) + CW_BAR; bar.x = 0; bar.st = misc + 8;
    if (ONE_LAUNCH) bar = xcd_barrier_post((unsigned*)(a.ws + WS_CTL) + CW_BAR, misc + 8);
    const int lo = a.ph_lo, hi = a.ph_hi;
#ifndef PH_MASK
#define PH_MASK 0x1fff
#endif
#define IN(k) (((PH_MASK >> (k)) & 1) && lo <= (k) && (k) < hi)
#define SEAM(k) do { if (IN(k) && IN((k) + 1)) xcd_barrier(bar); } while (0)
    if (IN(0)) { phase_cvt(a); phase_adaln(a, lds); }
    SEAM(0);
    if (IN(1)) phase_modulate(a, lds);
    SEAM(1);
    if (IN(2)) phase_inproj(a, lds, vcu, 0);
    SEAM(2);
    if (IN(3)) phase_mid(a, lds, vcu);
    if (IN(3) && IN(4)) xcd_barrier(bar);
    if (IN(5)) phase_ret_scan(a);
    SEAM(5);
    if (IN(6)) phase_attn(a, lds, vcu);
    if (IN(7)) phase_retout(a, lds, vcu);
    SEAM(7);
    if (IN(8)) phase_oproj(a, lds, vcu);
    SEAM(8);
    if (IN(9)) phase_router(a, lds);
    SEAM(9);
    if (IN(10)) phase_moe1(a, lds, vcu);
    SEAM(10);
    if (IN(11)) phase_moe2(a, lds, vcu);
    SEAM(11);
    if (IN(12)) phase_final(a);
}

extern "C" void kernel_launch(void* const* d_in, const int* in_sizes, int n_in, void* d_out, int out_size, void* d_ws, size_t ws_size, hipStream_t stream) {
    static int grid = 0;
    if (grid == 0) {
        if (n_in != 25 || out_size != T * DM || ws_size < WS_END) { fprintf(stderr, "kernel_launch: unexpected shapes: n_in %d out %d ws %zu (need %zu)\n", n_in, out_size, ws_size, (size_t)WS_END); grid = -1; return; }
        int dev = 0, cus = 0, per_cu = 0;
        if (hipGetDevice(&dev) != hipSuccess || hipDeviceGetAttribute(&cus, hipDeviceAttributeMultiprocessorCount, dev) != hipSuccess) { grid = -1; return; }
        if (hipFuncSetAttribute((const void*)mega, hipFuncAttributeMaxDynamicSharedMemorySize, LDS_BYTES) != hipSuccess) { fprintf(stderr, "kernel_launch: hipFuncSetAttribute failed\n"); grid = -1; return; }
        if (hipOccupancyMaxActiveBlocksPerMultiprocessor(&per_cu, (const void*)mega, NTHREADS, LDS_BYTES) != hipSuccess || per_cu < 1) { fprintf(stderr, "kernel_launch: occupancy query says %d blocks per CU\n", per_cu); }
        (void)hipGetLastError();
        grid = cus;
    }
    if (grid < 0) return;
    (void)hipMemsetAsync((char*)d_ws + WS_CTL, 0, CTL_BYTES, stream);
    Args a{};
    for (int i = 0; i < 25; ++i) a.in[i] = (const float*)d_in[i];
    a.out = (float*)d_out; a.ws = (unsigned char*)d_ws;
    if (ONE_LAUNCH) {
        a.ph_lo = 0; a.ph_hi = NPHASE;
        hipLaunchKernelGGL(mega, dim3(grid), dim3(NTHREADS), LDS_BYTES, stream, a);
    } else {
        for (int p = 0; p < NPHASE; ++p) { a.ph_lo = p; a.ph_hi = p + 1;
            for (int r = 0; r < 1 + (p == REP_PHASE); ++r) {
                if (p == 9) (void)hipMemsetAsync((char*)d_ws + WS_CTL, 0, CTL_BYTES, stream);
                hipLaunchKernelGGL(mega, dim3(grid), dim3(NTHREADS), LDS_BYTES, stream, a); } }
    }
    const hipError_t le = hipPeekAtLastError();
    if (le != hipSuccess) fprintf(stderr, "kernel_launch: launch failed: %s\n", hipGetErrorName(le));
}
```

```cpp
#include <hip/hip_runtime.h>
#include <cstdio>
#include <cstdint>

#ifndef REP_MASK
#define REP_MASK 0
#endif
#define REP(k) ((REP_MASK >> (k)) & 1)
#define LAS __attribute__((address_space(3)))
#define GAS __attribute__((address_space(1)))
typedef _Float16 h16;
typedef _Float16 h16x8 __attribute__((ext_vector_type(8)));
typedef _Float16 h16x4 __attribute__((ext_vector_type(4)));
typedef _Float16 h16x2 __attribute__((ext_vector_type(2)));
typedef float f32x4 __attribute__((ext_vector_type(4)));
typedef float f32x2 __attribute__((ext_vector_type(2)));
typedef float f32x16 __attribute__((ext_vector_type(16)));
typedef unsigned u32x4 __attribute__((ext_vector_type(4)));
typedef unsigned u32x2 __attribute__((ext_vector_type(2)));
typedef short s16x4v __attribute__((__vector_size__(8)));

constexpr int DM = 2048, NB = 4, SEQ = 2048, LC = 256, LK = LC + SEQ;
constexpr int T = NB * SEQ, TCX = NB * LC, TA = T + TCX;
constexpr int INW = 4928, NEXP = 32, DE = 512;
constexpr int ADAW = 6 * DM;
constexpr float EPS = 1e-6f, ALPHA = 1.189207115002721f;
constexpr float KSCALE = 0.08838834764831845f;
constexpr float L2_10000 = 13.287712379549449f;
constexpr int NTHREADS = 512;

constexpr size_t al256(size_t x) { return (x + 255) / 256 * 256; }
constexpr size_t WS_CTL = 0, CTL_BYTES = 65536;
constexpr size_t WS_PART = WS_CTL + CTL_BYTES;
constexpr size_t WS_MOD = WS_PART + al256((size_t)8 * 5 * ADAW * 4);
constexpr size_t WS_A1 = WS_MOD + al256((size_t)5 * ADAW * 4);
constexpr size_t WS_QR = WS_A1 + al256((size_t)TA * DM * 2);
constexpr size_t WS_KR = WS_QR + al256((size_t)T * 1024 * 2);
constexpr size_t WS_VR = WS_KR + al256((size_t)T * 1024 * 2);
constexpr size_t WS_KC = WS_VR + al256((size_t)T * 1024 * 2);
constexpr size_t WS_VC = WS_KC + al256((size_t)TCX * 1024 * 2);
constexpr size_t WS_GS = WS_VC + al256((size_t)TCX * 1024 * 2);
constexpr size_t WS_CQ = WS_GS + al256((size_t)T * 1024 * 2);
constexpr size_t WS_CKV = WS_CQ + al256((size_t)T * 512 * 2);
constexpr size_t WS_KPE = WS_CKV + al256((size_t)NB * LK * 256 * 2);
constexpr size_t WS_Q = WS_KPE + al256((size_t)NB * LK * 64 * 2);
constexpr size_t WS_KN = WS_Q + al256((size_t)T * 1536 * 2);
constexpr size_t WS_VV = WS_KN + al256((size_t)NB * 8 * LK * 128 * 2);
constexpr size_t WS_UF = WS_VV + al256((size_t)NB * 8 * LK * 128 * 2);
constexpr size_t WS_UB = WS_UF + al256((size_t)32 * 16 * 16384 * 4);
constexpr size_t WS_S0F = WS_UB + al256((size_t)32 * 16 * 16384 * 4);
constexpr size_t WS_S0B = WS_S0F + al256((size_t)32 * 16384 * 4);
constexpr size_t WS_SF = WS_S0B + al256((size_t)32 * 16384 * 4);
constexpr size_t WS_SB = WS_SF + al256((size_t)32 * 16 * 16384 * 2);
constexpr size_t WS_MIX = WS_SB + al256((size_t)32 * 16 * 16384 * 2);
constexpr size_t WS_U = WS_MIX + al256((size_t)T * DM * 2);
constexpr size_t WS_H = WS_U + al256((size_t)T * DM * 2);
constexpr size_t WS_A2 = WS_H + al256((size_t)T * DM * 2);
constexpr int SUBCAP = 2048;
constexpr size_t WS_LIST = WS_A2 + al256((size_t)T * DM * 2);
constexpr size_t WS_WL = WS_LIST + al256((size_t)NEXP * 8 * SUBCAP * 4);
constexpr int HID_ROWS = 2 * T + NEXP * 256;
constexpr size_t WS_HID = WS_WL + al256((size_t)NEXP * 8 * SUBCAP * 4);
constexpr size_t WS_Y = WS_HID + al256((size_t)HID_ROWS * DE * 2);
constexpr int WINP = 5120;
constexpr size_t WS_WIN16 = WS_Y + al256((size_t)2 * T * DM * 2);
constexpr size_t WS_WO16 = WS_WIN16 + al256((size_t)DM * WINP * 2);
constexpr size_t WS_WUQ16 = WS_WO16 + al256((size_t)DM * DM * 2);
constexpr size_t WS_WUKV16 = WS_WUQ16 + al256((size_t)512 * 1536 * 2);
constexpr size_t WS_WRH = WS_WUKV16 + al256((size_t)256 * 2048 * 2);
constexpr size_t WS_WRL = WS_WRH + al256((size_t)48 * DM * 2);
constexpr size_t WS_WD16 = WS_WRL + al256((size_t)48 * DM * 2);
constexpr size_t WS_END = WS_WD16 + al256((size_t)NEXP * DE * DM * 2);

constexpr int CW_CNT = 256;
constexpr int CW_POOL = 128;
constexpr int CW_BAR = 1024;

constexpr int LDS_BYTES = 151808;
constexpr int LDS_ROWS = 147456;
constexpr int LDS_MAP = 148480;
constexpr int LDS_MISC = 151552;

template <int M> __device__ __forceinline__ float swz_xor(float v) {
    return __int_as_float(__builtin_amdgcn_ds_swizzle(__float_as_int(v), 0x1F | (M << 10)));
}
__device__ __forceinline__ float wave_sum(float v) {
    v += swz_xor<1>(v); v += swz_xor<2>(v); v += swz_xor<4>(v); v += swz_xor<8>(v); v += swz_xor<16>(v);
    { auto rr = __builtin_amdgcn_permlane32_swap(__float_as_uint(v), __float_as_uint(v), false, false); v = __uint_as_float(rr[0]) + __uint_as_float(rr[1]); }
    return v;
}
__device__ __forceinline__ float silu_f(float x) { return x / (1.f + __expf(-x)); }
__device__ __forceinline__ h16x4 cvt4(f32x4 v) { h16x4 r; r[0] = (h16)v[0]; r[1] = (h16)v[1]; r[2] = (h16)v[2]; r[3] = (h16)v[3]; return r; }
__device__ __forceinline__ h16x4 trrd(LAS char* p) { s16x4v t = __builtin_amdgcn_ds_read_tr16_b64_v4i16((LAS s16x4v*)p); return __builtin_bit_cast(h16x4, t); }
__device__ __forceinline__ h16x8 cat8(h16x4 a, h16x4 b) { return __builtin_shufflevector(a, b, 0, 1, 2, 3, 4, 5, 6, 7); }
__device__ __forceinline__ f32x4 mfma16(h16x8 a, h16x8 b, f32x4 c) { return __builtin_amdgcn_mfma_f32_16x16x32_f16(a, b, c, 0, 0, 0); }

__device__ __forceinline__ int a_off(int row, int ch) { return row * 128 + ((ch ^ (row & 7)) << 4); }
__device__ __forceinline__ int off_b(int row, int ch) { return 256 * row + 16 * (ch ^ (((row & 3) << 2) | ((row >> 2) & 3))); }
__device__ __forceinline__ int tr_addr16(int lane, int c, int ks, int t) {
    const int g = lane >> 4, q = (lane & 15) >> 2, p = lane & 3;
    return off_b(32 * ks + 8 * g + 4 * t + q, 2 * c + (p >> 1)) + 8 * (p & 1);
}
__device__ __forceinline__ int row_addr16(int lane, int rb, int s) { return off_b((lane & 15) + 16 * rb, 4 * s + (lane >> 4)); }

#define XB_TMO      128
#define XB_XCNT(j)  (256  + 64 * (j))
#define XB_XSUB(j)  (1280 + 64 * (j))
#define XB_XGEN(j)  (2304 + 64 * (j))
#define XB_TOP      3328
#define XB_TOPGEN   3392
#define XCD_BAR_WORDS 3456
#define XB_SPIN_CAP (1u << 22)
__device__ __forceinline__ unsigned xb_ld(unsigned* p)              { return __hip_atomic_load(p, __ATOMIC_RELAXED, __HIP_MEMORY_SCOPE_AGENT); }
__device__ __forceinline__ unsigned xb_add(unsigned* p, unsigned v) { return __hip_atomic_fetch_add(p, v, __ATOMIC_RELAXED, __HIP_MEMORY_SCOPE_AGENT); }
__device__ __forceinline__ unsigned xb_xcc_id() { return (unsigned)__builtin_amdgcn_s_getreg((3 << 11) | 20) & 0xFu; }
#define XB_SPIN(cond, bar) do { unsigned _sp = 0; while (cond) { __builtin_amdgcn_s_sleep(1); \
    if ((++_sp & 255u) == 0u) { if (xb_ld(&(bar)[XB_TMO])) break; if (_sp > XB_SPIN_CAP) { atomicAdd(&(bar)[XB_TMO], 1u); break; } } } } while (0)
struct XcdBarrier { unsigned* bar; unsigned x; volatile LAS unsigned* st; };
__device__ __forceinline__ XcdBarrier xcd_barrier_post(unsigned* bar, volatile LAS unsigned* st) {
    XcdBarrier b; b.bar = bar; b.x = xb_xcc_id(); b.st = st;
    if (threadIdx.x == 0) (void)xb_add(&bar[XB_XCNT(b.x)], 1u);
    return b;
}
__device__ __forceinline__ void xcd_barrier_complete(unsigned* bar, unsigned x, unsigned& nloc, unsigned& nx) {
    const unsigned G = gridDim.x * gridDim.y * gridDim.z;
    unsigned sum, cnt, mine, sp = 0u;
    for (;;) {
        sum = 0u; cnt = 0u; mine = 0u;
#pragma unroll
        for (unsigned j = 0; j < 16; ++j) { const unsigned c = xb_ld(&bar[XB_XCNT(j)]); sum += c; cnt += (c > 0u) ? 1u : 0u; mine = (j == x) ? c : mine; }
        if (sum == G) break;
        __builtin_amdgcn_s_sleep(1);
        if ((++sp & 255u) == 0u) { if (xb_ld(&bar[XB_TMO])) break; if (sp > XB_SPIN_CAP) { atomicAdd(&bar[XB_TMO], 1u); break; } }
    }
    nloc = mine > 0u ? mine : 1u; nx = cnt > 0u ? cnt : 1u;
}
__device__ __forceinline__ void xcd_barrier(const XcdBarrier& b) {
    asm volatile("s_waitcnt vmcnt(0)" ::: "memory");
    __syncthreads();
    if (threadIdx.x == 0) {
        unsigned* bar = b.bar;
        __builtin_amdgcn_s_waitcnt(0);
        unsigned nloc = b.st[0], nx = b.st[1];
        if (nloc == 0u) { xcd_barrier_complete(bar, b.x, nloc, nx); b.st[0] = nloc; b.st[1] = nx; }
        const unsigned old = xb_add(&bar[XB_XSUB(b.x)], 1u);
        const unsigned gen = old / nloc;
        if (old + 1u == (gen + 1u) * nloc) {
            __builtin_amdgcn_fence(__ATOMIC_RELEASE, "agent");
            asm volatile("s_waitcnt vmcnt(0)" ::: "memory");
            const unsigned og = xb_add(&bar[XB_TOP], 1u);
            const unsigned tg = og / nx;
            if (og + 1u == (tg + 1u) * nx) xb_add(&bar[XB_TOPGEN], 1u);
            else XB_SPIN(xb_ld(&bar[XB_TOPGEN]) == tg, bar);
            __builtin_amdgcn_fence(__ATOMIC_ACQUIRE, "agent");
            xb_add(&bar[XB_XGEN(b.x)], 1u);
            asm volatile("s_waitcnt vmcnt(0)" ::: "memory");
        } else {
            XB_SPIN(xb_ld(&bar[XB_XGEN(b.x)]) == gen, bar);
            __builtin_amdgcn_fence(__ATOMIC_ACQUIRE, "agent");
            asm volatile("s_waitcnt vmcnt(0)" ::: "memory");
        }
    }
    __syncthreads();
}

struct Args {
    const float* in[25];
    float* out;
    unsigned char* ws;
    int ph_lo, ph_hi;
};
enum { I_X = 0, I_C, I_CTX, I_CCTX, I_WADA, I_BADA, I_WIN, I_RDEC, I_RGN, I_QNORM, I_KVNORM, I_WUQ, I_WUKV, I_WO, I_LN1W, I_LN1B,
       I_RGW, I_RGB, I_REW, I_REB, I_EWG, I_EWU, I_EWD, I_LN2W, I_LN2B };

__device__ __forceinline__ void wdown_pool(const Args& a, LAS char* lds, int budget);
constexpr int GEMM_STAGE = 49152, GEMM_ROWS_OFF = LDS_ROWS;
struct GemmThread {
    int tid, lane, wid, wm, wn, r16, g;
    int a_st;
    int b_st;
    int ta[2];
    int tb[4][2];
    __device__ __forceinline__ void init(bool opaque = false) {
        tid = threadIdx.x; if (opaque) asm volatile("" : "+v"(tid));
        lane = tid & 63; wid = __builtin_amdgcn_readfirstlane(tid >> 6); wm = wid >> 1; wn = wid & 1; r16 = lane & 15; g = lane >> 4;
        a_st = a_off(tid >> 3, tid & 7);
        const int nq = tid & 31, kk = tid >> 5;
        b_st = off_b(kk, nq >> 1) + (nq & 1) * 8;
#pragma unroll
        for (int ks = 0; ks < 2; ++ks) ta[ks] = a_off(wm * 64 + r16, ks * 4 + g);
#pragma unroll
        for (int ni = 0; ni < 4; ++ni)
#pragma unroll
            for (int t = 0; t < 2; ++t) tb[ni][t] = tr_addr16(lane, wn * 4 + ni, 0, t);
    }
};

typedef _Float16 h16x2v __attribute__((ext_vector_type(2)));
__device__ __forceinline__ h16x8 fp8x8_to_h16(unsigned w0, unsigned w1) {
    const h16x2v a = __builtin_amdgcn_cvt_scalef32_pk_f16_fp8((int)w0, 1.0f, false), b = __builtin_amdgcn_cvt_scalef32_pk_f16_fp8((int)w0, 1.0f, true);
    const h16x2v c = __builtin_amdgcn_cvt_scalef32_pk_f16_fp8((int)w1, 1.0f, false), d = __builtin_amdgcn_cvt_scalef32_pk_f16_fp8((int)w1, 1.0f, true);
    h16x8 r; r[0] = a[0]; r[1] = a[1]; r[2] = b[0]; r[3] = b[1]; r[4] = c[0]; r[5] = c[1]; r[6] = d[0]; r[7] = d[1];
    return r;
}
__device__ __forceinline__ void gemm_tile(LAS char* lds, const GemmThread& G, const unsigned char* const (&arow)[2], const float* bcol, size_t ldb,
                                          int nk, f32x4 (&acc)[4][4]) {
#pragma unroll
    for (int i = 0; i < 4; ++i)
#pragma unroll
        for (int j = 0; j < 4; ++j) acc[i][j] = (f32x4){0.f, 0.f, 0.f, 0.f};
    u32x4 ar0[2], ar1[2]; f32x4 br0[4], br1[4];
    const int aq0 = a_off(G.tid >> 2, 2 * (G.tid & 3)), aq1 = a_off(G.tid >> 2, 2 * (G.tid & 3) + 1);
#define GT_LOAD(AR, BR, kt) do { _Pragma("unroll") for (int i = 0; i < 2; ++i) AR[i] = *(const u32x4*)(arow[i] + (size_t)(kt) * 64); \
        _Pragma("unroll") for (int i = 0; i < 4; ++i) BR[i] = *(const f32x4*)(bcol + (size_t)((kt) * 64 + 16 * i) * ldb); } while (0)
#define GT_STORE(AR, BR, buf) do { LAS char* Ab_ = lds + (buf) * GEMM_STAGE; _Pragma("unroll") for (int i = 0; i < 2; ++i) { \
        *(LAS h16x8*)(Ab_ + aq0 + i * 16384) = fp8x8_to_h16(AR[i][0], AR[i][1]); *(LAS h16x8*)(Ab_ + aq1 + i * 16384) = fp8x8_to_h16(AR[i][2], AR[i][3]); } \
        _Pragma("unroll") for (int i = 0; i < 4; ++i) *(LAS h16x4*)(Ab_ + 32768 + G.b_st + i * 4096) = cvt4(BR[i]); } while (0)
#define GT_COMP(buf) do { LAS char* Ab = lds + (buf) * GEMM_STAGE; LAS char* Bb = Ab + 32768; \
        _Pragma("unroll") for (int ks = 0; ks < 2; ++ks) { h16x8 bf[4], af[4]; \
            _Pragma("unroll") for (int ni = 0; ni < 4; ++ni) bf[ni] = cat8(trrd(Bb + G.tb[ni][0] + ks * 8192), trrd(Bb + G.tb[ni][1] + ks * 8192)); \
            _Pragma("unroll") for (int mi = 0; mi < 4; ++mi) af[mi] = *(LAS h16x8*)(Ab + G.ta[ks] + mi * 2048); \
            _Pragma("unroll") for (int mi = 0; mi < 4; ++mi) _Pragma("unroll") for (int ni = 0; ni < 4; ++ni) acc[mi][ni] = mfma16(bf[ni], af[mi], acc[mi][ni]); } } while (0)
    __syncthreads();
    GT_LOAD(ar0, br0, 0);
    GT_LOAD(ar1, br1, 1);
    GT_STORE(ar0, br0, 0);
    __syncthreads();
    int kt = 0;
    for (; kt + 2 < nk; kt += 2) {
        GT_LOAD(ar0, br0, kt + 2); __builtin_amdgcn_sched_barrier(0);
        GT_COMP(0); __builtin_amdgcn_sched_barrier(0);
        GT_STORE(ar1, br1, 1);
        __syncthreads();
        GT_LOAD(ar1, br1, kt + 3); __builtin_amdgcn_sched_barrier(0);
        GT_COMP(1); __builtin_amdgcn_sched_barrier(0);
        GT_STORE(ar0, br0, 0);
        __syncthreads();
    }
    GT_COMP(0);
    GT_STORE(ar1, br1, 1);
    __syncthreads();
    GT_COMP(1);
#undef GT_LOAD
#undef GT_STORE
#undef GT_COMP
}

typedef short s16x4 __attribute__((ext_vector_type(4)));
template <int OFF> __device__ __forceinline__ s16x4 asm_tr(int addr) { s16x4 r; asm volatile("ds_read_b64_tr_b16 %0, %1 offset:%2" : "=v"(r) : "v"(addr), "i"(OFF) : "memory"); return r; }
template <int OFF> __device__ __forceinline__ h16x8 asm_rd128(int addr) { h16x8 r; asm volatile("ds_read_b128 %0, %1 offset:%2" : "=v"(r) : "v"(addr), "i"(OFF) : "memory"); return r; }
#define LGKM0() do { asm volatile("s_waitcnt lgkmcnt(0)" ::: "memory"); __builtin_amdgcn_sched_barrier(0); } while (0)
__device__ __forceinline__ h16x8 cat8s(s16x4 a, s16x4 b) { return __builtin_bit_cast(h16x8, __builtin_shufflevector(a, b, 0, 1, 2, 3, 4, 5, 6, 7)); }
struct G3Stream { int gs; bool primed; };
template <bool RMS>
__device__ __forceinline__ void gemm_tile_g(LAS char* lds, const GemmThread& G, const h16* Ab, int lda, const h16* Bb, int ldb, int nk, f32x4 (&acc)[4][4],
                                            G3Stream& S, const h16* nAb, const h16* nBb) {
#pragma unroll
    for (int i = 0; i < 4; ++i)
#pragma unroll
        for (int j = 0; j < 4; ++j) acc[i][j] = (f32x4){0.f, 0.f, 0.f, 0.f};
    float ss[4] = {0.f, 0.f, 0.f, 0.f};
    const bool loader = G.wid < 4; const int wq = G.wid & 3;
    const size_t a_i = (size_t)64 * lda, a_h = (size_t)32 * lda, b_i = (size_t)32 * ldb, b_h = (size_t)16 * ldb, b_k = (size_t)64 * ldb;
    const size_t lane_a = (size_t)(8 * wq + (G.lane >> 3)) * lda + (((G.lane & 7) ^ (G.lane >> 3)) << 3);
    const size_t lane_b = (size_t)(4 * wq + (G.lane >> 4)) * ldb + (((G.lane & 15) ^ (((G.lane >> 4) << 2) | wq)) << 3);
    const bool has_next = (nAb != nullptr);
    const h16* asrc = Ab + lane_a; const h16* bsrc = Bb + lane_b;
    const h16* nasrc = (has_next ? nAb : Ab) + lane_a; const h16* nbsrc = (has_next ? nBb : Bb) + lane_b;
    LAS char* wbase = lds + wq * 1024;
    const int lbase = (int)(uintptr_t)lds;
#define G3_ISSUE_(AS, BS, kt, st) do { LAS char* sb_ = wbase + (st) * GEMM_STAGE; \
        _Pragma("unroll") for (int h = 0; h < 2; ++h) { \
        _Pragma("unroll") for (int i = 0; i < 4; ++i) __builtin_amdgcn_global_load_lds((const unsigned*)((AS) + i * a_i + h * a_h + (size_t)(kt) * 64), (LAS unsigned*)(sb_ + h * 4096 + i * 8192), 16, 0, 0); \
        _Pragma("unroll") for (int i = 0; i < 2; ++i) __builtin_amdgcn_global_load_lds((const unsigned*)((BS) + i * b_i + h * b_h + (size_t)(kt) * b_k), (LAS unsigned*)(sb_ + 32768 + h * 4096 + i * 8192), 16, 0, 0); } } while (0)
#define G3_ISSUE(kt, st) G3_ISSUE_(asrc, bsrc, kt, st)
#define G3_READ(BF, AF, KS) do { \
        BF[0] = cat8s(asm_tr<32768 + (KS) * 8192>(sbase + G.tb[0][0]), asm_tr<32768 + (KS) * 8192>(sbase + G.tb[0][1])); \
        BF[1] = cat8s(asm_tr<32768 + (KS) * 8192>(sbase + G.tb[1][0]), asm_tr<32768 + (KS) * 8192>(sbase + G.tb[1][1])); \
        BF[2] = cat8s(asm_tr<32768 + (KS) * 8192>(sbase + G.tb[2][0]), asm_tr<32768 + (KS) * 8192>(sbase + G.tb[2][1])); \
        BF[3] = cat8s(asm_tr<32768 + (KS) * 8192>(sbase + G.tb[3][0]), asm_tr<32768 + (KS) * 8192>(sbase + G.tb[3][1])); \
        AF[0] = asm_rd128<0>(sbase + G.ta[KS]); AF[1] = asm_rd128<2048>(sbase + G.ta[KS]); AF[2] = asm_rd128<4096>(sbase + G.ta[KS]); AF[3] = asm_rd128<6144>(sbase + G.ta[KS]); } while (0)
#define G3_MMA(BF, AF) do { _Pragma("unroll") for (int mi = 0; mi < 4; ++mi) _Pragma("unroll") for (int ni = 0; ni < 4; ++ni) acc[mi][ni] = mfma16(BF[ni], AF[mi], acc[mi][ni]); } while (0)
    int sc = S.gs, si = (S.gs == 0) ? 2 : S.gs - 1;
    if (!S.primed) {
        asm volatile("s_waitcnt vmcnt(0)" ::: "memory");
        __builtin_amdgcn_s_barrier();
        asm volatile("" ::: "memory");
        if (loader) { G3_ISSUE(0, sc); G3_ISSUE(1, (sc == 2) ? 0 : sc + 1); }
    }
    for (int kt = 0; kt < nk; ++kt) {
        if (loader) { if ((kt == 0 && S.primed) || !(kt + 1 < nk || has_next)) asm volatile("s_waitcnt vmcnt(0)" ::: "memory"); else asm volatile("s_waitcnt vmcnt(12)" ::: "memory"); }
        __builtin_amdgcn_s_barrier();
        asm volatile("" ::: "memory");
        if (loader) {
            if (kt + 2 < nk) G3_ISSUE(kt + 2, si);
            else if (has_next) G3_ISSUE_(nasrc, nbsrc, kt + 2 - nk, si);
        }
        const int sbase = lbase + sc * GEMM_STAGE;
        h16x8 bf0[4], af0[4], bf1[4], af1[4];
        G3_READ(bf0, af0, 0);
        if (RMS) {
            h16x8 hv[4];
            hv[0] = asm_rd128<0>(sbase + G.a_st); hv[1] = asm_rd128<8192>(sbase + G.a_st); hv[2] = asm_rd128<16384>(sbase + G.a_st); hv[3] = asm_rd128<24576>(sbase + G.a_st);
            LGKM0();
#pragma unroll
            for (int i = 0; i < 4; ++i)
#pragma unroll
                for (int e = 0; e < 8; ++e) { const float f = (float)hv[i][e]; ss[i] += f * f; }
        } else LGKM0();
        G3_READ(bf1, af1, 1);
        G3_MMA(bf0, af0);
        LGKM0();
        G3_MMA(bf1, af1);
        sc = (sc == 2) ? 0 : sc + 1; si = (si == 2) ? 0 : si + 1;
    }
#undef G3_ISSUE
#undef G3_ISSUE_
#undef G3_READ
#undef G3_MMA
    S.gs = sc; S.primed = has_next;
    if (RMS) {
        LAS float* rs = (LAS float*)(lds + GEMM_ROWS_OFF);
#pragma unroll
        for (int i = 0; i < 4; ++i) {
            float s = ss[i]; s += __shfl_xor(s, 1); s += __shfl_xor(s, 2); s += __shfl_xor(s, 4);
            if ((G.tid & 7) == 0) rs[(G.tid >> 3) + 64 * i] = __builtin_amdgcn_rsqf(s / (float)(nk * 64) + EPS);
        }
        asm volatile("s_waitcnt lgkmcnt(0)" ::: "memory");
        __builtin_amdgcn_s_barrier();
        asm volatile("" ::: "memory");
    }
}

constexpr int G2_STAGE = 65536;
struct GemmThread2 {
    int tid, lane, wid, wm, wn, r16, g;
    int ta[2];
    int tb[4][2];
    __device__ __forceinline__ void init() {
        tid = threadIdx.x; lane = tid & 63; wid = __builtin_amdgcn_readfirstlane(tid >> 6); wm = wid >> 2; wn = wid & 3; r16 = lane & 15; g = lane >> 4;
#pragma unroll
        for (int ks = 0; ks < 2; ++ks) ta[ks] = a_off(wm * 128 + r16, ks * 4 + g);
#pragma unroll
        for (int ni = 0; ni < 4; ++ni)
#pragma unroll
            for (int t = 0; t < 2; ++t) tb[ni][t] = 32768 + (wn >> 1) * 16384 + tr_addr16(lane, (wn & 1) * 4 + ni, 0, t);
    }
};
__device__ __forceinline__ void gemm_tile_g2(LAS char* lds, const GemmThread2& G, const h16* Ab, int lda, const h16* Bb, int ldb, int nk, f32x4 (&acc)[8][4]) {
#pragma unroll
    for (int i = 0; i < 8; ++i)
#pragma unroll
        for (int j = 0; j < 4; ++j) acc[i][j] = (f32x4){0.f, 0.f, 0.f, 0.f};
    const bool loader = G.wid < 4;
    const int wq = G.wid & 3;
    const unsigned aoff = (unsigned)(((8 * wq + (G.lane >> 3)) * lda + (((G.lane & 7) ^ (G.lane >> 3)) << 3)) * 2);
    const unsigned boff = (unsigned)(((4 * wq + (G.lane >> 4)) * ldb + (((G.lane & 15) ^ (((G.lane >> 4) << 2) | wq)) << 3)) * 2);
    const char* asrc = (const char*)Ab; const char* bsrc = (const char*)Bb;
    const size_t a_i = (size_t)128 * lda, a_h = (size_t)64 * lda, b_i = (size_t)64 * ldb, b_h = (size_t)32 * ldb, b_k = (size_t)128 * ldb;
    LAS char* wbase = lds + wq * 1024;
    const int lbase = (int)(uintptr_t)lds;
#define G2_ISSUE(kt, st) do { LAS char* sb_ = wbase + (st) * G2_STAGE; \
        _Pragma("unroll") for (int h = 0; h < 2; ++h) { \
        _Pragma("unroll") for (int i = 0; i < 4; ++i) __builtin_amdgcn_global_load_lds((const unsigned*)(asrc + (i * a_i + h * a_h + (size_t)(kt) * 128) + aoff), (LAS unsigned*)(sb_ + h * 4096 + i * 8192), 16, 0, 0); \
        _Pragma("unroll") for (int i = 0; i < 4; ++i) __builtin_amdgcn_global_load_lds((const unsigned*)(bsrc + ((i & 1) * b_i + (i >> 1) * 256 + h * b_h + (size_t)(kt) * b_k) + boff), (LAS unsigned*)(sb_ + 32768 + h * 4096 + (i >> 1) * 16384 + (i & 1) * 8192), 16, 0, 0); } } while (0)
#define G2_RB(BF, KS) do { \
        BF[0] = cat8s(asm_tr<(KS) * 8192>(sbase + G.tb[0][0]), asm_tr<(KS) * 8192>(sbase + G.tb[0][1])); \
        BF[1] = cat8s(asm_tr<(KS) * 8192>(sbase + G.tb[1][0]), asm_tr<(KS) * 8192>(sbase + G.tb[1][1])); \
        BF[2] = cat8s(asm_tr<(KS) * 8192>(sbase + G.tb[2][0]), asm_tr<(KS) * 8192>(sbase + G.tb[2][1])); \
        BF[3] = cat8s(asm_tr<(KS) * 8192>(sbase + G.tb[3][0]), asm_tr<(KS) * 8192>(sbase + G.tb[3][1])); } while (0)
#define G2_RA(AF, KS, H) do { AF[0] = asm_rd128<(H) * 8192>(sbase + G.ta[KS]); AF[1] = asm_rd128<(H) * 8192 + 2048>(sbase + G.ta[KS]); \
        AF[2] = asm_rd128<(H) * 8192 + 4096>(sbase + G.ta[KS]); AF[3] = asm_rd128<(H) * 8192 + 6144>(sbase + G.ta[KS]); } while (0)
#define G2_MMA(BF, AF, H) do { _Pragma("unroll") for (int mi = 0; mi < 4; ++mi) _Pragma("unroll") for (int ni = 0; ni < 4; ++ni) \
        acc[(H) * 4 + mi][ni] = mfma16(BF[ni], AF[mi], acc[(H) * 4 + mi][ni]); } while (0)
    asm volatile("s_waitcnt vmcnt(0)" ::: "memory");
    __builtin_amdgcn_s_barrier();
    asm volatile("" ::: "memory");
    if (loader) G2_ISSUE(0, 0);
    for (int kt = 0; kt < nk; ++kt) {
        if (loader) asm volatile("s_waitcnt vmcnt(0)" ::: "memory");
        __builtin_amdgcn_s_barrier();
        asm volatile("" ::: "memory");
        if (loader) { if (kt + 1 < nk) G2_ISSUE(kt + 1, (kt + 1) & 1); }
        const int sbase = lbase + (kt & 1) * G2_STAGE;
        h16x8 bf0[4], bf1[4], afx[4], afy[4];
        G2_RB(bf0, 0); G2_RA(afx, 0, 0);
        LGKM0();
        G2_RA(afy, 0, 1); G2_RB(bf1, 1);
        G2_MMA(bf0, afx, 0);
        LGKM0();
        G2_RA(afx, 1, 0);
        G2_MMA(bf0, afy, 1);
        LGKM0();
        G2_RA(afy, 1, 1);
        G2_MMA(bf1, afx, 0);
        LGKM0();
        G2_MMA(bf1, afy, 1);
    }
#undef G2_ISSUE
#undef G2_RB
#undef G2_RA
#undef G2_MMA
}

template <int OFF> __device__ __forceinline__ u32x2 asm_rd64(int addr) { u32x2 r; asm volatile("ds_read_b64 %0, %1 offset:%2" : "=v"(r) : "v"(addr), "i"(OFF) : "memory"); return r; }
__device__ __forceinline__ void gemm_tile_g8(LAS char* lds, const GemmThread& G, const unsigned char* Ab, int lda, const h16* Bb, int ldb, int nk, f32x4 (&acc)[4][4],
                                             G3Stream& S, const unsigned char* nAb, const h16* nBb) {
#pragma unroll
    for (int i = 0; i < 4; ++i)
#pragma unroll
        for (int j = 0; j < 4; ++j) acc[i][j] = (f32x4){0.f, 0.f, 0.f, 0.f};
    const bool loader = G.wid < 4; const int wq = G.wid & 3;
    const size_t a_i = (size_t)128 * 64, b_i = (size_t)32 * ldb, b_h = (size_t)16 * ldb, b_k = (size_t)64 * ldb;
    const size_t lane_a = (size_t)(16 * wq + (G.lane >> 2)) * 64 + (((G.lane & 3) ^ ((G.lane >> 4) & 3)) << 4);
    const size_t lane_b = (size_t)(4 * wq + (G.lane >> 4)) * ldb + (((G.lane & 15) ^ (((G.lane >> 4) << 2) | wq)) << 3);
    const bool has_next = (nAb != nullptr);
    const unsigned char* asrc = Ab + lane_a; const h16* bsrc = Bb + lane_b;
    const unsigned char* nasrc = (has_next ? nAb : Ab) + lane_a; const h16* nbsrc = (has_next ? nBb : Bb) + lane_b;
    LAS char* wbase = lds + wq * 1024;
    const int lbase = (int)(uintptr_t)lds;
    int ta8[2];
    { const int x2 = 2 * ((G.r16 >> 2) & 3);
#pragma unroll
      for (int ks = 0; ks < 2; ++ks) ta8[ks] = (G.wm * 64 + G.r16) * 64 + (((4 * ks + G.g) ^ x2) << 3); }
#define G8_ISSUE_(AS, BS, kt, st) do { LAS char* sb_ = wbase + (st) * GEMM_STAGE; \
        _Pragma("unroll") for (int h = 0; h < 2; ++h) { \
        _Pragma("unroll") for (int i = 0; i < 2; ++i) __builtin_amdgcn_global_load_lds((const unsigned*)((AS) + i * a_i + h * 4096 + (size_t)(kt) * 16384), (LAS unsigned*)(sb_ + h * 4096 + i * 8192), 16, 0, 0); \
        _Pragma("unroll") for (int i = 0; i < 2; ++i) __builtin_amdgcn_global_load_lds((const unsigned*)((BS) + i * b_i + h * b_h + (size_t)(kt) * b_k), (LAS unsigned*)(sb_ + 32768 + h * 4096 + i * 8192), 16, 0, 0); } } while (0)
#define G8_ISSUE(kt, st) G8_ISSUE_(asrc, bsrc, kt, st)
#define G8_READ(BF, AR, KS) do { \
        BF[0] = cat8s(asm_tr<32768 + (KS) * 8192>(sbase + G.tb[0][0]), asm_tr<32768 + (KS) * 8192>(sbase + G.tb[0][1])); \
        BF[1] = cat8s(asm_tr<32768 + (KS) * 8192>(sbase + G.tb[1][0]), asm_tr<32768 + (KS) * 8192>(sbase + G.tb[1][1])); \
        BF[2] = cat8s(asm_tr<32768 + (KS) * 8192>(sbase + G.tb[2][0]), asm_tr<32768 + (KS) * 8192>(sbase + G.tb[2][1])); \
        BF[3] = cat8s(asm_tr<32768 + (KS) * 8192>(sbase + G.tb[3][0]), asm_tr<32768 + (KS) * 8192>(sbase + G.tb[3][1])); \
        AR[0] = asm_rd64<0>(sbase + ta8[KS]); AR[1] = asm_rd64<1024>(sbase + ta8[KS]); AR[2] = asm_rd64<2048>(sbase + ta8[KS]); AR[3] = asm_rd64<3072>(sbase + ta8[KS]); } while (0)
#define G8_MMA(BF, AR) do { h16x8 af_[4]; _Pragma("unroll") for (int mi = 0; mi < 4; ++mi) af_[mi] = fp8x8_to_h16(AR[mi][0], AR[mi][1]); \
        _Pragma("unroll") for (int mi = 0; mi < 4; ++mi) _Pragma("unroll") for (int ni = 0; ni < 4; ++ni) acc[mi][ni] = mfma16(BF[ni], af_[mi], acc[mi][ni]); } while (0)
    int sc = S.gs, si = (S.gs == 0) ? 2 : S.gs - 1;
    if (!S.primed) {
        asm volatile("s_waitcnt vmcnt(0)" ::: "memory");
        __builtin_amdgcn_s_barrier();
        asm volatile("" ::: "memory");
        if (loader) { G8_ISSUE(0, sc); G8_ISSUE(1, (sc == 2) ? 0 : sc + 1); }
    }
    for (int kt = 0; kt < nk; ++kt) {
        if (loader) { if ((kt == 0 && S.primed) || !(kt + 1 < nk || has_next)) asm volatile("s_waitcnt vmcnt(0)" ::: "memory"); else asm volatile("s_waitcnt vmcnt(8)" ::: "memory"); }
        __builtin_amdgcn_s_barrier();
        asm volatile("" ::: "memory");
        if (loader) {
            if (kt + 2 < nk) G8_ISSUE(kt + 2, si);
            else if (has_next) G8_ISSUE_(nasrc, nbsrc, kt + 2 - nk, si);
        }
        const int sbase = lbase + sc * GEMM_STAGE;
        h16x8 bf0[4], bf1[4]; u32x2 ar0[4], ar1[4];
        G8_READ(bf0, ar0, 0);
        LGKM0();
        G8_READ(bf1, ar1, 1);
        G8_MMA(bf0, ar0);
        LGKM0();
        G8_MMA(bf1, ar1);
        sc = (sc == 2) ? 0 : sc + 1; si = (si == 2) ? 0 : si + 1;
    }
#undef G8_ISSUE
#undef G8_ISSUE_
#undef G8_READ
#undef G8_MMA
    S.gs = sc; S.primed = has_next;
}

__device__ __forceinline__ void cvt_weight(const float* W, const float* rowscale, h16* O, int K, int N, int NP, int gtid, int gthreads) {
    const int cpr = NP >> 3;
    for (int idx = gtid; idx < K * cpr; idx += gthreads) {
        const int k = idx / cpr, c = (idx - k * cpr) << 3;
        h16x8 o;
        if (c < N) {
            f32x4 v0 = *(const f32x4*)(W + (size_t)k * N + c), v1 = *(const f32x4*)(W + (size_t)k * N + c + 4);
            if (rowscale) { const float r = rowscale[k]; v0 = v0 * r; v1 = v1 * r; }
#pragma unroll
            for (int e = 0; e < 4; ++e) { o[e] = (h16)v0[e]; o[4 + e] = (h16)v1[e]; }
        } else {
#pragma unroll
            for (int e = 0; e < 8; ++e) o[e] = (h16)0.f;
        }
        *(h16x8*)(O + (size_t)k * NP + c) = o;
    }
}
__device__ __forceinline__ void phase_cvt(const Args& a) {
    const int gtid = blockIdx.x * NTHREADS + threadIdx.x, gth = gridDim.x * NTHREADS;
    cvt_weight(a.in[I_WIN], nullptr, (h16*)(a.ws + WS_WIN16), DM, INW, WINP, gtid, gth);
    cvt_weight(a.in[I_WO], nullptr, (h16*)(a.ws + WS_WO16), DM, DM, DM, gtid, gth);
    cvt_weight(a.in[I_WUQ], a.in[I_QNORM], (h16*)(a.ws + WS_WUQ16), 512, 1536, 1536, gtid, gth);
    cvt_weight(a.in[I_WUKV], a.in[I_KVNORM], (h16*)(a.ws + WS_WUKV16), 256, 2048, 2048, gtid, gth);
    h16* WRH = (h16*)(a.ws + WS_WRH); h16* WRL = (h16*)(a.ws + WS_WRL);
    for (int idx = gtid; idx < 48 * DM; idx += gth) {
        const int n = idx / DM, k = idx - n * DM;
        float w = 0.f;
        if (n < 4) w = a.in[I_RGW][k * 4 + n];
        else if (n < 36) w = a.in[I_REW][(size_t)((n - 4) >> 3) * DM * 8 + (size_t)k * 8 + ((n - 4) & 7)];
        w *= 1024.f;
        const h16 hi = (h16)w; const h16 lo = (h16)(w - (float)hi);
        WRH[idx] = hi; WRL[idx] = lo;
    }
}

__device__ __forceinline__ void phase_adaln(const Args& a, LAS char* lds) {
    const int tid = threadIdx.x;
    LAS float* sact = (LAS float*)lds;
    LAS f32x4* red = (LAS f32x4*)(lds + 40960);
    const float* c = a.in[I_C]; const float* cc = a.in[I_CCTX]; const float* W = a.in[I_WADA];
    float* PART = (float*)(a.ws + WS_PART);
    for (int i = tid; i < 5 * DM; i += NTHREADS) { const float v = (i < 4 * DM) ? c[i] : cc[i - 4 * DM]; sact[i] = silu_f(v); }
    __syncthreads();
    const int col4 = tid & 31, ksub = tid >> 5;
    for (int u = blockIdx.x; u < 768; u += gridDim.x) {
        const int nc = u % 96, kc = u / 96;
        const int k0 = kc * 256 + ksub * 16;
        const float* wp = W + (size_t)k0 * ADAW + nc * 128 + col4 * 4;
        f32x4 acc[5];
#pragma unroll
        for (int r = 0; r < 5; ++r) acc[r] = (f32x4){0.f, 0.f, 0.f, 0.f};
#pragma unroll 8
        for (int kk = 0; kk < 16; ++kk) {
            const f32x4 w = *(const f32x4*)(wp + (size_t)kk * ADAW);
#pragma unroll
            for (int r = 0; r < 5; ++r) acc[r] += w * sact[r * DM + k0 + kk];
        }
#pragma unroll
        for (int r = 0; r < 5; ++r) red[(ksub * 5 + r) * 32 + col4] = acc[r];
        __syncthreads();
        if (tid < 160) {
            const int r = tid >> 5, c4 = tid & 31;
            f32x4 s = (f32x4){0.f, 0.f, 0.f, 0.f};
#pragma unroll
            for (int j = 0; j < 16; ++j) s += red[(j * 5 + r) * 32 + c4];
            *(f32x4*)(PART + ((size_t)kc * 5 + r) * ADAW + nc * 128 + c4 * 4) = s;
        }
        __syncthreads();
    }
}

__device__ __forceinline__ float mod_sum(const float* PART, const float* bada, int r, int n) {
    float s = bada[n];
#pragma unroll
    for (int kc = 0; kc < 8; ++kc) s += PART[((size_t)kc * 5 + r) * ADAW + n];
    return s;
}
__device__ __forceinline__ void phase_modulate(const Args& a, LAS char* lds) {
    const int tid = threadIdx.x, lane = tid & 63, wid = tid >> 6;
    const float* PART = (const float*)(a.ws + WS_PART); const float* bada = a.in[I_BADA];
    float* MOD = (float*)(a.ws + WS_MOD);
    for (int idx = blockIdx.x * NTHREADS + tid; idx < 5 * ADAW; idx += gridDim.x * NTHREADS) MOD[idx] = mod_sum(PART, bada, idx / ADAW, idx % ADAW);
    const int per = (TA + gridDim.x - 1) / gridDim.x;
    const int r0 = blockIdx.x * per, r1 = (r0 + per < TA) ? r0 + per : TA;
    if (r0 >= r1) return;
    const int mrA = (r0 < T) ? r0 / SEQ : 4, mrB = (r1 - 1 < T) ? (r1 - 1) / SEQ : 4;
    LAS float* smod = (LAS float*)lds;
    for (int i = tid; i < 2 * 2 * DM; i += NTHREADS) {
        const int slot = i / (2 * DM), n = i % (2 * DM);
        smod[i] = mod_sum(PART, bada, slot ? mrB : mrA, n);
    }
    __syncthreads();
    h16* A1 = (h16*)(a.ws + WS_A1);
    for (int row = r0 + wid; row < r1; row += 8) {
        const float* xr = (row < T) ? a.in[I_X] + (size_t)row * DM : a.in[I_CTX] + (size_t)(row - T) * DM;
        const int mr = (row < T) ? row / SEQ : 4;
        LAS float* sm = smod + ((mr == mrA) ? 0 : 2 * DM);
        f32x4 v[8]; float s = 0.f;
#pragma unroll
        for (int j = 0; j < 8; ++j) { v[j] = *(const f32x4*)(xr + j * 256 + lane * 4); s += (v[j][0] + v[j][1]) + (v[j][2] + v[j][3]); }
        const float mean = wave_sum(s) * (1.f / DM); float q = 0.f;
#pragma unroll
        for (int j = 0; j < 8; ++j) { v[j] = v[j] - mean; q += (v[j][0] * v[j][0] + v[j][1] * v[j][1]) + (v[j][2] * v[j][2] + v[j][3] * v[j][3]); }
        const float rstd = 1.f / sqrtf(wave_sum(q) * (1.f / DM) + EPS);
#pragma unroll
        for (int j = 0; j < 8; ++j) {
            const int k = j * 256 + lane * 4;
            const f32x4 sh = *(LAS f32x4*)(sm + k), sc = *(LAS f32x4*)(sm + DM + k);
            const f32x4 y = v[j] * rstd * (sc + 1.f) + sh;
            *(h16x4*)(A1 + (size_t)row * DM + k) = cvt4(y);
        }
    }
}

__device__ __forceinline__ void acc_rows16(const f32x4 (&c)[4], float w, u32x4 (&v)[2]) {
    u32x2 x[4];
#pragma unroll
    for (int ni = 0; ni < 4; ++ni) x[ni] = __builtin_bit_cast(u32x2, cvt4(c[ni] * w));
#pragma unroll
    for (int n1 = 0; n1 < 2; ++n1) {
#pragma unroll
        for (int d = 0; d < 2; ++d) {
            auto p = __builtin_amdgcn_permlane32_swap(x[2 * n1][d], x[2 * n1 + 1][d], false, false);
            auto q = __builtin_amdgcn_permlane16_swap(p[0], p[1], false, false);
            x[2 * n1][d] = q[0]; x[2 * n1 + 1][d] = q[1];
        }
        v[n1] = (u32x4){x[2 * n1][0], x[2 * n1][1], x[2 * n1 + 1][0], x[2 * n1 + 1][1]};
    }
}
__device__ __forceinline__ void st_rows16(h16* rowp, const f32x4 (&c)[4], float w, int g) {
    u32x4 v[2];
    acc_rows16(c, w, v);
    *(u32x4*)(rowp + 8 * g) = v[0]; *(u32x4*)(rowp + 8 * g + 32) = v[1];
}
__device__ __forceinline__ void st4(h16* p, f32x4 v) { *(h16x4*)p = cvt4(v); }
__device__ __forceinline__ void rope4(f32x4 x1, f32x4 x2, float pos, int i0, float step, float sc, f32x4& o1, f32x4& o2) {
#pragma unroll
    for (int r = 0; r < 4; ++r) {
        const float invf = exp2f(-(float)(i0 + r) * step);
        const float ang = pos * invf;
        const float s = __sinf(ang), c = __cosf(ang);
        o1[r] = (x1[r] * c - x2[r] * s) * sc; o2[r] = (x1[r] * s + x2[r] * c) * sc;
    }
}
template <int NM>
__device__ __forceinline__ void inproj_epi(const Args& a, const f32x4 (&acc)[NM][4], bool lat, int b, int m0, int l0, int nt, int wn, int g) {
    h16* QR = (h16*)(a.ws + WS_QR); h16* KR = (h16*)(a.ws + WS_KR); h16* VR = (h16*)(a.ws + WS_VR);
    h16* KC = (h16*)(a.ws + WS_KC); h16* VC = (h16*)(a.ws + WS_VC); h16* GS = (h16*)(a.ws + WS_GS);
    h16* CQ = (h16*)(a.ws + WS_CQ); h16* CKV = (h16*)(a.ws + WS_CKV); h16* KPE = (h16*)(a.ws + WS_KPE);
    const int cw = wn * 64;
    if (nt < 16) {
        const int h = nt & 7; const bool isq = nt < 8;
        h16* dst = isq ? QR : (lat ? KR : KC);
        const float sc = isq ? 1.f : KSCALE;
#pragma unroll
        for (int mi = 0; mi < NM; ++mi) {
            const int l = l0 + mi * 16;
            const size_t ro = lat ? ((size_t)(b * 8 + h) * SEQ + l) * 128 : ((size_t)(b * 8 + h) * LC + l) * 128;
            const float pos = (wn == 0) ? (float)(l >> 6) : (float)(l & 63);
            f32x4 c[4];
#pragma unroll
            for (int ni = 0; ni < 2; ++ni) {
                if (lat) rope4(acc[mi][ni], acc[mi][ni + 2], pos, ni * 16 + 4 * g, L2_10000 / 32.f, sc, c[ni], c[ni + 2]);
                else { c[ni] = acc[mi][ni] * sc; c[ni + 2] = acc[mi][ni + 2] * sc; }
            }
            st_rows16(dst + ro + cw, c, 1.f, g);
        }
    } else if (nt < 24) {
        const int h = nt - 16; h16* dst = lat ? VR : VC;
#pragma unroll
        for (int mi = 0; mi < NM; ++mi) {
            const int l = l0 + mi * 16;
            const size_t ro = lat ? ((size_t)(b * 8 + h) * SEQ + l) * 128 : ((size_t)(b * 8 + h) * LC + l) * 128;
            st_rows16(dst + ro + cw, acc[mi], 1.f, g);
        }
    } else if (nt < 32) {
#pragma unroll
        for (int mi = 0; mi < NM; ++mi) {
            f32x4 c[4];
#pragma unroll
            for (int ni = 0; ni < 4; ++ni)
#pragma unroll
                for (int r = 0; r < 4; ++r) c[ni][r] = silu_f(acc[mi][ni][r]);
            st_rows16(GS + (size_t)(m0 + mi * 16) * 1024 + (nt - 24) * 128 + cw, c, 1.f, g);
        }
    } else if (nt < 36) {
#pragma unroll
        for (int mi = 0; mi < NM; ++mi) st_rows16(CQ + (size_t)(m0 + mi * 16) * 512 + (nt - 32) * 128 + cw, acc[mi], 1.f, g);
    } else if (nt < 38) {
#pragma unroll
        for (int mi = 0; mi < NM; ++mi) {
            const int key = (lat ? LC : 0) + l0 + mi * 16;
            st_rows16(CKV + ((size_t)b * LK + key) * 256 + (nt - 36) * 128 + cw, acc[mi], 1.f, g);
        }
    } else if (nt == 38 && wn == 0) {
#pragma unroll
        for (int mi = 0; mi < NM; ++mi) {
            const int l = l0 + mi * 16, key = (lat ? LC : 0) + l;
            f32x4 c[4];
#pragma unroll
            for (int hf = 0; hf < 2; ++hf) {
                const float pos = hf ? (float)(l & 63) : (float)(l >> 6);
                if (lat) rope4(acc[mi][2 * hf], acc[mi][2 * hf + 1], pos, 4 * g, L2_10000 / 16.f, 1.f, c[2 * hf], c[2 * hf + 1]);
                else { c[2 * hf] = acc[mi][2 * hf]; c[2 * hf + 1] = acc[mi][2 * hf + 1]; }
            }
            st_rows16(KPE + ((size_t)b * LK + key) * 64, c, 1.f, g);
        }
    }
}
__device__ __forceinline__ void inproj_unit(int list, int p, int& mt, int& nt) {
    if (list == 0) {
        if (p < 352) { const int mg = p / 44, rem = p - mg * 44, ti = rem >> 2; mt = mg * 4 + (rem & 3); nt = (ti < 8) ? 4 + ti : 8 + ti; }
        else if (p < 388) { const int q = p - 352, ti = q >> 2; mt = 32 + (q & 3); nt = (ti < 8) ? 4 + ti : 18; }
        else { const int q = p - 388; mt = q >> 2; nt = q & 3; }
    } else {
        if (p < 4) { mt = 31; nt = p; }
        else if (p < 132) { const int q = p - 4; mt = q >> 2; nt = 12 + (q & 3); }
        else if (p < 164) { mt = p - 132; nt = 19; }
        else { mt = 32 + (p - 164); nt = 19; }
    }
}
constexpr int INPROJ_NU0 = 512, INPROJ_NU1 = 168;
__device__ __forceinline__ void phase_inproj(const Args& a, LAS char* lds, int vcu, int list) {
    GemmThread2 G; G.init();
    const h16* A1 = (const h16*)(a.ws + WS_A1); const h16* W16 = (const h16*)(a.ws + WS_WIN16);
    const int NU = list ? INPROJ_NU1 : INPROJ_NU0;
    for (int p = vcu; p < NU; p += gridDim.x) {
        int mt, nt;
        inproj_unit(list, p, mt, nt);
        f32x4 acc[8][4];
        gemm_tile_g2(lds, G, A1 + (size_t)mt * 256 * DM, DM, W16 + nt * 256, WINP, DM / 64, acc);
        const bool lat = mt < 32;
        const int b = lat ? (mt >> 3) : (mt - 32);
        int r16l = G.r16, gl = G.g;
        asm volatile("" : "+v"(r16l), "+v"(gl));
        const int m0 = mt * 256 + G.wm * 128 + r16l;
        const int l0 = lat ? (m0 & (SEQ - 1)) : (m0 - T - b * LC);
        const int cb = nt * 4 + G.wn;
        inproj_epi<8>(a, acc, lat, b, m0, l0, cb >> 1, cb & 1, gl);
    }
    if (list == 0) {
        const int rounds = (NU + (int)gridDim.x - 1) / (int)gridDim.x, mine = (vcu < NU) ? (NU - vcu + (int)gridDim.x - 1) / (int)gridDim.x : 0;
        if (mine < rounds) wdown_pool(a, lds, 8 * (rounds - mine));
    }
}

__device__ __forceinline__ void qup_unit(const Args& a, LAS char* lds, G3Stream& S, int p, int pn) {
    GemmThread G; G.init(true);
    const h16* CQ = (const h16*)(a.ws + WS_CQ); h16* Q = (h16*)(a.ws + WS_Q);
    LAS float* rs = (LAS float*)(lds + GEMM_ROWS_OFF);
    const int mt = p / 12, nt = p % 12;
    const bool hn = pn >= 0;
    f32x4 acc[4][4];
    gemm_tile_g<true>(lds, G, CQ + (size_t)mt * 256 * 512, 512, (const h16*)(a.ws + WS_WUQ16) + nt * 128, 1536, 512 / 64, acc, S,
                      hn ? CQ + (size_t)(pn / 12) * 256 * 512 : nullptr, hn ? (const h16*)(a.ws + WS_WUQ16) + (pn % 12) * 128 : nullptr);
    const int c0 = nt * 128 + G.wn * 64, head = c0 / 192, d0 = c0 % 192;
#pragma unroll
    for (int mi = 0; mi < 4; ++mi) {
        const int ml = G.wm * 64 + mi * 16 + G.r16, m = mt * 256 + ml;
        const float r = rs[ml];
        const int b = m >> 11, l = m & (SEQ - 1);
        h16* dst = Q + ((size_t)(b * 8 + head) * SEQ + l) * 192 + d0;
        if (d0 < 128) st_rows16(dst, acc[mi], r, G.g);
        else {
            f32x4 c[4];
#pragma unroll
            for (int hf = 0; hf < 2; ++hf) {
                const float pos = hf ? (float)(l & 63) : (float)(l >> 6);
                rope4(acc[mi][2 * hf], acc[mi][2 * hf + 1], pos, 4 * G.g, L2_10000 / 16.f, r, c[2 * hf], c[2 * hf + 1]);
            }
            st_rows16(dst, c, 1.f, G.g);
        }
    }
}
__device__ __forceinline__ void kvup_unit(const Args& a, LAS char* lds, G3Stream& S, int p, int pn) {
    GemmThread G; G.init(true);
    const h16* CKV = (const h16*)(a.ws + WS_CKV); h16* KN = (h16*)(a.ws + WS_KN); h16* VV = (h16*)(a.ws + WS_VV);
    LAS float* rs = (LAS float*)(lds + GEMM_ROWS_OFF);
    const int mt = p >> 4, nt = p & 15;
    const bool hn = pn >= 0;
    f32x4 acc[4][4];
    gemm_tile_g<true>(lds, G, CKV + (size_t)mt * 256 * 256, 256, (const h16*)(a.ws + WS_WUKV16) + nt * 128, 2048, 256 / 64, acc, S,
                      hn ? CKV + (size_t)(pn >> 4) * 256 * 256 : nullptr, hn ? (const h16*)(a.ws + WS_WUKV16) + (pn & 15) * 128 : nullptr);
    const int head = nt >> 1; h16* base = (nt & 1) ? VV : KN;
#pragma unroll
    for (int mi = 0; mi < 4; ++mi) {
        const int ml = G.wm * 64 + mi * 16 + G.r16, m = mt * 256 + ml;
        const float r = rs[ml];
        const int b = m / LK, key = m % LK;
        st_rows16(base + ((size_t)(b * 8 + head) * LK + key) * 128 + G.wn * 64, acc[mi], r, G.g);
    }
}

__device__ __forceinline__ float log2_gamma(const float* rdec, int dir, int h) {
    const float x = rdec[dir * 8 + h];
    return -log1pf(__expf(-x)) * 1.4426950408889634f;
}

__device__ __forceinline__ void ret_state_item(const Args& a, LAS char* lds, int it) {
    int tid = threadIdx.x; asm volatile("" : "+v"(tid));
    const int lane = tid & 63, wid = __builtin_amdgcn_readfirstlane(tid >> 6), r16 = lane & 15, g = lane >> 4;
    const h16* KR = (const h16*)(a.ws + WS_KR); const h16* VR = (const h16*)(a.ws + WS_VR);
    const h16* KC = (const h16*)(a.ws + WS_KC); const h16* VC = (const h16*)(a.ws + WS_VC);
    h16* UF = (h16*)(a.ws + WS_UF); h16* UB = (h16*)(a.ws + WS_UB); h16* S0F = (h16*)(a.ws + WS_S0F); h16* S0B = (h16*)(a.ws + WS_S0B);
    LAS char* Kf = lds; LAS char* Kb = lds + 32768; LAS char* Vi = lds + 65536;
    __syncthreads();
    {
        const int bh = it / 17, c = it % 17, h = bh & 7;
        const float lgf = log2_gamma(a.in[I_RDEC], 0, h), lgb = log2_gamma(a.in[I_RDEC], 1, h);
        const bool isctx = (c == 16);
        const int J = isctx ? 256 : 128;
        const h16* Kp = isctx ? KC + (size_t)bh * LC * 128 : KR + ((size_t)bh * SEQ + c * 128) * 128;
        const h16* Vp = isctx ? VC + (size_t)bh * LC * 128 : VR + ((size_t)bh * SEQ + c * 128) * 128;
        f32x4 accf[8], accb[8];
#pragma unroll
        for (int i = 0; i < 8; ++i) { accf[i] = (f32x4){0.f, 0.f, 0.f, 0.f}; accb[i] = (f32x4){0.f, 0.f, 0.f, 0.f}; }
        for (int sub = 0; sub < J / 128; ++sub) {
            if (sub) __syncthreads();
#pragma unroll
            for (int i = 0; i < 4; ++i) {
                const int row = (tid >> 4) + 32 * i, ch = tid & 15, j = sub * 128 + row;
                const h16x8 kv = *(const h16x8*)(Kp + (size_t)j * 128 + ch * 8);
                const h16x8 vv = *(const h16x8*)(Vp + (size_t)j * 128 + ch * 8);
                const float zf = exp2f(lgf * (float)(J - 1 - j)), zb = exp2f(lgb * (float)j);
                h16x8 kf, kb;
#pragma unroll
                for (int e = 0; e < 8; ++e) { const float f = (float)kv[e]; kf[e] = (h16)(f * zf); kb[e] = (h16)(f * zb); }
                const int o = off_b(row, ch);
                *(LAS h16x8*)(Kf + o) = kf; *(LAS h16x8*)(Kb + o) = kb; *(LAS h16x8*)(Vi + o) = vv;
            }
            __syncthreads();
#pragma unroll
            for (int ks = 0; ks < 4; ++ks) {
                const int o0 = tr_addr16(lane, wid, ks, 0), o1 = tr_addr16(lane, wid, ks, 1);
                const h16x8 af = cat8(trrd(Kf + o0), trrd(Kf + o1)), ab = cat8(trrd(Kb + o0), trrd(Kb + o1));
#pragma unroll
                for (int cb = 0; cb < 8; ++cb) {
                    const h16x8 bv = cat8(trrd(Vi + tr_addr16(lane, cb, ks, 0)), trrd(Vi + tr_addr16(lane, cb, ks, 1)));
                    accf[cb] = mfma16(af, bv, accf[cb]); accb[cb] = mfma16(ab, bv, accb[cb]);
                }
            }
        }
        h16* of = isctx ? S0F + (size_t)bh * 16384 : UF + ((size_t)bh * 16 + c) * 16384;
        h16* ob = isctx ? S0B + (size_t)bh * 16384 : UB + ((size_t)bh * 16 + c) * 16384;
#pragma unroll
        for (int cb = 0; cb < 8; ++cb)
#pragma unroll
            for (int r = 0; r < 4; ++r) {
                const int d = wid * 16 + 4 * g + r, e = cb * 16 + r16;
                of[d * 128 + e] = (h16)accf[cb][r]; ob[d * 128 + e] = (h16)accb[cb][r];
            }
        __syncthreads();
    }
}

constexpr int N_ITEMS = 384 + 544 + 576;
__device__ __forceinline__ void phase_mid(const Args& a, LAS char* lds, int vcu) {
    phase_inproj(a, lds, vcu, 1);
    const int Gn = (int)gridDim.x;
    const bool bal = (Gn == 256);
    const int cyc = bal ? 432 : Gn, nseq = (bal && vcu >= INPROJ_NU1) ? 3 : 1;
    G3Stream S; S.gs = 0; S.primed = false;
    int j = 0, t = 0;
    for (;;) {
        const int i = vcu + 88 * t + cyc * j;
        if (i >= N_ITEMS) break;
        int t2 = t + 1, j2 = j; if (t2 == nseq) { t2 = 0; ++j2; }
        const int inext = vcu + 88 * t2 + cyc * j2;
        if (i < 384) qup_unit(a, lds, S, i, (inext < 384) ? inext : -1);
        else if (i < 928) ret_state_item(a, lds, i - 384);
        else kvup_unit(a, lds, S, i - 928, (inext < N_ITEMS) ? inext - 928 : -1);
        t = t2; j = j2;
    }
}

__device__ __forceinline__ void phase_ret_scan(const Args& a) {
    const h16* UF = (const h16*)(a.ws + WS_UF); const h16* UB = (const h16*)(a.ws + WS_UB);
    const h16* S0F = (const h16*)(a.ws + WS_S0F); const h16* S0B = (const h16*)(a.ws + WS_S0B);
    h16* SF = (h16*)(a.ws + WS_SF); h16* SB = (h16*)(a.ws + WS_SB);
    for (int idx = blockIdx.x * NTHREADS + threadIdx.x; idx < 32 * 16384; idx += gridDim.x * NTHREADS) {
        const int bh = idx >> 14, el = idx & 16383, h = bh & 7;
        const float gf = exp2f(128.f * log2_gamma(a.in[I_RDEC], 0, h)), gb = exp2f(128.f * log2_gamma(a.in[I_RDEC], 1, h));
        float sf = (float)S0F[idx], sb = (float)S0B[idx];
        for (int c = 0; c < 16; ++c) {
            SF[((size_t)bh * 16 + c) * 16384 + el] = (h16)sf;
            sf = gf * sf + (float)UF[((size_t)bh * 16 + c) * 16384 + el];
        }
        for (int c = 15; c >= 0; --c) {
            SB[((size_t)bh * 16 + c) * 16384 + el] = (h16)sb;
            sb = gb * sb + (float)UB[((size_t)bh * 16 + c) * 16384 + el];
        }
    }
}

__device__ __forceinline__ void ret_out_item(const Args& a, LAS char* lds, int bh, int c) {
    const int tid = threadIdx.x, lane = tid & 63, wid = __builtin_amdgcn_readfirstlane(tid >> 6), r16 = lane & 15, g = lane >> 4;
    const int b = bh >> 3, h = bh & 7;
    const float lgf = log2_gamma(a.in[I_RDEC], 0, h), lgb = log2_gamma(a.in[I_RDEC], 1, h);
    const h16* QR = (const h16*)(a.ws + WS_QR); const h16* KR = (const h16*)(a.ws + WS_KR); const h16* VR = (const h16*)(a.ws + WS_VR);
    const h16* SF = (const h16*)(a.ws + WS_SF); const h16* SB = (const h16*)(a.ws + WS_SB);
    const h16* GS = (const h16*)(a.ws + WS_GS); h16* MIX = (h16*)(a.ws + WS_MIX);
    LAS char* Qi = lds; LAS char* Ki = lds + 32768; LAS char* Vi = lds + 65536; LAS char* Pi = lds + 98304;
    const size_t src0 = ((size_t)bh * SEQ + c * 128) * 128, st0 = ((size_t)bh * 16 + c) * 16384;
    int ra[4], tbv[8][2];
#pragma unroll
    for (int s = 0; s < 4; ++s) ra[s] = row_addr16(lane, 0, s);
#pragma unroll
    for (int eb = 0; eb < 8; ++eb) { tbv[eb][0] = tr_addr16(lane, eb, 0, 0); tbv[eb][1] = tr_addr16(lane, eb, 0, 1); }
    const int st_o = off_b(tid >> 4, tid & 15);
    u32x4 sfr[4], sbr[4];
    {
        u32x4 qv[4], kv[4], vv[4];
#pragma unroll
        for (int i = 0; i < 4; ++i) {
            const size_t s = src0 + (size_t)((tid >> 4) + 32 * i) * 128 + (tid & 15) * 8;
            qv[i] = *(const u32x4*)(QR + s); kv[i] = *(const u32x4*)(KR + s); vv[i] = *(const u32x4*)(VR + s);
        }
#pragma unroll
        for (int i = 0; i < 4; ++i) {
            const size_t s = st0 + (size_t)((tid >> 4) + 32 * i) * 128 + (tid & 15) * 8;
            sfr[i] = *(const u32x4*)(SF + s); sbr[i] = *(const u32x4*)(SB + s);
        }
#pragma unroll
        for (int i = 0; i < 4; ++i) { *(LAS u32x4*)(Qi + st_o + i * 8192) = qv[i]; *(LAS u32x4*)(Ki + st_o + i * 8192) = kv[i]; *(LAS u32x4*)(Vi + st_o + i * 8192) = vv[i]; }
    }
    __syncthreads();
    h16x8 qf[4];
#pragma unroll
    for (int s = 0; s < 4; ++s) qf[s] = *(LAS h16x8*)(Qi + ra[s] + wid * 4096);
    const int il = 16 * wid + r16;
#pragma unroll
    for (int jb = 0; jb < 8; ++jb) {
        f32x4 sa = (f32x4){0.f, 0.f, 0.f, 0.f};
#pragma unroll
        for (int s = 0; s < 4; ++s) { const h16x8 kf = *(LAS h16x8*)(Ki + ra[s] + jb * 4096); sa = mfma16(kf, qf[s], sa); }
        f32x4 pv;
#pragma unroll
        for (int r = 0; r < 4; ++r) {
            const int dl = il - (16 * jb + 4 * g + r);
            float f = 0.f;
            if (dl >= 0) f += exp2f(lgf * (float)dl);
            if (dl <= 0) f += exp2f(lgb * (float)(-dl));
            pv[r] = sa[r] * f;
        }
        *(LAS h16x4*)(Pi + off_b(il, 2 * jb + (g >> 1)) + (g & 1) * 8) = cvt4(pv);
    }
    __syncthreads();
#pragma unroll
    for (int i = 0; i < 4; ++i) *(LAS u32x4*)(Ki + st_o + i * 8192) = sfr[i];
    __syncthreads();
    const h16 xfh = (h16)exp2f(lgf * (float)(il + 1)), xbh = (h16)exp2f(lgb * (float)(128 - il));
    f32x4 ao[8];
#pragma unroll
    for (int i = 0; i < 8; ++i) ao[i] = (f32x4){0.f, 0.f, 0.f, 0.f};
#pragma unroll
    for (int s = 0; s < 4; ++s) {
        const h16x8 pf = *(LAS h16x8*)(Pi + ra[s] + wid * 4096);
        const h16x8 qsf = qf[s] * xfh;
#pragma unroll
        for (int eb = 0; eb < 8; ++eb) {
            const h16x8 vf = cat8(trrd(Vi + tbv[eb][0] + s * 8192), trrd(Vi + tbv[eb][1] + s * 8192));
            ao[eb] = mfma16(vf, pf, ao[eb]);
            const h16x8 sf = cat8(trrd(Ki + tbv[eb][0] + s * 8192), trrd(Ki + tbv[eb][1] + s * 8192));
            ao[eb] = mfma16(sf, qsf, ao[eb]);
        }
    }
    __syncthreads();
#pragma unroll
    for (int i = 0; i < 4; ++i) *(LAS u32x4*)(Vi + st_o + i * 8192) = sbr[i];
    __syncthreads();
#pragma unroll
    for (int s = 0; s < 4; ++s) {
        const h16x8 qsb = qf[s] * xbh;
#pragma unroll
        for (int eb = 0; eb < 8; ++eb) {
            const h16x8 sf = cat8(trrd(Vi + tbv[eb][0] + s * 8192), trrd(Vi + tbv[eb][1] + s * 8192));
            ao[eb] = mfma16(sf, qsb, ao[eb]);
        }
    }
    float sum = 0.f;
#pragma unroll
    for (int eb = 0; eb < 8; ++eb) sum += (ao[eb][0] + ao[eb][1]) + (ao[eb][2] + ao[eb][3]);
    sum += __shfl_xor(sum, 16); sum += __shfl_xor(sum, 32);
    const float mean = sum * (1.f / 128.f); float q = 0.f;
#pragma unroll
    for (int eb = 0; eb < 8; ++eb) { ao[eb] = ao[eb] - mean; q += (ao[eb][0] * ao[eb][0] + ao[eb][1] * ao[eb][1]) + (ao[eb][2] * ao[eb][2] + ao[eb][3] * ao[eb][3]); }
    q += __shfl_xor(q, 16); q += __shfl_xor(q, 32);
    const float rstd = 1.f / sqrtf(q * (1.f / 128.f) + EPS);
    const int t = b * SEQ + c * 128 + il;
    const float* gw = a.in[I_RGN] + h * 128;
#pragma unroll
    for (int eb = 0; eb < 8; ++eb) {
        const int e = 16 * eb + 4 * g;
        const f32x4 w = *(const f32x4*)(gw + e);
        const h16x4 gs = *(const h16x4*)(GS + (size_t)t * 1024 + h * 128 + e);
        f32x4 o;
#pragma unroll
        for (int r = 0; r < 4; ++r) o[r] = ao[eb][r] * rstd * w[r] * (float)gs[r];
        st4(MIX + (size_t)t * DM + h * 128 + e, o);
    }
    __syncthreads();
}

namespace att {
constexpr float SCALE = 0.07216878364870322f;
constexpr float THR = 8.f;
constexpr int SHM_V = 16384, SHM_K = 16384, SHM_P = 8192;
constexpr int OFF_V = 0, OFF_K = 32768, OFF_P = 65536, OFF_W = 81920, OFF_QP = 83968;
using s16x4 = __attribute__((ext_vector_type(4))) short;
#define KSWZ(row, colB) ((row) * 256 + ((colB) ^ (((row) & 7) << 4)))
#define PSWZ(row, colB) ((row) * 128 + ((colB) ^ (((row) & 7) << 4)))
#define SBAR() __builtin_amdgcn_sched_barrier(0)
__device__ __forceinline__ int crow(int r, int hi) { return (r & 3) + 8 * (r >> 2) + 4 * hi; }
__device__ __forceinline__ unsigned pk2(float lo, float hi) { h16x2 v; v[0] = (h16)lo; v[1] = (h16)hi; return __builtin_bit_cast(unsigned, v); }
__device__ __forceinline__ f32x16 mfma32(h16x8 a, h16x8 b, f32x16 c) { return __builtin_amdgcn_mfma_f32_32x32x16_f16(a, b, c, 0, 0, 0); }
__device__ __forceinline__ void partialSM(f32x16& p0, f32x16& p1, float& m_reg, float& mn, float& alpha) {
    constexpr float C = SCALE * 1.4426950408889634f;
    float pmax = p0[0];
#pragma unroll
    for (int r = 1; r < 16; ++r) pmax = fmaxf(pmax, p0[r]);
#pragma unroll
    for (int r = 0; r < 16; ++r) pmax = fmaxf(pmax, p1[r]);
    { auto rr = __builtin_amdgcn_permlane32_swap(__float_as_uint(pmax), __float_as_uint(pmax), false, false);
      pmax = fmaxf(__uint_as_float(rr[0]), __uint_as_float(rr[1])); }
    if (__builtin_expect(__all(pmax - m_reg <= THR / SCALE), 1)) { mn = m_reg; alpha = 1.f; }
    else { mn = fmaxf(m_reg, pmax); alpha = __builtin_amdgcn_exp2f((m_reg - mn) * C); m_reg = mn; }
    const float mnC = -mn * C;
#pragma unroll
    for (int r = 0; r < 16; ++r) p0[r] = fmaf(p0[r], C, mnC);
#pragma unroll
    for (int r = 0; r < 16; ++r) p1[r] = fmaf(p1[r], C, mnC);
#pragma unroll
    for (int r = 0; r < 16; ++r) p0[r] = __builtin_amdgcn_exp2f(p0[r]);
}
__device__ __forceinline__ void finishSM(f32x16& p0, f32x16& p1, float alpha, float& l_reg, h16x8& pa0, h16x8& pa1, h16x8& pa2, h16x8& pa3) {
#pragma unroll
    for (int r = 0; r < 16; ++r) p1[r] = __builtin_amdgcn_exp2f(p1[r]);
    float ps = 0;
#pragma unroll
    for (int r = 0; r < 16; ++r) ps += p0[r];
#pragma unroll
    for (int r = 0; r < 16; ++r) ps += p1[r];
    { auto rr = __builtin_amdgcn_permlane32_swap(__float_as_uint(ps), __float_as_uint(ps), false, false);
      ps = __uint_as_float(rr[0]) + __uint_as_float(rr[1]); }
    l_reg = l_reg * alpha + ps;
#define PK4(P, BASE, OUT) do { unsigned a0 = pk2(P[BASE + 0], P[BASE + 1]), a1 = pk2(P[BASE + 2], P[BASE + 3]);   \
    unsigned b0 = pk2(P[BASE + 4], P[BASE + 5]), b1 = pk2(P[BASE + 6], P[BASE + 7]);                              \
    auto r0 = __builtin_amdgcn_permlane32_swap(a0, b0, false, false); auto r1 = __builtin_amdgcn_permlane32_swap(a1, b1, false, false); \
    u32x4 w = {r0[0], r1[0], r0[1], r1[1]}; OUT = __builtin_bit_cast(h16x8, w); } while (0)
    PK4(p0, 0, pa0); PK4(p0, 8, pa1); PK4(p1, 0, pa2); PK4(p1, 8, pa3);
#undef PK4
}
__device__ __forceinline__ void qkt(f32x16& p0, f32x16& p1, LAS char* Ks, LAS char* Ps, const h16x8* qr, LAS char* qpl, int r32, int hi) {
    p0 = f32x16{}; p1 = f32x16{};
#pragma unroll
    for (int d0 = 0; d0 < 8; ++d0) { const int cb = (d0 * 16 + hi * 8) * 2;
        const h16x8 b0 = *(LAS h16x8*)(Ks + KSWZ(r32, cb));
        const h16x8 b1 = *(LAS h16x8*)(Ks + KSWZ(32 + r32, cb));
        p0 = mfma32(b0, qr[d0], p0); p1 = mfma32(b1, qr[d0], p1); }
    SBAR();
#pragma unroll
    for (int d0 = 0; d0 < 4; ++d0) { const int cb = (d0 * 16 + hi * 8) * 2;
        const h16x8 b0 = *(LAS h16x8*)(Ps + PSWZ(r32, cb));
        const h16x8 b1 = *(LAS h16x8*)(Ps + PSWZ(32 + r32, cb));
        const h16x8 qv = *(LAS h16x8*)(qpl + PSWZ(r32, cb));
        p0 = mfma32(b0, qv, p0); p1 = mfma32(b1, qv, p1); }
}
__device__ __forceinline__ int v_st(int k, int c) { const int kk = (k & ~0xC) | ((k & 4) << 1) | ((k & 8) >> 1); return ((kk >> 3) * 4 + (c >> 5)) * 512 + ((kk & 7) * 32 + (c & 31)) * 2; }
__device__ __forceinline__ int v_rd_base(int lane) { return ((lane & 3) << 3) | (((lane >> 2) & 3) << 6) | (((lane >> 4) & 1) << 5) | (((lane >> 5) & 1) << 8); }
constexpr int v_rd_off(int d0, int ks, int half) { return d0 * 512 + ks * 4096 + half * 2048; }
template <int OFF> __device__ __forceinline__ s16x4 tr_read(int vb) {
    s16x4 r; asm volatile("ds_read_b64_tr_b16 %0, %1 offset:%2" : "=&v"(r) : "v"(vb), "i"(OFF) : "memory"); return r;
}
template <int D0> __device__ __forceinline__ void pv_one(f32x16& od, int vb, h16x8 pa0, h16x8 pa1, h16x8 pa2, h16x8 pa3) {
    const s16x4 l0 = tr_read<v_rd_off(D0, 0, 0)>(vb), h0 = tr_read<v_rd_off(D0, 0, 1)>(vb), l1 = tr_read<v_rd_off(D0, 1, 0)>(vb), h1 = tr_read<v_rd_off(D0, 1, 1)>(vb);
    const s16x4 l2 = tr_read<v_rd_off(D0, 2, 0)>(vb), h2 = tr_read<v_rd_off(D0, 2, 1)>(vb), l3 = tr_read<v_rd_off(D0, 3, 0)>(vb), h3 = tr_read<v_rd_off(D0, 3, 1)>(vb);
    asm volatile("s_waitcnt lgkmcnt(0)" ::: "memory"); SBAR();
#define PK(L, H) __builtin_bit_cast(h16x8, __builtin_shufflevector(L, H, 0, 1, 2, 3, 4, 5, 6, 7))
    od = mfma32(pa0, PK(l0, h0), od);
    od = mfma32(pa1, PK(l1, h1), od);
    od = mfma32(pa2, PK(l2, h2), od);
    od = mfma32(pa3, PK(l3, h3), od);
#undef PK
}
__device__ __forceinline__ void pv_d0(f32x16* o, int vb, h16x8 pa0, h16x8 pa1, h16x8 pa2, h16x8 pa3) {
    pv_one<0>(o[0], vb, pa0, pa1, pa2, pa3); pv_one<1>(o[1], vb, pa0, pa1, pa2, pa3); pv_one<2>(o[2], vb, pa0, pa1, pa2, pa3); pv_one<3>(o[3], vb, pa0, pa1, pa2, pa3);
}
__device__ __forceinline__ void attn_body(const h16* __restrict__ Qb, const h16* __restrict__ Kh, const h16* __restrict__ Vh, const h16* __restrict__ Ph,
                                          h16* __restrict__ Ob, int seq, LAS char* lds) {
    int tid = threadIdx.x; asm volatile("" : "+v"(tid));
    const int wid = tid >> 6, lane = tid & 63, r32 = lane & 31, hi = lane >> 5;
    LAS char* V_lds = lds + OFF_V; LAS char* K_lds = lds + OFF_K; LAS char* P_lds = lds + OFF_P;
    LAS float* wsf = (LAS float*)(lds + OFF_W) + wid * 64; LAS float* li_l = wsf; LAS float* al_l = wsf + 32;
    float m_reg = -1e30f, l_reg = 0; f32x16 o[4] = {}; h16x8 qr[8];
    LAS char* qp = lds + OFF_QP + wid * 4096;
    const h16* Qw = Qb + (size_t)(wid * 32 + r32) * 192 + hi * 8;
#pragma unroll
    for (int d0 = 0; d0 < 8; ++d0) qr[d0] = *(const h16x8*)(Qw + d0 * 16);
#pragma unroll
    for (int d0 = 0; d0 < 4; ++d0) *(LAS u32x4*)(qp + PSWZ(r32, (d0 * 16 + hi * 8) * 2)) = *(const u32x4*)(Qw + 128 + d0 * 16);
    const int sr = tid >> 4, sc = (tid & 15) * 8, vst0 = v_st(sr, sc), vst1 = v_st(32 + sr, sc);
    const int pr = tid >> 3, pc = (tid & 7) * 8;
    const int vb0 = (int)(uintptr_t)V_lds + v_rd_base(lane);
    struct { u32x4 vs0, vs1, ks0, ks1, ps; } sr_[1];
    const int vo = sr * 256 + sc * 2, po = pr * 128 + pc * 2;
    const __amdgpu_buffer_rsrc_t rsK = __builtin_amdgcn_make_buffer_rsrc((void*)Kh, (short)0, seq * 256, 0x00020000);
    const __amdgpu_buffer_rsrc_t rsV = __builtin_amdgcn_make_buffer_rsrc((void*)Vh, (short)0, seq * 256, 0x00020000);
    const __amdgpu_buffer_rsrc_t rsP = __builtin_amdgcn_make_buffer_rsrc((void*)Ph, (short)0, seq * 128, 0x00020000);
#define SLOAD(i, k0) do { const int so_ = (k0) * 256; \
    sr_[i].vs0 = __builtin_bit_cast(u32x4, __builtin_amdgcn_raw_buffer_load_b128(rsV, vo, so_, 0)); sr_[i].vs1 = __builtin_bit_cast(u32x4, __builtin_amdgcn_raw_buffer_load_b128(rsV, vo, so_ + 8192, 0)); \
    sr_[i].ks0 = __builtin_bit_cast(u32x4, __builtin_amdgcn_raw_buffer_load_b128(rsK, vo, so_, 0)); sr_[i].ks1 = __builtin_bit_cast(u32x4, __builtin_amdgcn_raw_buffer_load_b128(rsK, vo, so_ + 8192, 0)); \
    sr_[i].ps = __builtin_bit_cast(u32x4, __builtin_amdgcn_raw_buffer_load_b128(rsP, po, (k0) * 128, 0)); } while (0)
#define SWRITE(b, i) do { *(LAS u32x4*)(V_lds + (b) * SHM_V + vst0) = sr_[i].vs0;          \
    *(LAS u32x4*)(V_lds + (b) * SHM_V + vst1) = sr_[i].vs1; const int kc = sc * 2;               \
    *(LAS u32x4*)(K_lds + (b) * SHM_K + KSWZ(sr, kc)) = sr_[i].ks0;                       \
    *(LAS u32x4*)(K_lds + (b) * SHM_K + KSWZ(32 + sr, kc)) = sr_[i].ks1;                  \
    *(LAS u32x4*)(P_lds + (b) * SHM_P + PSWZ(pr, pc * 2)) = sr_[i].ps; } while (0)
#define SWAIT() asm volatile("s_waitcnt vmcnt(0)" ::: "memory")
#define RESC(a) do { if (__any((a) < 1.f)) { if (hi == 0) al_l[r32] = (a); asm volatile("s_waitcnt lgkmcnt(0)" ::: "memory"); \
    _Pragma("unroll") for (int d = 0; d < 4; ++d) _Pragma("unroll") for (int r = 0; r < 16; ++r) o[d][r] *= al_l[crow(r, hi)]; } } while (0)
    f32x16 pA0, pA1, pB0, pB1; float mnA, mnB, alA, alB; h16x8 pa0, pa1, pa2, pa3; const int NT = seq / 64;
    constexpr int SE = 0, SO = 0;
    SLOAD(SE, 0); asm volatile("s_waitcnt vmcnt(0)" ::: "memory"); SWRITE(0, SE); __syncthreads();
    qkt(pA0, pA1, K_lds, P_lds, qr, qp, r32, hi); partialSM(pA0, pA1, m_reg, mnA, alA);
    SLOAD(SO, 64);
    SWAIT(); SWRITE(1, SO); __syncthreads();
    for (int j = 1; j + 1 < NT; j += 2) {
        SBAR(); qkt(pB0, pB1, K_lds + SHM_K, P_lds + SHM_P, qr, qp, r32, hi);
        finishSM(pA0, pA1, alA, l_reg, pa0, pa1, pa2, pa3); SBAR();
        SLOAD(SO, (j + 1) * 64); SBAR();
        pv_d0(o, vb0, pa0, pa1, pa2, pa3); partialSM(pB0, pB1, m_reg, mnB, alB);
        __syncthreads(); SWAIT(); SWRITE(0, SE);
        RESC(alB); __syncthreads();
        SBAR(); qkt(pA0, pA1, K_lds, P_lds, qr, qp, r32, hi);
        finishSM(pB0, pB1, alB, l_reg, pa0, pa1, pa2, pa3); SBAR();
        SLOAD(SE, (j + 2) * 64); SBAR();
        pv_d0(o, vb0 + SHM_V, pa0, pa1, pa2, pa3); partialSM(pA0, pA1, m_reg, mnA, alA);
        __syncthreads(); SWAIT(); SWRITE(1, SO);
        RESC(alA); __syncthreads();
    }
    SBAR(); qkt(pB0, pB1, K_lds + SHM_K, P_lds + SHM_P, qr, qp, r32, hi);
    finishSM(pA0, pA1, alA, l_reg, pa0, pa1, pa2, pa3); SBAR();
    pv_d0(o, vb0, pa0, pa1, pa2, pa3); partialSM(pB0, pB1, m_reg, mnB, alB);
    __syncthreads(); RESC(alB);
    finishSM(pB0, pB1, alB, l_reg, pa0, pa1, pa2, pa3); SBAR();
    pv_d0(o, vb0 + SHM_V, pa0, pa1, pa2, pa3);
    if (hi == 0) li_l[r32] = l_reg; asm volatile("s_waitcnt lgkmcnt(0)" ::: "memory");
    float rli[16];
#pragma unroll
    for (int r = 0; r < 16; ++r) rli[r] = __builtin_amdgcn_rcpf(li_l[crow(r, hi)]);
    h16* Ow = Ob + (size_t)(wid * 32) * DM;
#pragma unroll
    for (int r = 0; r < 16; ++r) { const int orow = crow(r, hi);
#pragma unroll
        for (int d0 = 0; d0 < 4; ++d0) Ow[(size_t)orow * DM + d0 * 32 + r32] = (h16)(o[d0][r] * rli[r]); }
    __syncthreads();
#undef SLOAD
#undef SWRITE
#undef SWAIT
#undef RESC
}
#undef KSWZ
#undef PSWZ
}

__device__ __forceinline__ void phase_attn(const Args& a, LAS char* lds, int vcu) {
    const h16* Q = (const h16*)(a.ws + WS_Q); const h16* KN = (const h16*)(a.ws + WS_KN); const h16* VV = (const h16*)(a.ws + WS_VV);
    const h16* KPE = (const h16*)(a.ws + WS_KPE); h16* MIX = (h16*)(a.ws + WS_MIX);
    for (int it = vcu; it < 256; it += gridDim.x) {
        const int bh = it >> 3, qb = it & 7, b = bh >> 3, h = bh & 7;
        att::attn_body(Q + ((size_t)bh * SEQ + qb * 256) * 192, KN + (size_t)bh * LK * 128, VV + (size_t)bh * LK * 128, KPE + (size_t)b * LK * 64,
                       MIX + ((size_t)b * SEQ + qb * 256) * DM + 1024 + h * 128, LK, lds);
    }
}
__device__ __forceinline__ void phase_retout(const Args& a, LAS char* lds, int vcu) {
    for (int it = vcu; it < 512; it += gridDim.x) ret_out_item(a, lds, it >> 4, it & 15);
}

__device__ __forceinline__ void phase_oproj(const Args& a, LAS char* lds, int vcu) {
    GemmThread2 G; G.init();
    const h16* MIX = (const h16*)(a.ws + WS_MIX); const float* MOD = (const float*)(a.ws + WS_MOD); h16* U = (h16*)(a.ws + WS_U);
    const float* X = a.in[I_X];
    for (int p = vcu; p < 32 * 8; p += gridDim.x) {
        const int mg = p >> 5, rem = p & 31, nt = rem >> 2, mt = mg * 4 + (rem & 3);
        f32x4 acc[8][4];
        gemm_tile_g2(lds, G, MIX + (size_t)mt * 256 * DM, DM, (const h16*)(a.ws + WS_WO16) + nt * 256, DM, DM / 64, acc);
        const int b = mt >> 3, c0 = nt * 256 + G.wn * 64 + 4 * G.g;
        const float* g1 = MOD + (size_t)b * ADAW + 2 * DM + c0;
        f32x4 gv[4];
#pragma unroll
        for (int ni = 0; ni < 4; ++ni) gv[ni] = *(const f32x4*)(g1 + ni * 16);
        const size_t ro0 = (size_t)(mt * 256 + G.wm * 128 + G.r16) * DM + c0;
        f32x4 xn[4];
#pragma unroll
        for (int ni = 0; ni < 4; ++ni) xn[ni] = *(const f32x4*)(X + ro0 + ni * 16);
#pragma unroll
        for (int mi = 0; mi < 8; ++mi) {
            const size_t ro = ro0 + (size_t)mi * 16 * DM;
            f32x4 xv[4];
#pragma unroll
            for (int ni = 0; ni < 4; ++ni) xv[ni] = xn[ni];
            if (mi < 7) {
#pragma unroll
                for (int ni = 0; ni < 4; ++ni) xn[ni] = *(const f32x4*)(X + ro + (size_t)16 * DM + ni * 16);
            }
            __builtin_amdgcn_sched_barrier(0);
            f32x4 c[4];
#pragma unroll
            for (int ni = 0; ni < 4; ++ni) c[ni] = xv[ni] * ALPHA + gv[ni] * acc[mi][ni];
            st_rows16(U + ro - 4 * G.g, c, 1.f, G.g);
        }
    }
}

__device__ __forceinline__ int rt_off(int m, int c) { return m * 4096 + ((c ^ (m & 15)) << 4); }
__device__ __forceinline__ void phase_router(const Args& a, LAS char* lds) {
    const int tid = threadIdx.x, lane = tid & 63, wid = __builtin_amdgcn_readfirstlane(tid >> 6), r16 = lane & 15, g = lane >> 4;
    const h16* U = (const h16*)(a.ws + WS_U); const float* MOD = (const float*)(a.ws + WS_MOD);
    h16* H = (h16*)(a.ws + WS_H); unsigned char* A2q = (unsigned char*)(a.ws + WS_A2);
    int* LIST = (int*)(a.ws + WS_LIST); float* WL = (float*)(a.ws + WS_WL); unsigned* CNT = (unsigned*)(a.ws + WS_CTL) + CW_CNT;
    const h16* WRH = (const h16*)(a.ws + WS_WRH);
    const float* ln1w = a.in[I_LN1W]; const float* ln1b = a.in[I_LN1B];
    LAS char* THI = lds;
    LAS f32x4* red = (LAS f32x4*)lds;
    LAS float* lg = (LAS float*)(lds + 65536);
    LAS int* asg_e = (LAS int*)(lds + LDS_MAP + 2048); LAS int* asg_t = asg_e + 64; LAS float* asg_w = (LAS float*)(asg_e + 128);
    for (int base = blockIdx.x * 32; base < T; base += gridDim.x * 32) {
#pragma unroll 1
        for (int rr = 0; rr < 4; rr += 2) {
            const int m = 4 * wid + rr, row = base + m, b = row >> 11;
            f32x4 v[2][8]; float s[2] = {0.f, 0.f};
#pragma unroll
            for (int r = 0; r < 2; ++r)
#pragma unroll
                for (int j = 0; j < 8; ++j) { const h16x4 u4 = *(const h16x4*)(U + (size_t)(row + r) * DM + j * 256 + lane * 4);
#pragma unroll
                    for (int e = 0; e < 4; ++e) v[r][j][e] = (float)u4[e];
                    s[r] += (v[r][j][0] + v[r][j][1]) + (v[r][j][2] + v[r][j][3]); }
            float mean[2], q[2] = {0.f, 0.f}, rstd[2];
#pragma unroll
            for (int r = 0; r < 2; ++r) mean[r] = wave_sum(s[r]) * (1.f / DM);
#pragma unroll
            for (int r = 0; r < 2; ++r)
#pragma unroll
                for (int j = 0; j < 8; ++j) { v[r][j] = v[r][j] - mean[r]; q[r] += (v[r][j][0] * v[r][j][0] + v[r][j][1] * v[r][j][1]) + (v[r][j][2] * v[r][j][2] + v[r][j][3] * v[r][j][3]); }
#pragma unroll
            for (int r = 0; r < 2; ++r) { rstd[r] = 1.f / sqrtf(wave_sum(q[r]) * (1.f / DM) + EPS); s[r] = 0.f; }
#pragma unroll
            for (int j = 0; j < 8; ++j) {
                const int k = j * 256 + lane * 4;
                const f32x4 lw = *(const f32x4*)(ln1w + k), lb = *(const f32x4*)(ln1b + k);
#pragma unroll
                for (int r = 0; r < 2; ++r) {
                    v[r][j] = v[r][j] * rstd[r] * lw + lb;
                    *(h16x4*)(H + (size_t)(row + r) * DM + k) = cvt4(v[r][j]);
                    s[r] += (v[r][j][0] + v[r][j][1]) + (v[r][j][2] + v[r][j][3]);
                }
            }
#pragma unroll
            for (int r = 0; r < 2; ++r) { mean[r] = wave_sum(s[r]) * (1.f / DM); q[r] = 0.f; }
#pragma unroll
            for (int r = 0; r < 2; ++r)
#pragma unroll
                for (int j = 0; j < 8; ++j) { v[r][j] = v[r][j] - mean[r]; q[r] += (v[r][j][0] * v[r][j][0] + v[r][j][1] * v[r][j][1]) + (v[r][j][2] * v[r][j][2] + v[r][j][3] * v[r][j][3]); }
#pragma unroll
            for (int r = 0; r < 2; ++r) rstd[r] = 1.f / sqrtf(wave_sum(q[r]) * (1.f / DM) + EPS);
#pragma unroll
            for (int j = 0; j < 8; ++j) {
                const int k = j * 256 + lane * 4;
                const f32x4 sh = *(const f32x4*)(MOD + (size_t)b * ADAW + 3 * DM + k), sc = *(const f32x4*)(MOD + (size_t)b * ADAW + 4 * DM + k);
#pragma unroll
                for (int r = 0; r < 2; ++r) {
                    const f32x4 tt = v[r][j] * rstd[r] * (sc + 1.f) + sh;
                    const h16x4 hi = cvt4(tt);
                    int w8 = __builtin_amdgcn_cvt_pk_fp8_f32(tt[0], tt[1], 0, false); w8 = __builtin_amdgcn_cvt_pk_fp8_f32(tt[2], tt[3], w8, true);
                    *(int*)(A2q + (size_t)(row + r) * DM + k) = w8;
                    *(LAS h16x4*)(THI + rt_off(m + r, j * 32 + (lane >> 1)) + (lane & 1) * 8) = hi;
                }
            }
        }
        __syncthreads();
        f32x4 acc[2][3];
#pragma unroll
        for (int mt = 0; mt < 2; ++mt)
#pragma unroll
            for (int nt = 0; nt < 3; ++nt) acc[mt][nt] = (f32x4){0.f, 0.f, 0.f, 0.f};
#pragma unroll 4
        for (int s8 = 0; s8 < 8; ++s8) {
            const int c = wid * 32 + s8 * 4 + g;
            const h16x8 t0 = *(LAS h16x8*)(THI + rt_off(r16, c)), t1 = *(LAS h16x8*)(THI + rt_off(16 + r16, c));
#pragma unroll
            for (int nt = 0; nt < 3; ++nt) {
                const h16x8 wh = *(const h16x8*)(WRH + (size_t)(16 * nt + r16) * DM + c * 8);
                acc[0][nt] = mfma16(wh, t0, acc[0][nt]); acc[1][nt] = mfma16(wh, t1, acc[1][nt]);
            }
        }
        __syncthreads();
#pragma unroll
        for (int mt = 0; mt < 2; ++mt)
#pragma unroll
            for (int nt = 0; nt < 3; ++nt) red[(wid * 6 + mt * 3 + nt) * 64 + lane] = acc[mt][nt];
        __syncthreads();
        if (tid < 384) {
            const int t6 = tid >> 6, l2 = tid & 63, mt = t6 / 3, nt = t6 - 3 * mt;
            f32x4 sum = (f32x4){0.f, 0.f, 0.f, 0.f};
#pragma unroll
            for (int w = 0; w < 8; ++w) sum += red[(w * 6 + t6) * 64 + l2];
#pragma unroll
            for (int r = 0; r < 4; ++r) lg[(16 * mt + (l2 & 15)) * 48 + 16 * nt + 4 * (l2 >> 4) + r] = sum[r] * (1.f / 1024.f);
        }
        __syncthreads();
        if (tid < 32) {
            const int row = base + tid;
            const float* bg = a.in[I_RGB]; const float* be = a.in[I_REB];
            float glv[4];
#pragma unroll
            for (int c = 0; c < 4; ++c) glv[c] = lg[tid * 48 + c] + bg[c];
            int gs = 0; float gm = glv[0];
#pragma unroll
            for (int c = 1; c < 4; ++c) if (glv[c] > gm) { gm = glv[c]; gs = c; }
            float gden = 0.f;
#pragma unroll
            for (int c = 0; c < 4; ++c) gden += __expf(glv[c] - gm);
            const float gp = 1.f / gden;
            float el[8];
#pragma unroll
            for (int c = 0; c < 8; ++c) el[c] = lg[tid * 48 + 4 + gs * 8 + c] + be[gs * 8 + c];
            int i0 = 0; float v0 = el[0];
#pragma unroll
            for (int c = 1; c < 8; ++c) if (el[c] > v0) { v0 = el[c]; i0 = c; }
            int i1 = -1; float v1 = -3.0e38f;
#pragma unroll
            for (int c = 0; c < 8; ++c) if (c != i0 && el[c] > v1) { v1 = el[c]; i1 = c; }
            const float ex = __expf(v1 - v0), w0 = gp / (1.f + ex), w1 = gp * ex / (1.f + ex);
            asg_e[2 * tid] = gs * 8 + i0; asg_t[2 * tid] = row * 2; asg_w[2 * tid] = w0;
            asg_e[2 * tid + 1] = gs * 8 + i1; asg_t[2 * tid + 1] = row * 2 + 1; asg_w[2 * tid + 1] = w1;
        }
        __syncthreads();
        if (tid < NEXP) {
            int c = 0;
#pragma unroll 4
            for (int i = 0; i < 64; ++i) c += (asg_e[i] == tid) ? 1 : 0;
            if (c) {
                const int sub = tid * 8 + (blockIdx.x & 7);
                unsigned pos = atomicAdd(&CNT[sub], (unsigned)c);
                for (int i = 0; i < 64; ++i) if (asg_e[i] == tid) { LIST[(size_t)sub * SUBCAP + pos] = asg_t[i]; WL[(size_t)sub * SUBCAP + pos] = asg_w[i]; ++pos; }
            }
        }
        __syncthreads();
    }
}

struct MoeMap { int upre[NEXP + 1]; int rpre[NEXP + 1]; };
__device__ __forceinline__ void moe_map(const Args& a, LAS int* mp, int units_per_mtile) {
    const unsigned* CNT = (const unsigned*)(a.ws + WS_CTL) + CW_CNT;
    LAS int* c8 = mp + 448;
    if (threadIdx.x < NEXP * 8) c8[threadIdx.x] = (int)__hip_atomic_load(&CNT[threadIdx.x], __ATOMIC_RELAXED, __HIP_MEMORY_SCOPE_AGENT);
    __syncthreads();
    if (threadIdx.x < NEXP) {
        int acc = 0;
        for (int x = 0; x < 8; ++x) { mp[128 + 9 * threadIdx.x + x] = acc; acc += c8[threadIdx.x * 8 + x]; }
        mp[128 + 9 * threadIdx.x + 8] = acc; mp[66 + threadIdx.x] = acc;
    }
    __syncthreads();
    if (threadIdx.x == 0) {
        int up = 0, rp = 0;
        for (int e = 0; e < NEXP; ++e) {
            const int c = mp[66 + e];
            const int ntm = (c + 255) >> 8;
            mp[e] = up; mp[33 + e] = rp;
            up += ntm * units_per_mtile; rp += ntm * 256;
        }
        mp[32] = up; mp[65] = rp;
    }
    __syncthreads();
}
__device__ __forceinline__ int moe_pos(const LAS int* mp, int e, int idx) {
    const LAS int* sp = mp + 128 + 9 * e;
    int x = 0;
#pragma unroll
    for (int i = 1; i < 8; ++i) x += (idx >= sp[i]) ? 1 : 0;
    return (e * 8 + x) * SUBCAP + idx - sp[x];
}
__device__ __forceinline__ void wdown_pool(const Args& a, LAS char* lds, int budget);
__device__ __forceinline__ void phase_moe1(const Args& a, LAS char* lds, int vcu) {
    GemmThread G; G.init();
    LAS int* mp = (LAS int*)(lds + LDS_MAP);
    moe_map(a, mp, 8);
    const unsigned char* A2q = (const unsigned char*)(a.ws + WS_A2); const int* LIST = (const int*)(a.ws + WS_LIST); unsigned char* HID = (unsigned char*)(a.ws + WS_HID);
    const int NU = mp[32];
    for (int p = vcu; p < NU; p += gridDim.x) {
        int e = 0;
        while (p >= mp[e + 1]) ++e;
        const int q = p - mp[e], cnt = mp[66 + e], ntm = (cnt + 255) >> 8, nt = q / ntm, mt = q % ntm;
        const unsigned char* arow[2];
#pragma unroll
        for (int i = 0; i < 2; ++i) {
            const int idx = mt * 256 + (G.tid >> 2) + 128 * i;
            const int tok = (idx < cnt) ? (LIST[moe_pos(mp, e, idx)] >> 1) : 0;
            arow[i] = A2q + (size_t)tok * DM + (G.tid & 3) * 16;
        }
        const int c = (G.tid & 31) * 4, wnc = c >> 6, within = c & 63;
        const float* wsrc = (within >= 32) ? a.in[I_EWU] : a.in[I_EWG];
        const float* bcol = wsrc + (size_t)e * DM * DE + (size_t)(G.tid >> 5) * DE + nt * 64 + wnc * 32 + (within & 31);
        f32x4 acc[4][4];
        gemm_tile(lds, G, arow, bcol, (size_t)DE, DM / 64, acc);
        {
#pragma unroll
            for (int mi = 0; mi < 4; ++mi) {
                unsigned char* dst = HID + (size_t)(mp[33 + e] + mt * 256) * DE + nt * 16384 + (G.wm * 64 + mi * 16 + G.r16) * 64 + G.wn * 32 + 4 * G.g;
#pragma unroll
                for (int ni = 0; ni < 2; ++ni) {
                    f32x4 o;
#pragma unroll
                    for (int r = 0; r < 4; ++r) o[r] = silu_f(acc[mi][ni][r]) * acc[mi][ni + 2][r];
                    int w8 = __builtin_amdgcn_cvt_pk_fp8_f32(o[0], o[1], 0, false); w8 = __builtin_amdgcn_cvt_pk_fp8_f32(o[2], o[3], w8, true);
                    *(int*)(dst + ni * 16) = w8;
                }
            }
        }
    }
    wdown_pool(a, lds, 1 << 20);
}
constexpr int POOL_ITEMS = (NEXP * DE * DM / 8) / (NTHREADS * 8);
__device__ __forceinline__ void wdown_pool(const Args& a, LAS char* lds, int budget) {
    unsigned* head = (unsigned*)(a.ws + WS_CTL) + CW_POOL;
    const float* W = a.in[I_EWD]; h16* O = (h16*)(a.ws + WS_WD16);
    LAS unsigned* slot = (LAS unsigned*)(lds + LDS_MAP + 400);
    for (int it = 0; it < budget; ++it) {
        __syncthreads();
        if (threadIdx.x == 0) *slot = atomicAdd(head, 1u);
        __syncthreads();
        const unsigned item = *slot;
        if (item >= (unsigned)POOL_ITEMS) break;
        const size_t base = (size_t)item * (NTHREADS * 8) + threadIdx.x;
        f32x4 v[8][2];
#pragma unroll
        for (int j = 0; j < 8; ++j) { const float* p = W + (base + (size_t)j * NTHREADS) * 8; v[j][0] = *(const f32x4*)p; v[j][1] = *(const f32x4*)(p + 4); }
#pragma unroll
        for (int j = 0; j < 8; ++j) {
            h16x8 o;
#pragma unroll
            for (int e = 0; e < 4; ++e) { o[e] = (h16)v[j][0][e]; o[4 + e] = (h16)v[j][1][e]; }
            *(h16x8*)(O + (base + (size_t)j * NTHREADS) * 8) = o;
        }
    }
}
__device__ __forceinline__ void phase_moe2(const Args& a, LAS char* lds, int vcu) {
    GemmThread G; G.init();
    LAS int* mp = (LAS int*)(lds + LDS_MAP);
    moe_map(a, mp, 16);
    const unsigned char* HID = (const unsigned char*)(a.ws + WS_HID); const int* LIST = (const int*)(a.ws + WS_LIST); const float* WL = (const float*)(a.ws + WS_WL);
    const h16* WD16 = (const h16*)(a.ws + WS_WD16); h16* Y = (h16*)(a.ws + WS_Y);
    const int NU = mp[32];
    G3Stream S; S.gs = 0; S.primed = false;
    for (int p = vcu; p < NU; p += gridDim.x) {
        int e = 0;
        while (p >= mp[e + 1]) ++e;
        const int q = p - mp[e], cnt = mp[66 + e], ntm = (cnt + 255) >> 8, nt = q / ntm, mt = q % ntm;
        const int pn = p + (int)gridDim.x; const bool hn = pn < NU;
        const unsigned char* nA = nullptr; const h16* nB = nullptr;
        if (hn) { int e2 = e; while (pn >= mp[e2 + 1]) ++e2;
            const int q2 = pn - mp[e2], ntm2 = (mp[66 + e2] + 255) >> 8, nt2 = q2 / ntm2, mt2 = q2 % ntm2;
            nA = HID + (size_t)(mp[33 + e2] + mt2 * 256) * DE; nB = WD16 + (size_t)e2 * DE * DM + nt2 * 128; }
        f32x4 acc[4][4];
        gemm_tile_g8(lds, G, HID + (size_t)(mp[33 + e] + mt * 256) * DE, DE, WD16 + (size_t)e * DE * DM + nt * 128, DM, DE / 64, acc, S, nA, nB);
        {
#pragma unroll
            for (int mi = 0; mi < 4; ++mi) {
                const int idx = mt * 256 + G.wm * 64 + mi * 16 + G.r16;
                const bool ok = idx < cnt;
                const int lp = moe_pos(mp, e, ok ? idx : 0); const int slot = LIST[lp]; const float w = WL[lp];
                u32x4 v[2];
                acc_rows16(acc[mi], w, v);
                if (ok) {
                    h16* dst = Y + (size_t)slot * DM + nt * 128 + G.wn * 64 + 8 * G.g;
                    *(u32x4*)dst = v[0]; *(u32x4*)(dst + 32) = v[1];
                }
            }
        }
    }
}

__device__ __forceinline__ void phase_final(const Args& a) {
    const int tid = threadIdx.x, lane = tid & 63, wid = tid >> 6;
    const h16* H = (const h16*)(a.ws + WS_H); const h16* Y = (const h16*)(a.ws + WS_Y); const float* MOD = (const float*)(a.ws + WS_MOD);
    const float* w2 = a.in[I_LN2W]; const float* b2 = a.in[I_LN2B];
    for (int row = blockIdx.x * 16 + 2 * wid; row < T; row += gridDim.x * 16) {
        const int b = row >> 11;
        f32x4 v[2][8]; float s[2] = {0.f, 0.f};
#pragma unroll
        for (int j = 0; j < 8; ++j) {
            const int k = j * 256 + lane * 4;
            const f32x4 g2 = *(const f32x4*)(MOD + (size_t)b * ADAW + 5 * DM + k);
#pragma unroll
            for (int r = 0; r < 2; ++r) {
                const h16x4 h4 = *(const h16x4*)(H + (size_t)(row + r) * DM + k);
                const h16x4 y0 = *(const h16x4*)(Y + (size_t)((row + r) * 2) * DM + k), y1 = *(const h16x4*)(Y + (size_t)((row + r) * 2 + 1) * DM + k);
                f32x4 hv, yv;
#pragma unroll
                for (int e = 0; e < 4; ++e) { hv[e] = (float)h4[e]; yv[e] = (float)y0[e] + (float)y1[e]; }
                v[r][j] = hv * ALPHA + g2 * yv;
                s[r] += (v[r][j][0] + v[r][j][1]) + (v[r][j][2] + v[r][j][3]);
            }
            if (j == 3) __builtin_amdgcn_sched_barrier(0);
        }
        float mean[2], q[2] = {0.f, 0.f}, rstd[2];
#pragma unroll
        for (int r = 0; r < 2; ++r) mean[r] = wave_sum(s[r]) * (1.f / DM);
#pragma unroll
        for (int r = 0; r < 2; ++r)
#pragma unroll
            for (int j = 0; j < 8; ++j) { v[r][j] = v[r][j] - mean[r]; q[r] += (v[r][j][0] * v[r][j][0] + v[r][j][1] * v[r][j][1]) + (v[r][j][2] * v[r][j][2] + v[r][j][3] * v[r][j][3]); }
#pragma unroll
        for (int r = 0; r < 2; ++r) rstd[r] = 1.f / sqrtf(wave_sum(q[r]) * (1.f / DM) + EPS);
#pragma unroll
        for (int j = 0; j < 8; ++j) {
            const int k = j * 256 + lane * 4;
            const f32x4 lw = *(const f32x4*)(w2 + k), lb = *(const f32x4*)(b2 + k);
#pragma unroll
            for (int r = 0; r < 2; ++r) *(f32x4*)(a.out + (size_t)(row + r) * DM + k) = v[r][j] * rstd[r] * lw + lb;
        }
    }
}

constexpr int NPHASE = 13;
#ifndef REP_PHASE
#define REP_PHASE -1
#endif
#ifndef ONE_LAUNCH
#define ONE_LAUNCH 1
#endif
__global__ void __launch_bounds__(NTHREADS, 2) mega(Args a) {
    extern __shared__ __attribute__((aligned(16))) unsigned char lds_raw[];
    LAS char* lds = (LAS char*)lds_raw;
    volatile LAS unsigned* misc = (volatile LAS unsigned*)(lds + LDS_MISC);
    if (threadIdx.x < 64) misc[threadIdx.x] = 0u;
    __syncthreads();
    const int G_ = gridDim.x, bx = blockIdx.x;
    const int vcu = (G_ % 8 == 0) ? (bx % 8) * (G_ / 8) + bx / 8 : bx;
    XcdBarrier bar; bar.bar = (unsigned*)(a.ws + WS_CTL) + CW_BAR; bar.x = 0; bar.st = misc + 8;
    if (ONE_LAUNCH) bar = xcd_barrier_post((unsigned*)(a.ws + WS_CTL) + CW_BAR, misc + 8);
    const int lo = a.ph_lo, hi = a.ph_hi;
#ifndef PH_MASK
#define PH_MASK 0x1fff
#endif
#define IN(k) (((PH_MASK >> (k)) & 1) && lo <= (k) && (k) < hi)
#define SEAM(k) do { if (IN(k) && IN((k) + 1)) xcd_barrier(bar); } while (0)
    if (IN(0)) { phase_cvt(a); phase_adaln(a, lds); }
    SEAM(0);
    if (IN(1)) phase_modulate(a, lds);
    SEAM(1);
    if (IN(2)) phase_inproj(a, lds, vcu, 0);
    SEAM(2);
    if (IN(3)) phase_mid(a, lds, vcu);
    if (IN(3) && IN(4)) xcd_barrier(bar);
    if (IN(5)) phase_ret_scan(a);
    SEAM(5);
    if (IN(6)) phase_attn(a, lds, vcu);
    if (IN(7)) phase_retout(a, lds, vcu);
    SEAM(7);
    if (IN(8)) phase_oproj(a, lds, vcu);
    SEAM(8);
    if (IN(9)) phase_router(a, lds);
    SEAM(9);
    if (IN(10)) phase_moe1(a, lds, vcu);
    SEAM(10);
    if (IN(11)) phase_moe2(a, lds, vcu);
    SEAM(11);
    if (IN(12)) phase_final(a);
}

extern "C" void kernel_launch(void* const* d_in, const int* in_sizes, int n_in, void* d_out, int out_size, void* d_ws, size_t ws_size, hipStream_t stream) {
    static int grid = 0;
    if (grid == 0) {
        if (n_in != 25 || out_size != T * DM || ws_size < WS_END) { fprintf(stderr, "kernel_launch: unexpected shapes: n_in %d out %d ws %zu (need %zu)\n", n_in, out_size, ws_size, (size_t)WS_END); grid = -1; return; }
        int dev = 0, cus = 0, per_cu = 0;
        if (hipGetDevice(&dev) != hipSuccess || hipDeviceGetAttribute(&cus, hipDeviceAttributeMultiprocessorCount, dev) != hipSuccess) { grid = -1; return; }
        if (hipFuncSetAttribute((const void*)mega, hipFuncAttributeMaxDynamicSharedMemorySize, LDS_BYTES) != hipSuccess) { fprintf(stderr, "kernel_launch: hipFuncSetAttribute failed\n"); grid = -1; return; }
        if (hipOccupancyMaxActiveBlocksPerMultiprocessor(&per_cu, (const void*)mega, NTHREADS, LDS_BYTES) != hipSuccess || per_cu < 1) { fprintf(stderr, "kernel_launch: occupancy query says %d blocks per CU\n", per_cu); }
        (void)hipGetLastError();
        grid = cus;
    }
    if (grid < 0) return;
    (void)hipMemsetAsync((char*)d_ws + WS_CTL, 0, CTL_BYTES, stream);
    Args a{};
    for (int i = 0; i < 25; ++i) a.in[i] = (const float*)d_in[i];
    a.out = (float*)d_out; a.ws = (unsigned char*)d_ws;
    if (ONE_LAUNCH) {
        a.ph_lo = 0; a.ph_hi = NPHASE;
        hipLaunchKernelGGL(mega, dim3(grid), dim3(NTHREADS), LDS_BYTES, stream, a);
    } else {
        for (int p = 0; p < NPHASE; ++p) { a.ph_lo = p; a.ph_hi = p + 1;
            for (int r = 0; r < 1 + (p == REP_PHASE); ++r) {
                if (p == 9) (void)hipMemsetAsync((char*)d_ws + WS_CTL, 0, CTL_BYTES, stream);
                hipLaunchKernelGGL(mega, dim3(grid), dim3(NTHREADS), LDS_BYTES, stream, a); } }
    }
    const hipError_t le = hipPeekAtLastError();
    if (le != hipSuccess) fprintf(stderr, "kernel_launch: launch failed: %s\n", hipGetErrorName(le));
}
```

```cpp
#include <hip/hip_runtime.h>
#include <cstdio>
#include <cstdint>

#ifndef REP_MASK
#define REP_MASK 0
#endif
#define REP(k) ((REP_MASK >> (k)) & 1)
#define LAS __attribute__((address_space(3)))
#define GAS __attribute__((address_space(1)))
typedef _Float16 h16;
typedef _Float16 h16x8 __attribute__((ext_vector_type(8)));
typedef _Float16 h16x4 __attribute__((ext_vector_type(4)));
typedef _Float16 h16x2 __attribute__((ext_vector_type(2)));
typedef float f32x4 __attribute__((ext_vector_type(4)));
typedef float f32x2 __attribute__((ext_vector_type(2)));
typedef float f32x16 __attribute__((ext_vector_type(16)));
typedef unsigned u32x4 __attribute__((ext_vector_type(4)));
typedef unsigned u32x2 __attribute__((ext_vector_type(2)));
typedef short s16x4v __attribute__((__vector_size__(8)));

constexpr int DM = 2048, NB = 4, SEQ = 2048, LC = 256, LK = LC + SEQ;
constexpr int T = NB * SEQ, TCX = NB * LC, TA = T + TCX;
constexpr int INW = 4928, NEXP = 32, DE = 512;
constexpr int ADAW = 6 * DM;
constexpr float EPS = 1e-6f, ALPHA = 1.189207115002721f;
constexpr float KSCALE = 0.08838834764831845f;
constexpr float L2_10000 = 13.287712379549449f;
constexpr int NTHREADS = 512;

constexpr size_t al256(size_t x) { return (x + 255) / 256 * 256; }
constexpr size_t WS_CTL = 0, CTL_BYTES = 65536;
constexpr size_t WS_PART = WS_CTL + CTL_BYTES;
constexpr size_t WS_MOD = WS_PART + al256((size_t)8 * 5 * ADAW * 4);
constexpr size_t WS_A1 = WS_MOD + al256((size_t)5 * ADAW * 4);
constexpr size_t WS_QR = WS_A1 + al256((size_t)TA * DM * 2);
constexpr size_t WS_KR = WS_QR + al256((size_t)T * 1024 * 2);
constexpr size_t WS_VR = WS_KR + al256((size_t)T * 1024 * 2);
constexpr size_t WS_KC = WS_VR + al256((size_t)T * 1024 * 2);
constexpr size_t WS_VC = WS_KC + al256((size_t)TCX * 1024 * 2);
constexpr size_t WS_GS = WS_VC + al256((size_t)TCX * 1024 * 2);
constexpr size_t WS_CQ = WS_GS + al256((size_t)T * 1024 * 2);
constexpr size_t WS_CKV = WS_CQ + al256((size_t)T * 512 * 2);
constexpr size_t WS_KPE = WS_CKV + al256((size_t)NB * LK * 256 * 2);
constexpr size_t WS_Q = WS_KPE + al256((size_t)NB * LK * 64 * 2);
constexpr size_t WS_KN = WS_Q + al256((size_t)T * 1536 * 2);
constexpr size_t WS_VV = WS_KN + al256((size_t)NB * 8 * LK * 128 * 2);
constexpr size_t WS_UF = WS_VV + al256((size_t)NB * 8 * LK * 128 * 2);
constexpr size_t WS_UB = WS_UF + al256((size_t)32 * 16 * 16384 * 4);
constexpr size_t WS_S0F = WS_UB + al256((size_t)32 * 16 * 16384 * 4);
constexpr size_t WS_S0B = WS_S0F + al256((size_t)32 * 16384 * 4);
constexpr size_t WS_SF = WS_S0B + al256((size_t)32 * 16384 * 4);
constexpr size_t WS_SB = WS_SF + al256((size_t)32 * 16 * 16384 * 2);
constexpr size_t WS_MIX = WS_SB + al256((size_t)32 * 16 * 16384 * 2);
constexpr size_t WS_U = WS_MIX + al256((size_t)T * DM * 2);
constexpr size_t WS_H = WS_U + al256((size_t)T * DM * 2);
constexpr size_t WS_A2 = WS_H + al256((size_t)T * DM * 2);
constexpr int SUBCAP = 2048;
constexpr size_t WS_LIST = WS_A2 + al256((size_t)T * DM * 2);
constexpr size_t WS_WL = WS_LIST + al256((size_t)NEXP * 8 * SUBCAP * 4);
constexpr int HID_ROWS = 2 * T + NEXP * 256;
constexpr size_t WS_HID = WS_WL + al256((size_t)NEXP * 8 * SUBCAP * 4);
constexpr size_t WS_Y = WS_HID + al256((size_t)HID_ROWS * DE * 2);
constexpr int WINP = 5120;
constexpr size_t WS_WIN16 = WS_Y + al256((size_t)2 * T * DM * 2);
constexpr size_t WS_WO16 = WS_WIN16 + al256((size_t)DM * WINP * 2);
constexpr size_t WS_WUQ16 = WS_WO16 + al256((size_t)DM * DM * 2);
constexpr size_t WS_WUKV16 = WS_WUQ16 + al256((size_t)512 * 1536 * 2);
constexpr size_t WS_WRH = WS_WUKV16 + al256((size_t)256 * 2048 * 2);
constexpr size_t WS_WRL = WS_WRH + al256((size_t)48 * DM * 2);
constexpr size_t WS_WD16 = WS_WRL + al256((size_t)48 * DM * 2);
constexpr size_t WS_END = WS_WD16 + al256((size_t)NEXP * DE * DM * 2);

constexpr int CW_CNT = 256;
constexpr int CW_POOL = 128;
constexpr int CW_BAR = 1024;

constexpr int LDS_BYTES = 151808;
constexpr int LDS_ROWS = 147456;
constexpr int LDS_MAP = 148480;
constexpr int LDS_MISC = 151552;

template <int M> __device__ __forceinline__ float swz_xor(float v) {
    return __int_as_float(__builtin_amdgcn_ds_swizzle(__float_as_int(v), 0x1F | (M << 10)));
}
__device__ __forceinline__ float wave_sum(float v) {
    v += swz_xor<1>(v); v += swz_xor<2>(v); v += swz_xor<4>(v); v += swz_xor<8>(v); v += swz_xor<16>(v);
    { auto rr = __builtin_amdgcn_permlane32_swap(__float_as_uint(v), __float_as_uint(v), false, false); v = __uint_as_float(rr[0]) + __uint_as_float(rr[1]); }
    return v;
}
__device__ __forceinline__ float silu_f(float x) { return x / (1.f + __expf(-x)); }
__device__ __forceinline__ h16x4 cvt4(f32x4 v) { h16x4 r; r[0] = (h16)v[0]; r[1] = (h16)v[1]; r[2] = (h16)v[2]; r[3] = (h16)v[3]; return r; }
__device__ __forceinline__ h16x4 trrd(LAS char* p) { s16x4v t = __builtin_amdgcn_ds_read_tr16_b64_v4i16((LAS s16x4v*)p); return __builtin_bit_cast(h16x4, t); }
__device__ __forceinline__ h16x8 cat8(h16x4 a, h16x4 b) { return __builtin_shufflevector(a, b, 0, 1, 2, 3, 4, 5, 6, 7); }
__device__ __forceinline__ f32x4 mfma16(h16x8 a, h16x8 b, f32x4 c) { return __builtin_amdgcn_mfma_f32_16x16x32_f16(a, b, c, 0, 0, 0); }

__device__ __forceinline__ int a_off(int row, int ch) { return row * 128 + ((ch ^ (row & 7)) << 4); }
__device__ __forceinline__ int off_b(int row, int ch) { return 256 * row + 16 * (ch ^ (((row & 3) << 2) | ((row >> 2) & 3))); }
__device__ __forceinline__ int tr_addr16(int lane, int c, int ks, int t) {
    const int g = lane >> 4, q = (lane & 15) >> 2, p = lane & 3;
    return off_b(32 * ks + 8 * g + 4 * t + q, 2 * c + (p >> 1)) + 8 * (p & 1);
}
__device__ __forceinline__ int row_addr16(int lane, int rb, int s) { return off_b((lane & 15) + 16 * rb, 4 * s + (lane >> 4)); }

#define XB_TMO      128
#define XB_XCNT(j)  (256  + 64 * (j))
#define XB_XSUB(j)  (1280 + 64 * (j))
#define XB_XGEN(j)  (2304 + 64 * (j))
#define XB_TOP      3328
#define XB_TOPGEN   3392
#define XCD_BAR_WORDS 3456
#define XB_SPIN_CAP (1u << 22)
__device__ __forceinline__ unsigned xb_ld(unsigned* p)              { return __hip_atomic_load(p, __ATOMIC_RELAXED, __HIP_MEMORY_SCOPE_AGENT); }
__device__ __forceinline__ unsigned xb_add(unsigned* p, unsigned v) { return __hip_atomic_fetch_add(p, v, __ATOMIC_RELAXED, __HIP_MEMORY_SCOPE_AGENT); }
__device__ __forceinline__ unsigned xb_xcc_id() { return (unsigned)__builtin_amdgcn_s_getreg((3 << 11) | 20) & 0xFu; }
#define XB_SPIN(cond, bar) do { unsigned _sp = 0; while (cond) { __builtin_amdgcn_s_sleep(1); \
    if ((++_sp & 255u) == 0u) { if (xb_ld(&(bar)[XB_TMO])) break; if (_sp > XB_SPIN_CAP) { atomicAdd(&(bar)[XB_TMO], 1u); break; } } } } while (0)
struct XcdBarrier { unsigned* bar; unsigned x; volatile LAS unsigned* st; };
__device__ __forceinline__ XcdBarrier xcd_barrier_post(unsigned* bar, volatile LAS unsigned* st) {
    XcdBarrier b; b.bar = bar; b.x = xb_xcc_id(); b.st = st;
    if (threadIdx.x == 0) (void)xb_add(&bar[XB_XCNT(b.x)], 1u);
    return b;
}
__device__ __forceinline__ void xcd_barrier_complete(unsigned* bar, unsigned x, unsigned& nloc, unsigned& nx) {
    const unsigned G = gridDim.x * gridDim.y * gridDim.z;
    unsigned sum, cnt, mine, sp = 0u;
    for (;;) {
        sum = 0u; cnt = 0u; mine = 0u;
#pragma unroll
        for (unsigned j = 0; j < 16; ++j) { const unsigned c = xb_ld(&bar[XB_XCNT(j)]); sum += c; cnt += (c > 0u) ? 1u : 0u; mine = (j == x) ? c : mine; }
        if (sum == G) break;
        __builtin_amdgcn_s_sleep(1);
        if ((++sp & 255u) == 0u) { if (xb_ld(&bar[XB_TMO])) break; if (sp > XB_SPIN_CAP) { atomicAdd(&bar[XB_TMO], 1u); break; } }
    }
    nloc = mine > 0u ? mine : 1u; nx = cnt > 0u ? cnt : 1u;
}
__device__ __forceinline__ void xcd_barrier(const XcdBarrier& b) {
    asm volatile("s_waitcnt vmcnt(0)" ::: "memory");
    __syncthreads();
    if (threadIdx.x == 0) {
        unsigned* bar = b.bar;
        __builtin_amdgcn_s_waitcnt(0);
        unsigned nloc = b.st[0], nx = b.st[1];
        if (nloc == 0u) { xcd_barrier_complete(bar, b.x, nloc, nx); b.st[0] = nloc; b.st[1] = nx; }
        const unsigned old = xb_add(&bar[XB_XSUB(b.x)], 1u);
        const unsigned gen = old / nloc;
        if (old + 1u == (gen + 1u) * nloc) {
            __builtin_amdgcn_fence(__ATOMIC_RELEASE, "agent");
            asm volatile("s_waitcnt vmcnt(0)" ::: "memory");
            const unsigned og = xb_add(&bar[XB_TOP], 1u);
            const unsigned tg = og / nx;
            if (og + 1u == (tg + 1u) * nx) xb_add(&bar[XB_TOPGEN], 1u);
            else XB_SPIN(xb_ld(&bar[XB_TOPGEN]) == tg, bar);
            __builtin_amdgcn_fence(__ATOMIC_ACQUIRE, "agent");
            xb_add(&bar[XB_XGEN(b.x)], 1u);
            asm volatile("s_waitcnt vmcnt(0)" ::: "memory");
        } else {
            XB_SPIN(xb_ld(&bar[XB_XGEN(b.x)]) == gen, bar);
            __builtin_amdgcn_fence(__ATOMIC_ACQUIRE, "agent");
            asm volatile("s_waitcnt vmcnt(0)" ::: "memory");
        }
    }
    __syncthreads();
}

struct Args {
    const float* in[25];
    float* out;
    unsigned char* ws;
    int ph_lo, ph_hi;
};
enum { I_X = 0, I_C, I_CTX, I_CCTX, I_WADA, I_BADA, I_WIN, I_RDEC, I_RGN, I_QNORM, I_KVNORM, I_WUQ, I_WUKV, I_WO, I_LN1W, I_LN1B,
       I_RGW, I_RGB, I_REW, I_REB, I_EWG, I_EWU, I_EWD, I_LN2W, I_LN2B };

__device__ __forceinline__ void wdown_pool(const Args& a, LAS char* lds, int budget);
constexpr int GEMM_STAGE = 49152, GEMM_ROWS_OFF = LDS_ROWS;
struct GemmThread {
    int tid, lane, wid, wm, wn, r16, g;
    int a_st;
    int b_st;
    int ta[2];
    int tb[4][2];
    __device__ __forceinline__ void init(bool opaque = false) {
        tid = threadIdx.x; if (opaque) asm volatile("" : "+v"(tid));
        lane = tid & 63; wid = __builtin_amdgcn_readfirstlane(tid >> 6); wm = wid >> 1; wn = wid & 1; r16 = lane & 15; g = lane >> 4;
        a_st = a_off(tid >> 3, tid & 7);
        const int nq = tid & 31, kk = tid >> 5;
        b_st = off_b(kk, nq >> 1) + (nq & 1) * 8;
#pragma unroll
        for (int ks = 0; ks < 2; ++ks) ta[ks] = a_off(wm * 64 + r16, ks * 4 + g);
#pragma unroll
        for (int ni = 0; ni < 4; ++ni)
#pragma unroll
            for (int t = 0; t < 2; ++t) tb[ni][t] = tr_addr16(lane, wn * 4 + ni, 0, t);
    }
};

typedef _Float16 h16x2v __attribute__((ext_vector_type(2)));
__device__ __forceinline__ h16x8 fp8x8_to_h16(unsigned w0, unsigned w1) {
    const h16x2v a = __builtin_amdgcn_cvt_scalef32_pk_f16_fp8((int)w0, 1.0f, false), b = __builtin_amdgcn_cvt_scalef32_pk_f16_fp8((int)w0, 1.0f, true);
    const h16x2v c = __builtin_amdgcn_cvt_scalef32_pk_f16_fp8((int)w1, 1.0f, false), d = __builtin_amdgcn_cvt_scalef32_pk_f16_fp8((int)w1, 1.0f, true);
    h16x8 r; r[0] = a[0]; r[1] = a[1]; r[2] = b[0]; r[3] = b[1]; r[4] = c[0]; r[5] = c[1]; r[6] = d[0]; r[7] = d[1];
    return r;
}
__device__ __forceinline__ void gemm_tile(LAS char* lds, const GemmThread& G, const unsigned char* const (&arow)[2], const float* bcol, size_t ldb,
                                          int nk, f32x4 (&acc)[4][4]) {
#pragma unroll
    for (int i = 0; i < 4; ++i)
#pragma unroll
        for (int j = 0; j < 4; ++j) acc[i][j] = (f32x4){0.f, 0.f, 0.f, 0.f};
    u32x4 ar0[2], ar1[2]; f32x4 br0[4], br1[4];
    const int aq0 = a_off(G.tid >> 2, 2 * (G.tid & 3)), aq1 = a_off(G.tid >> 2, 2 * (G.tid & 3) + 1);
#define GT_LOAD(AR, BR, kt) do { _Pragma("unroll") for (int i = 0; i < 2; ++i) AR[i] = *(const u32x4*)(arow[i] + (size_t)(kt) * 64); \
        _Pragma("unroll") for (int i = 0; i < 4; ++i) BR[i] = *(const f32x4*)(bcol + (size_t)((kt) * 64 + 16 * i) * ldb); } while (0)
#define GT_STORE(AR, BR, buf) do { LAS char* Ab_ = lds + (buf) * GEMM_STAGE; _Pragma("unroll") for (int i = 0; i < 2; ++i) { \
        *(LAS h16x8*)(Ab_ + aq0 + i * 16384) = fp8x8_to_h16(AR[i][0], AR[i][1]); *(LAS h16x8*)(Ab_ + aq1 + i * 16384) = fp8x8_to_h16(AR[i][2], AR[i][3]); } \
        _Pragma("unroll") for (int i = 0; i < 4; ++i) *(LAS h16x4*)(Ab_ + 32768 + G.b_st + i * 4096) = cvt4(BR[i]); } while (0)
#define GT_COMP(buf) do { LAS char* Ab = lds + (buf) * GEMM_STAGE; LAS char* Bb = Ab + 32768; \
        _Pragma("unroll") for (int ks = 0; ks < 2; ++ks) { h16x8 bf[4], af[4]; \
            _Pragma("unroll") for (int ni = 0; ni < 4; ++ni) bf[ni] = cat8(trrd(Bb + G.tb[ni][0] + ks * 8192), trrd(Bb + G.tb[ni][1] + ks * 8192)); \
            _Pragma("unroll") for (int mi = 0; mi < 4; ++mi) af[mi] = *(LAS h16x8*)(Ab + G.ta[ks] + mi * 2048); \
            _Pragma("unroll") for (int mi = 0; mi < 4; ++mi) _Pragma("unroll") for (int ni = 0; ni < 4; ++ni) acc[mi][ni] = mfma16(bf[ni], af[mi], acc[mi][ni]); } } while (0)
    __syncthreads();
    GT_LOAD(ar0, br0, 0);
    GT_LOAD(ar1, br1, 1);
    GT_STORE(ar0, br0, 0);
    __syncthreads();
    int kt = 0;
    for (; kt + 2 < nk; kt += 2) {
        GT_LOAD(ar0, br0, kt + 2); __builtin_amdgcn_sched_barrier(0);
        GT_COMP(0); __builtin_amdgcn_sched_barrier(0);
        GT_STORE(ar1, br1, 1);
        __syncthreads();
        GT_LOAD(ar1, br1, kt + 3); __builtin_amdgcn_sched_barrier(0);
        GT_COMP(1); __builtin_amdgcn_sched_barrier(0);
        GT_STORE(ar0, br0, 0);
        __syncthreads();
    }
    GT_COMP(0);
    GT_STORE(ar1, br1, 1);
    __syncthreads();
    GT_COMP(1);
#undef GT_LOAD
#undef GT_STORE
#undef GT_COMP
}

typedef short s16x4 __attribute__((ext_vector_type(4)));
template <int OFF> __device__ __forceinline__ s16x4 asm_tr(int addr) { s16x4 r; asm volatile("ds_read_b64_tr_b16 %0, %1 offset:%2" : "=v"(r) : "v"(addr), "i"(OFF) : "memory"); return r; }
template <int OFF> __device__ __forceinline__ h16x8 asm_rd128(int addr) { h16x8 r; asm volatile("ds_read_b128 %0, %1 offset:%2" : "=v"(r) : "v"(addr), "i"(OFF) : "memory"); return r; }
#define LGKM0() do { asm volatile("s_waitcnt lgkmcnt(0)" ::: "memory"); __builtin_amdgcn_sched_barrier(0); } while (0)
__device__ __forceinline__ h16x8 cat8s(s16x4 a, s16x4 b) { return __builtin_bit_cast(h16x8, __builtin_shufflevector(a, b, 0, 1, 2, 3, 4, 5, 6, 7)); }
struct G3Stream { int gs; bool primed; };
template <bool RMS>
__device__ __forceinline__ void gemm_tile_g(LAS char* lds, const GemmThread& G, const h16* Ab, int lda, const h16* Bb, int ldb, int nk, f32x4 (&acc)[4][4],
                                            G3Stream& S, const h16* nAb, const h16* nBb) {
#pragma unroll
    for (int i = 0; i < 4; ++i)
#pragma unroll
        for (int j = 0; j < 4; ++j) acc[i][j] = (f32x4){0.f, 0.f, 0.f, 0.f};
    float ss[4] = {0.f, 0.f, 0.f, 0.f};
    const bool loader = G.wid < 4; const int wq = G.wid & 3;
    const size_t a_i = (size_t)64 * lda, a_h = (size_t)32 * lda, b_i = (size_t)32 * ldb, b_h = (size_t)16 * ldb, b_k = (size_t)64 * ldb;
    const size_t lane_a = (size_t)(8 * wq + (G.lane >> 3)) * lda + (((G.lane & 7) ^ (G.lane >> 3)) << 3);
    const size_t lane_b = (size_t)(4 * wq + (G.lane >> 4)) * ldb + (((G.lane & 15) ^ (((G.lane >> 4) << 2) | wq)) << 3);
    const bool has_next = (nAb != nullptr);
    const h16* asrc = Ab + lane_a; const h16* bsrc = Bb + lane_b;
    const h16* nasrc = (has_next ? nAb : Ab) + lane_a; const h16* nbsrc = (has_next ? nBb : Bb) + lane_b;
    LAS char* wbase = lds + wq * 1024;
    const int lbase = (int)(uintptr_t)lds;
#define G3_ISSUE_(AS, BS, kt, st) do { LAS char* sb_ = wbase + (st) * GEMM_STAGE; \
        _Pragma("unroll") for (int h = 0; h < 2; ++h) { \
        _Pragma("unroll") for (int i = 0; i < 4; ++i) __builtin_amdgcn_global_load_lds((const unsigned*)((AS) + i * a_i + h * a_h + (size_t)(kt) * 64), (LAS unsigned*)(sb_ + h * 4096 + i * 8192), 16, 0, 0); \
        _Pragma("unroll") for (int i = 0; i < 2; ++i) __builtin_amdgcn_global_load_lds((const unsigned*)((BS) + i * b_i + h * b_h + (size_t)(kt) * b_k), (LAS unsigned*)(sb_ + 32768 + h * 4096 + i * 8192), 16, 0, 0); } } while (0)
#define G3_ISSUE(kt, st) G3_ISSUE_(asrc, bsrc, kt, st)
#define G3_READ(BF, AF, KS) do { \
        BF[0] = cat8s(asm_tr<32768 + (KS) * 8192>(sbase + G.tb[0][0]), asm_tr<32768 + (KS) * 8192>(sbase + G.tb[0][1])); \
        BF[1] = cat8s(asm_tr<32768 + (KS) * 8192>(sbase + G.tb[1][0]), asm_tr<32768 + (KS) * 8192>(sbase + G.tb[1][1])); \
        BF[2] = cat8s(asm_tr<32768 + (KS) * 8192>(sbase + G.tb[2][0]), asm_tr<32768 + (KS) * 8192>(sbase + G.tb[2][1])); \
        BF[3] = cat8s(asm_tr<32768 + (KS) * 8192>(sbase + G.tb[3][0]), asm_tr<32768 + (KS) * 8192>(sbase + G.tb[3][1])); \
        AF[0] = asm_rd128<0>(sbase + G.ta[KS]); AF[1] = asm_rd128<2048>(sbase + G.ta[KS]); AF[2] = asm_rd128<4096>(sbase + G.ta[KS]); AF[3] = asm_rd128<6144>(sbase + G.ta[KS]); } while (0)
#define G3_MMA(BF, AF) do { _Pragma("unroll") for (int mi = 0; mi < 4; ++mi) _Pragma("unroll") for (int ni = 0; ni < 4; ++ni) acc[mi][ni] = mfma16(BF[ni], AF[mi], acc[mi][ni]); } while (0)
    int sc = S.gs, si = (S.gs == 0) ? 2 : S.gs - 1;
    if (!S.primed) {
        asm volatile("s_waitcnt vmcnt(0)" ::: "memory");
        __builtin_amdgcn_s_barrier();
        asm volatile("" ::: "memory");
        if (loader) { G3_ISSUE(0, sc); G3_ISSUE(1, (sc == 2) ? 0 : sc + 1); }
    }
    for (int kt = 0; kt < nk; ++kt) {
        if (loader) { if ((kt == 0 && S.primed) || !(kt + 1 < nk || has_next)) asm volatile("s_waitcnt vmcnt(0)" ::: "memory"); else asm volatile("s_waitcnt vmcnt(12)" ::: "memory"); }
        __builtin_amdgcn_s_barrier();
        asm volatile("" ::: "memory");
        if (loader) {
            if (kt + 2 < nk) G3_ISSUE(kt + 2, si);
            else if (has_next) G3_ISSUE_(nasrc, nbsrc, kt + 2 - nk, si);
        }
        const int sbase = lbase + sc * GEMM_STAGE;
        h16x8 bf0[4], af0[4], bf1[4], af1[4];
        G3_READ(bf0, af0, 0);
        if (RMS) {
            h16x8 hv[4];
            hv[0] = asm_rd128<0>(sbase + G.a_st); hv[1] = asm_rd128<8192>(sbase + G.a_st); hv[2] = asm_rd128<16384>(sbase + G.a_st); hv[3] = asm_rd128<24576>(sbase + G.a_st);
            LGKM0();
#pragma unroll
            for (int i = 0; i < 4; ++i)
#pragma unroll
                for (int e = 0; e < 8; ++e) { const float f = (float)hv[i][e]; ss[i] += f * f; }
        } else LGKM0();
        G3_READ(bf1, af1, 1);
        G3_MMA(bf0, af0);
        LGKM0();
        G3_MMA(bf1, af1);
        sc = (sc == 2) ? 0 : sc + 1; si = (si == 2) ? 0 : si + 1;
    }
#undef G3_ISSUE
#undef G3_ISSUE_
#undef G3_READ
#undef G3_MMA
    S.gs = sc; S.primed = has_next;
    if (RMS) {
        LAS float* rs = (LAS float*)(lds + GEMM_ROWS_OFF);
#pragma unroll
        for (int i = 0; i < 4; ++i) {
            float s = ss[i]; s += __shfl_xor(s, 1); s += __shfl_xor(s, 2); s += __shfl_xor(s, 4);
            if ((G.tid & 7) == 0) rs[(G.tid >> 3) + 64 * i] = __builtin_amdgcn_rsqf(s / (float)(nk * 64) + EPS);
        }
        asm volatile("s_waitcnt lgkmcnt(0)" ::: "memory");
        __builtin_amdgcn_s_barrier();
        asm volatile("" ::: "memory");
    }
}

constexpr int G2_STAGE = 65536;
struct GemmThread2 {
    int tid, lane, wid, wm, wn, r16, g;
    int ta[2];
    int tb[4][2];
    __device__ __forceinline__ void init() {
        tid = threadIdx.x; lane = tid & 63; wid = __builtin_amdgcn_readfirstlane(tid >> 6); wm = wid >> 2; wn = wid & 3; r16 = lane & 15; g = lane >> 4;
#pragma unroll
        for (int ks = 0; ks < 2; ++ks) ta[ks] = a_off(wm * 128 + r16, ks * 4 + g);
#pragma unroll
        for (int ni = 0; ni < 4; ++ni)
#pragma unroll
            for (int t = 0; t < 2; ++t) tb[ni][t] = 32768 + (wn >> 1) * 16384 + tr_addr16(lane, (wn & 1) * 4 + ni, 0, t);
    }
};
__device__ __forceinline__ void gemm_tile_g2(LAS char* lds, const GemmThread2& G, const h16* Ab, int lda, const h16* Bb, int ldb, int nk, f32x4 (&acc)[8][4]) {
#pragma unroll
    for (int i = 0; i < 8; ++i)
#pragma unroll
        for (int j = 0; j < 4; ++j) acc[i][j] = (f32x4){0.f, 0.f, 0.f, 0.f};
    const bool loader = G.wid < 4;
    const int wq = G.wid & 3;
    const unsigned aoff = (unsigned)(((8 * wq + (G.lane >> 3)) * lda + (((G.lane & 7) ^ (G.lane >> 3)) << 3)) * 2);
    const unsigned boff = (unsigned)(((4 * wq + (G.lane >> 4)) * ldb + (((G.lane & 15) ^ (((G.lane >> 4) << 2) | wq)) << 3)) * 2);
    const char* asrc = (const char*)Ab; const char* bsrc = (const char*)Bb;
    const size_t a_i = (size_t)128 * lda, a_h = (size_t)64 * lda, b_i = (size_t)64 * ldb, b_h = (size_t)32 * ldb, b_k = (size_t)128 * ldb;
    LAS char* wbase = lds + wq * 1024;
    const int lbase = (int)(uintptr_t)lds;
#define G2_ISSUE(kt, st) do { LAS char* sb_ = wbase + (st) * G2_STAGE; \
        _Pragma("unroll") for (int h = 0; h < 2; ++h) { \
        _Pragma("unroll") for (int i = 0; i < 4; ++i) __builtin_amdgcn_global_load_lds((const unsigned*)(asrc + (i * a_i + h * a_h + (size_t)(kt) * 128) + aoff), (LAS unsigned*)(sb_ + h * 4096 + i * 8192), 16, 0, 0); \
        _Pragma("unroll") for (int i = 0; i < 4; ++i) __builtin_amdgcn_global_load_lds((const unsigned*)(bsrc + ((i & 1) * b_i + (i >> 1) * 256 + h * b_h + (size_t)(kt) * b_k) + boff), (LAS unsigned*)(sb_ + 32768 + h * 4096 + (i >> 1) * 16384 + (i & 1) * 8192), 16, 0, 0); } } while (0)
#define G2_RB(BF, KS) do { \
        BF[0] = cat8s(asm_tr<(KS) * 8192>(sbase + G.tb[0][0]), asm_tr<(KS) * 8192>(sbase + G.tb[0][1])); \
        BF[1] = cat8s(asm_tr<(KS) * 8192>(sbase + G.tb[1][0]), asm_tr<(KS) * 8192>(sbase + G.tb[1][1])); \
        BF[2] = cat8s(asm_tr<(KS) * 8192>(sbase + G.tb[2][0]), asm_tr<(KS) * 8192>(sbase + G.tb[2][1])); \
        BF[3] = cat8s(asm_tr<(KS) * 8192>(sbase + G.tb[3][0]), asm_tr<(KS) * 8192>(sbase + G.tb[3][1])); } while (0)
#define G2_RA(AF, KS, H) do { AF[0] = asm_rd128<(H) * 8192>(sbase + G.ta[KS]); AF[1] = asm_rd128<(H) * 8192 + 2048>(sbase + G.ta[KS]); \
        AF[2] = asm_rd128<(H) * 8192 + 4096>(sbase + G.ta[KS]); AF[3] = asm_rd128<(H) * 8192 + 6144>(sbase + G.ta[KS]); } while (0)
#define G2_MMA(BF, AF, H) do { _Pragma("unroll") for (int mi = 0; mi < 4; ++mi) _Pragma("unroll") for (int ni = 0; ni < 4; ++ni) \
        acc[(H) * 4 + mi][ni] = mfma16(BF[ni], AF[mi], acc[(H) * 4 + mi][ni]); } while (0)
    asm volatile("s_waitcnt vmcnt(0)" ::: "memory");
    __builtin_amdgcn_s_barrier();
    asm volatile("" ::: "memory");
    if (loader) G2_ISSUE(0, 0);
    for (int kt = 0; kt < nk; ++kt) {
        if (loader) asm volatile("s_waitcnt vmcnt(0)" ::: "memory");
        __builtin_amdgcn_s_barrier();
        asm volatile("" ::: "memory");
        if (loader) { if (kt + 1 < nk) G2_ISSUE(kt + 1, (kt + 1) & 1); }
        const int sbase = lbase + (kt & 1) * G2_STAGE;
        h16x8 bf0[4], bf1[4], afx[4], afy[4];
        G2_RB(bf0, 0); G2_RA(afx, 0, 0);
        LGKM0();
        G2_RA(afy, 0, 1); G2_RB(bf1, 1);
        G2_MMA(bf0, afx, 0);
        LGKM0();
        G2_RA(afx, 1, 0);
        G2_MMA(bf0, afy, 1);
        LGKM0();
        G2_RA(afy, 1, 1);
        G2_MMA(bf1, afx, 0);
        LGKM0();
        G2_MMA(bf1, afy, 1);
    }
#undef G2_ISSUE
#undef G2_RB
#undef G2_RA
#undef G2_MMA
}

template <int OFF> __device__ __forceinline__ unsigned asm_rd32(int addr) { unsigned r; asm volatile("ds_read_b32 %0, %1 offset:%2" : "=v"(r) : "v"(addr), "i"(OFF) : "memory"); return r; }
template <int OFF> __device__ __forceinline__ u32x2 asm_rd64(int addr) { u32x2 r; asm volatile("ds_read_b64 %0, %1 offset:%2" : "=v"(r) : "v"(addr), "i"(OFF) : "memory"); return r; }
__device__ __forceinline__ void gemm_tile_g8(LAS char* lds, const GemmThread& G, const unsigned char* Ab, int lda, const h16* Bb, int ldb, int nk, f32x4 (&acc)[4][4],
                                             G3Stream& S, const unsigned char* nAb, const h16* nBb) {
#pragma unroll
    for (int i = 0; i < 4; ++i)
#pragma unroll
        for (int j = 0; j < 4; ++j) acc[i][j] = (f32x4){0.f, 0.f, 0.f, 0.f};
    const bool loader = G.wid < 4; const int wq = G.wid & 3;
    const size_t a_i = (size_t)128 * 64, b_i = (size_t)32 * ldb, b_h = (size_t)16 * ldb, b_k = (size_t)64 * ldb;
    const size_t lane_a = (size_t)(16 * wq + (G.lane >> 2)) * 64 + (((G.lane & 3) ^ ((G.lane >> 4) & 3)) << 4);
    const size_t lane_b = (size_t)(4 * wq + (G.lane >> 4)) * ldb + (((G.lane & 15) ^ (((G.lane >> 4) << 2) | wq)) << 3);
    const bool has_next = (nAb != nullptr);
    const unsigned char* asrc = Ab + lane_a; const h16* bsrc = Bb + lane_b;
    const unsigned char* nasrc = (has_next ? nAb : Ab) + lane_a; const h16* nbsrc = (has_next ? nBb : Bb) + lane_b;
    LAS char* wbase = lds + wq * 1024;
    const int lbase = (int)(uintptr_t)lds;
    int ta8[2];
    { const int x2 = 2 * ((G.r16 >> 2) & 3);
#pragma unroll
      for (int ks = 0; ks < 2; ++ks) ta8[ks] = (G.wm * 64 + G.r16) * 64 + (((4 * ks + G.g) ^ x2) << 3); }
#define G8_ISSUE_(AS, BS, kt, st) do { LAS char* sb_ = wbase + (st) * GEMM_STAGE; \
        _Pragma("unroll") for (int h = 0; h < 2; ++h) { \
        _Pragma("unroll") for (int i = 0; i < 2; ++i) __builtin_amdgcn_global_load_lds((const unsigned*)((AS) + i * a_i + h * 4096 + (size_t)(kt) * 16384), (LAS unsigned*)(sb_ + h * 4096 + i * 8192), 16, 0, 0); \
        _Pragma("unroll") for (int i = 0; i < 2; ++i) __builtin_amdgcn_global_load_lds((const unsigned*)((BS) + i * b_i + h * b_h + (size_t)(kt) * b_k), (LAS unsigned*)(sb_ + 32768 + h * 4096 + i * 8192), 16, 0, 0); } } while (0)
#define G8_ISSUE(kt, st) G8_ISSUE_(asrc, bsrc, kt, st)
#define G8_READ(BF, AR, KS) do { \
        BF[0] = cat8s(asm_tr<32768 + (KS) * 8192>(sbase + G.tb[0][0]), asm_tr<32768 + (KS) * 8192>(sbase + G.tb[0][1])); \
        BF[1] = cat8s(asm_tr<32768 + (KS) * 8192>(sbase + G.tb[1][0]), asm_tr<32768 + (KS) * 8192>(sbase + G.tb[1][1])); \
        BF[2] = cat8s(asm_tr<32768 + (KS) * 8192>(sbase + G.tb[2][0]), asm_tr<32768 + (KS) * 8192>(sbase + G.tb[2][1])); \
        BF[3] = cat8s(asm_tr<32768 + (KS) * 8192>(sbase + G.tb[3][0]), asm_tr<32768 + (KS) * 8192>(sbase + G.tb[3][1])); \
        AR[0] = asm_rd64<0>(sbase + ta8[KS]); AR[1] = asm_rd64<1024>(sbase + ta8[KS]); AR[2] = asm_rd64<2048>(sbase + ta8[KS]); AR[3] = asm_rd64<3072>(sbase + ta8[KS]); } while (0)
#define G8_MMA(BF, AR) do { h16x8 af_[4]; _Pragma("unroll") for (int mi = 0; mi < 4; ++mi) af_[mi] = fp8x8_to_h16(AR[mi][0], AR[mi][1]); \
        _Pragma("unroll") for (int mi = 0; mi < 4; ++mi) _Pragma("unroll") for (int ni = 0; ni < 4; ++ni) acc[mi][ni] = mfma16(BF[ni], af_[mi], acc[mi][ni]); } while (0)
    int sc = S.gs, si = (S.gs == 0) ? 2 : S.gs - 1;
    if (!S.primed) {
        asm volatile("s_waitcnt vmcnt(0)" ::: "memory");
        __builtin_amdgcn_s_barrier();
        asm volatile("" ::: "memory");
        if (loader) { G8_ISSUE(0, sc); G8_ISSUE(1, (sc == 2) ? 0 : sc + 1); }
    }
    for (int kt = 0; kt < nk; ++kt) {
        if (loader) { if ((kt == 0 && S.primed) || !(kt + 1 < nk || has_next)) asm volatile("s_waitcnt vmcnt(0)" ::: "memory"); else asm volatile("s_waitcnt vmcnt(8)" ::: "memory"); }
        __builtin_amdgcn_s_barrier();
        asm volatile("" ::: "memory");
        if (loader) {
            if (kt + 2 < nk) G8_ISSUE(kt + 2, si);
            else if (has_next) G8_ISSUE_(nasrc, nbsrc, kt + 2 - nk, si);
        }
        const int sbase = lbase + sc * GEMM_STAGE;
        h16x8 bf0[4], bf1[4]; u32x2 ar0[4], ar1[4];
        G8_READ(bf0, ar0, 0);
        LGKM0();
        G8_READ(bf1, ar1, 1);
        G8_MMA(bf0, ar0);
        LGKM0();
        G8_MMA(bf1, ar1);
        sc = (sc == 2) ? 0 : sc + 1; si = (si == 2) ? 0 : si + 1;
    }
#undef G8_ISSUE
#undef G8_ISSUE_
#undef G8_READ
#undef G8_MMA
    S.gs = sc; S.primed = has_next;
}

__device__ __forceinline__ void cvt_weight(const float* W, const float* rowscale, h16* O, int K, int N, int NP, int gtid, int gthreads) {
    const int cpr = NP >> 3;
    for (int idx = gtid; idx < K * cpr; idx += gthreads) {
        const int k = idx / cpr, c = (idx - k * cpr) << 3;
        h16x8 o;
        if (c < N) {
            f32x4 v0 = *(const f32x4*)(W + (size_t)k * N + c), v1 = *(const f32x4*)(W + (size_t)k * N + c + 4);
            if (rowscale) { const float r = rowscale[k]; v0 = v0 * r; v1 = v1 * r; }
#pragma unroll
            for (int e = 0; e < 4; ++e) { o[e] = (h16)v0[e]; o[4 + e] = (h16)v1[e]; }
        } else {
#pragma unroll
            for (int e = 0; e < 8; ++e) o[e] = (h16)0.f;
        }
        *(h16x8*)(O + (size_t)k * NP + c) = o;
    }
}
__device__ __forceinline__ void phase_cvt(const Args& a) {
    const int gtid = blockIdx.x * NTHREADS + threadIdx.x, gth = gridDim.x * NTHREADS;
    cvt_weight(a.in[I_WIN], nullptr, (h16*)(a.ws + WS_WIN16), DM, INW, WINP, gtid, gth);
    cvt_weight(a.in[I_WO], nullptr, (h16*)(a.ws + WS_WO16), DM, DM, DM, gtid, gth);
    cvt_weight(a.in[I_WUQ], a.in[I_QNORM], (h16*)(a.ws + WS_WUQ16), 512, 1536, 1536, gtid, gth);
    cvt_weight(a.in[I_WUKV], a.in[I_KVNORM], (h16*)(a.ws + WS_WUKV16), 256, 2048, 2048, gtid, gth);
    h16* WRH = (h16*)(a.ws + WS_WRH); h16* WRL = (h16*)(a.ws + WS_WRL);
    for (int idx = gtid; idx < 48 * DM; idx += gth) {
        const int n = idx / DM, k = idx - n * DM;
        float w = 0.f;
        if (n < 4) w = a.in[I_RGW][k * 4 + n];
        else if (n < 36) w = a.in[I_REW][(size_t)((n - 4) >> 3) * DM * 8 + (size_t)k * 8 + ((n - 4) & 7)];
        w *= 1024.f;
        const h16 hi = (h16)w; const h16 lo = (h16)(w - (float)hi);
        WRH[idx] = hi; WRL[idx] = lo;
    }
}

__device__ __forceinline__ void phase_adaln(const Args& a, LAS char* lds) {
    const int tid = threadIdx.x;
    LAS float* sact = (LAS float*)lds;
    LAS f32x4* red = (LAS f32x4*)(lds + 40960);
    const float* c = a.in[I_C]; const float* cc = a.in[I_CCTX]; const float* W = a.in[I_WADA];
    float* PART = (float*)(a.ws + WS_PART);
    for (int i = tid; i < 5 * DM; i += NTHREADS) { const float v = (i < 4 * DM) ? c[i] : cc[i - 4 * DM]; sact[i] = silu_f(v); }
    __syncthreads();
    const int col4 = tid & 31, ksub = tid >> 5;
    for (int u = blockIdx.x; u < 768; u += gridDim.x) {
        const int nc = u % 96, kc = u / 96;
        const int k0 = kc * 256 + ksub * 16;
        const float* wp = W + (size_t)k0 * ADAW + nc * 128 + col4 * 4;
        f32x4 acc[5];
#pragma unroll
        for (int r = 0; r < 5; ++r) acc[r] = (f32x4){0.f, 0.f, 0.f, 0.f};
#pragma unroll 8
        for (int kk = 0; kk < 16; ++kk) {
            const f32x4 w = *(const f32x4*)(wp + (size_t)kk * ADAW);
#pragma unroll
            for (int r = 0; r < 5; ++r) acc[r] += w * sact[r * DM + k0 + kk];
        }
#pragma unroll
        for (int r = 0; r < 5; ++r) red[(ksub * 5 + r) * 32 + col4] = acc[r];
        __syncthreads();
        if (tid < 160) {
            const int r = tid >> 5, c4 = tid & 31;
            f32x4 s = (f32x4){0.f, 0.f, 0.f, 0.f};
#pragma unroll
            for (int j = 0; j < 16; ++j) s += red[(j * 5 + r) * 32 + c4];
            *(f32x4*)(PART + ((size_t)kc * 5 + r) * ADAW + nc * 128 + c4 * 4) = s;
        }
        __syncthreads();
    }
}

__device__ __forceinline__ float mod_sum(const float* PART, const float* bada, int r, int n) {
    float s = bada[n];
#pragma unroll
    for (int kc = 0; kc < 8; ++kc) s += PART[((size_t)kc * 5 + r) * ADAW + n];
    return s;
}
__device__ __forceinline__ void phase_modulate(const Args& a, LAS char* lds) {
    const int tid = threadIdx.x, lane = tid & 63, wid = tid >> 6;
    const float* PART = (const float*)(a.ws + WS_PART); const float* bada = a.in[I_BADA];
    float* MOD = (float*)(a.ws + WS_MOD);
    for (int idx = blockIdx.x * NTHREADS + tid; idx < 5 * ADAW; idx += gridDim.x * NTHREADS) MOD[idx] = mod_sum(PART, bada, idx / ADAW, idx % ADAW);
    const int per = (TA + gridDim.x - 1) / gridDim.x;
    const int r0 = blockIdx.x * per, r1 = (r0 + per < TA) ? r0 + per : TA;
    if (r0 >= r1) return;
    const int mrA = (r0 < T) ? r0 / SEQ : 4, mrB = (r1 - 1 < T) ? (r1 - 1) / SEQ : 4;
    LAS float* smod = (LAS float*)lds;
    for (int i = tid; i < 2 * 2 * DM; i += NTHREADS) {
        const int slot = i / (2 * DM), n = i % (2 * DM);
        smod[i] = mod_sum(PART, bada, slot ? mrB : mrA, n);
    }
    __syncthreads();
    h16* A1 = (h16*)(a.ws + WS_A1);
    for (int row = r0 + wid; row < r1; row += 8) {
        const float* xr = (row < T) ? a.in[I_X] + (size_t)row * DM : a.in[I_CTX] + (size_t)(row - T) * DM;
        const int mr = (row < T) ? row / SEQ : 4;
        LAS float* sm = smod + ((mr == mrA) ? 0 : 2 * DM);
        f32x4 v[8]; float s = 0.f;
#pragma unroll
        for (int j = 0; j < 8; ++j) { v[j] = *(const f32x4*)(xr + j * 256 + lane * 4); s += (v[j][0] + v[j][1]) + (v[j][2] + v[j][3]); }
        const float mean = wave_sum(s) * (1.f / DM); float q = 0.f;
#pragma unroll
        for (int j = 0; j < 8; ++j) { v[j] = v[j] - mean; q += (v[j][0] * v[j][0] + v[j][1] * v[j][1]) + (v[j][2] * v[j][2] + v[j][3] * v[j][3]); }
        const float rstd = 1.f / sqrtf(wave_sum(q) * (1.f / DM) + EPS);
#pragma unroll
        for (int j = 0; j < 8; ++j) {
            const int k = j * 256 + lane * 4;
            const f32x4 sh = *(LAS f32x4*)(sm + k), sc = *(LAS f32x4*)(sm + DM + k);
            const f32x4 y = v[j] * rstd * (sc + 1.f) + sh;
            *(h16x4*)(A1 + (size_t)row * DM + k) = cvt4(y);
        }
    }
}

__device__ __forceinline__ void acc_rows16(const f32x4 (&c)[4], float w, u32x4 (&v)[2]) {
    u32x2 x[4];
#pragma unroll
    for (int ni = 0; ni < 4; ++ni) x[ni] = __builtin_bit_cast(u32x2, cvt4(c[ni] * w));
#pragma unroll
    for (int n1 = 0; n1 < 2; ++n1) {
#pragma unroll
        for (int d = 0; d < 2; ++d) {
            auto p = __builtin_amdgcn_permlane32_swap(x[2 * n1][d], x[2 * n1 + 1][d], false, false);
            auto q = __builtin_amdgcn_permlane16_swap(p[0], p[1], false, false);
            x[2 * n1][d] = q[0]; x[2 * n1 + 1][d] = q[1];
        }
        v[n1] = (u32x4){x[2 * n1][0], x[2 * n1][1], x[2 * n1 + 1][0], x[2 * n1 + 1][1]};
    }
}
__device__ __forceinline__ void st_rows16(h16* rowp, const f32x4 (&c)[4], float w, int g) {
    u32x4 v[2];
    acc_rows16(c, w, v);
    *(u32x4*)(rowp + 8 * g) = v[0]; *(u32x4*)(rowp + 8 * g + 32) = v[1];
}
__device__ __forceinline__ void st4(h16* p, f32x4 v) { *(h16x4*)p = cvt4(v); }
__device__ __forceinline__ void rope4(f32x4 x1, f32x4 x2, float pos, int i0, float step, float sc, f32x4& o1, f32x4& o2) {
#pragma unroll
    for (int r = 0; r < 4; ++r) {
        const float invf = exp2f(-(float)(i0 + r) * step);
        const float ang = pos * invf;
        const float s = __sinf(ang), c = __cosf(ang);
        o1[r] = (x1[r] * c - x2[r] * s) * sc; o2[r] = (x1[r] * s + x2[r] * c) * sc;
    }
}
template <int NM>
__device__ __forceinline__ void inproj_epi(const Args& a, const f32x4 (&acc)[NM][4], bool lat, int b, int m0, int l0, int nt, int wn, int g) {
    h16* QR = (h16*)(a.ws + WS_QR); h16* KR = (h16*)(a.ws + WS_KR); h16* VR = (h16*)(a.ws + WS_VR);
    h16* KC = (h16*)(a.ws + WS_KC); h16* VC = (h16*)(a.ws + WS_VC); h16* GS = (h16*)(a.ws + WS_GS);
    h16* CQ = (h16*)(a.ws + WS_CQ); h16* CKV = (h16*)(a.ws + WS_CKV); h16* KPE = (h16*)(a.ws + WS_KPE);
    const int cw = wn * 64;
    if (nt < 16) {
        const int h = nt & 7; const bool isq = nt < 8;
        h16* dst = isq ? QR : (lat ? KR : KC);
        const float sc = isq ? 1.f : KSCALE;
#pragma unroll
        for (int mi = 0; mi < NM; ++mi) {
            const int l = l0 + mi * 16;
            const size_t ro = lat ? ((size_t)(b * 8 + h) * SEQ + l) * 128 : ((size_t)(b * 8 + h) * LC + l) * 128;
            const float pos = (wn == 0) ? (float)(l >> 6) : (float)(l & 63);
            f32x4 c[4];
#pragma unroll
            for (int ni = 0; ni < 2; ++ni) {
                if (lat) rope4(acc[mi][ni], acc[mi][ni + 2], pos, ni * 16 + 4 * g, L2_10000 / 32.f, sc, c[ni], c[ni + 2]);
                else { c[ni] = acc[mi][ni] * sc; c[ni + 2] = acc[mi][ni + 2] * sc; }
            }
            st_rows16(dst + ro + cw, c, 1.f, g);
        }
    } else if (nt < 24) {
        const int h = nt - 16; h16* dst = lat ? VR : VC;
#pragma unroll
        for (int mi = 0; mi < NM; ++mi) {
            const int l = l0 + mi * 16;
            const size_t ro = lat ? ((size_t)(b * 8 + h) * SEQ + l) * 128 : ((size_t)(b * 8 + h) * LC + l) * 128;
            st_rows16(dst + ro + cw, acc[mi], 1.f, g);
        }
    } else if (nt < 32) {
#pragma unroll
        for (int mi = 0; mi < NM; ++mi) {
            f32x4 c[4];
#pragma unroll
            for (int ni = 0; ni < 4; ++ni)
#pragma unroll
                for (int r = 0; r < 4; ++r) c[ni][r] = silu_f(acc[mi][ni][r]);
            st_rows16(GS + (size_t)(m0 + mi * 16) * 1024 + (nt - 24) * 128 + cw, c, 1.f, g);
        }
    } else if (nt < 36) {
#pragma unroll
        for (int mi = 0; mi < NM; ++mi) st_rows16(CQ + (size_t)(m0 + mi * 16) * 512 + (nt - 32) * 128 + cw, acc[mi], 1.f, g);
    } else if (nt < 38) {
#pragma unroll
        for (int mi = 0; mi < NM; ++mi) {
            const int key = (lat ? LC : 0) + l0 + mi * 16;
            st_rows16(CKV + ((size_t)b * LK + key) * 256 + (nt - 36) * 128 + cw, acc[mi], 1.f, g);
        }
    } else if (nt == 38 && wn == 0) {
#pragma unroll
        for (int mi = 0; mi < NM; ++mi) {
            const int l = l0 + mi * 16, key = (lat ? LC : 0) + l;
            f32x4 c[4];
#pragma unroll
            for (int hf = 0; hf < 2; ++hf) {
                const float pos = hf ? (float)(l & 63) : (float)(l >> 6);
                if (lat) rope4(acc[mi][2 * hf], acc[mi][2 * hf + 1], pos, 4 * g, L2_10000 / 16.f, 1.f, c[2 * hf], c[2 * hf + 1]);
                else { c[2 * hf] = acc[mi][2 * hf]; c[2 * hf + 1] = acc[mi][2 * hf + 1]; }
            }
            st_rows16(KPE + ((size_t)b * LK + key) * 64, c, 1.f, g);
        }
    }
}
__device__ __forceinline__ void inproj_unit(int list, int p, int& mt, int& nt) {
    if (list == 0) {
        if (p < 352) { const int mg = p / 44, rem = p - mg * 44, ti = rem >> 2; mt = mg * 4 + (rem & 3); nt = (ti < 8) ? 4 + ti : 8 + ti; }
        else if (p < 388) { const int q = p - 352, ti = q >> 2; mt = 32 + (q & 3); nt = (ti < 8) ? 4 + ti : 18; }
        else { const int q = p - 388; mt = q >> 2; nt = q & 3; }
    } else {
        if (p < 4) { mt = 31; nt = p; }
        else if (p < 132) { const int q = p - 4; mt = q >> 2; nt = 12 + (q & 3); }
        else if (p < 164) { mt = p - 132; nt = 19; }
        else { mt = 32 + (p - 164); nt = 19; }
    }
}
constexpr int INPROJ_NU0 = 512, INPROJ_NU1 = 168;
__device__ __forceinline__ void phase_inproj(const Args& a, LAS char* lds, int vcu, int list) {
    GemmThread2 G; G.init();
    const h16* A1 = (const h16*)(a.ws + WS_A1); const h16* W16 = (const h16*)(a.ws + WS_WIN16);
    const int NU = list ? INPROJ_NU1 : INPROJ_NU0;
    for (int p = vcu; p < NU; p += gridDim.x) {
        int mt, nt;
        inproj_unit(list, p, mt, nt);
        f32x4 acc[8][4];
        gemm_tile_g2(lds, G, A1 + (size_t)mt * 256 * DM, DM, W16 + nt * 256, WINP, DM / 64, acc);
        const bool lat = mt < 32;
        const int b = lat ? (mt >> 3) : (mt - 32);
        int r16l = G.r16, gl = G.g;
        asm volatile("" : "+v"(r16l), "+v"(gl));
        const int m0 = mt * 256 + G.wm * 128 + r16l;
        const int l0 = lat ? (m0 & (SEQ - 1)) : (m0 - T - b * LC);
        const int cb = nt * 4 + G.wn;
        inproj_epi<8>(a, acc, lat, b, m0, l0, cb >> 1, cb & 1, gl);
    }
    if (list == 0) {
        const int rounds = (NU + (int)gridDim.x - 1) / (int)gridDim.x, mine = (vcu < NU) ? (NU - vcu + (int)gridDim.x - 1) / (int)gridDim.x : 0;
        if (mine < rounds) wdown_pool(a, lds, 8 * (rounds - mine));
    }
}

__device__ __forceinline__ void qup_unit(const Args& a, LAS char* lds, G3Stream& S, int p, int pn) {
    GemmThread G; G.init(true);
    const h16* CQ = (const h16*)(a.ws + WS_CQ); h16* Q = (h16*)(a.ws + WS_Q);
    LAS float* rs = (LAS float*)(lds + GEMM_ROWS_OFF);
    const int mt = p / 12, nt = p % 12;
    const bool hn = pn >= 0;
    f32x4 acc[4][4];
    gemm_tile_g<true>(lds, G, CQ + (size_t)mt * 256 * 512, 512, (const h16*)(a.ws + WS_WUQ16) + nt * 128, 1536, 512 / 64, acc, S,
                      hn ? CQ + (size_t)(pn / 12) * 256 * 512 : nullptr, hn ? (const h16*)(a.ws + WS_WUQ16) + (pn % 12) * 128 : nullptr);
    const int c0 = nt * 128 + G.wn * 64, head = c0 / 192, d0 = c0 % 192;
#pragma unroll
    for (int mi = 0; mi < 4; ++mi) {
        const int ml = G.wm * 64 + mi * 16 + G.r16, m = mt * 256 + ml;
        const float r = rs[ml];
        const int b = m >> 11, l = m & (SEQ - 1);
        h16* dst = Q + ((size_t)(b * 8 + head) * SEQ + l) * 192 + d0;
        if (d0 < 128) st_rows16(dst, acc[mi], r, G.g);
        else {
            f32x4 c[4];
#pragma unroll
            for (int hf = 0; hf < 2; ++hf) {
                const float pos = hf ? (float)(l & 63) : (float)(l >> 6);
                rope4(acc[mi][2 * hf], acc[mi][2 * hf + 1], pos, 4 * G.g, L2_10000 / 16.f, r, c[2 * hf], c[2 * hf + 1]);
            }
            st_rows16(dst, c, 1.f, G.g);
        }
    }
}
__device__ __forceinline__ void kvup_unit(const Args& a, LAS char* lds, G3Stream& S, int p, int pn) {
    GemmThread G; G.init(true);
    const h16* CKV = (const h16*)(a.ws + WS_CKV); h16* KN = (h16*)(a.ws + WS_KN); h16* VV = (h16*)(a.ws + WS_VV);
    LAS float* rs = (LAS float*)(lds + GEMM_ROWS_OFF);
    const int mt = p >> 4, nt = p & 15;
    const bool hn = pn >= 0;
    f32x4 acc[4][4];
    gemm_tile_g<true>(lds, G, CKV + (size_t)mt * 256 * 256, 256, (const h16*)(a.ws + WS_WUKV16) + nt * 128, 2048, 256 / 64, acc, S,
                      hn ? CKV + (size_t)(pn >> 4) * 256 * 256 : nullptr, hn ? (const h16*)(a.ws + WS_WUKV16) + (pn & 15) * 128 : nullptr);
    const int head = nt >> 1; h16* base = (nt & 1) ? VV : KN;
#pragma unroll
    for (int mi = 0; mi < 4; ++mi) {
        const int ml = G.wm * 64 + mi * 16 + G.r16, m = mt * 256 + ml;
        const float r = rs[ml];
        const int b = m / LK, key = m % LK;
        st_rows16(base + ((size_t)(b * 8 + head) * LK + key) * 128 + G.wn * 64, acc[mi], r, G.g);
    }
}

__device__ __forceinline__ float log2_gamma(const float* rdec, int dir, int h) {
    const float x = rdec[dir * 8 + h];
    return -log1pf(__expf(-x)) * 1.4426950408889634f;
}

__device__ __forceinline__ void ret_state_item(const Args& a, LAS char* lds, int it) {
    int tid = threadIdx.x; asm volatile("" : "+v"(tid));
    const int lane = tid & 63, wid = __builtin_amdgcn_readfirstlane(tid >> 6), r16 = lane & 15, g = lane >> 4;
    const h16* KR = (const h16*)(a.ws + WS_KR); const h16* VR = (const h16*)(a.ws + WS_VR);
    const h16* KC = (const h16*)(a.ws + WS_KC); const h16* VC = (const h16*)(a.ws + WS_VC);
    h16* UF = (h16*)(a.ws + WS_UF); h16* UB = (h16*)(a.ws + WS_UB); h16* S0F = (h16*)(a.ws + WS_S0F); h16* S0B = (h16*)(a.ws + WS_S0B);
    LAS char* Kf = lds; LAS char* Kb = lds + 32768; LAS char* Vi = lds + 65536;
    __syncthreads();
    {
        const int bh = it / 17, c = it % 17, h = bh & 7;
        const float lgf = log2_gamma(a.in[I_RDEC], 0, h), lgb = log2_gamma(a.in[I_RDEC], 1, h);
        const bool isctx = (c == 16);
        const int J = isctx ? 256 : 128;
        const h16* Kp = isctx ? KC + (size_t)bh * LC * 128 : KR + ((size_t)bh * SEQ + c * 128) * 128;
        const h16* Vp = isctx ? VC + (size_t)bh * LC * 128 : VR + ((size_t)bh * SEQ + c * 128) * 128;
        f32x4 accf[8], accb[8];
#pragma unroll
        for (int i = 0; i < 8; ++i) { accf[i] = (f32x4){0.f, 0.f, 0.f, 0.f}; accb[i] = (f32x4){0.f, 0.f, 0.f, 0.f}; }
        for (int sub = 0; sub < J / 128; ++sub) {
            if (sub) __syncthreads();
#pragma unroll
            for (int i = 0; i < 4; ++i) {
                const int row = (tid >> 4) + 32 * i, ch = tid & 15, j = sub * 128 + row;
                const h16x8 kv = *(const h16x8*)(Kp + (size_t)j * 128 + ch * 8);
                const h16x8 vv = *(const h16x8*)(Vp + (size_t)j * 128 + ch * 8);
                const float zf = exp2f(lgf * (float)(J - 1 - j)), zb = exp2f(lgb * (float)j);
                h16x8 kf, kb;
#pragma unroll
                for (int e = 0; e < 8; ++e) { const float f = (float)kv[e]; kf[e] = (h16)(f * zf); kb[e] = (h16)(f * zb); }
                const int o = off_b(row, ch);
                *(LAS h16x8*)(Kf + o) = kf; *(LAS h16x8*)(Kb + o) = kb; *(LAS h16x8*)(Vi + o) = vv;
            }
            __syncthreads();
#pragma unroll
            for (int ks = 0; ks < 4; ++ks) {
                const int o0 = tr_addr16(lane, wid, ks, 0), o1 = tr_addr16(lane, wid, ks, 1);
                const h16x8 af = cat8(trrd(Kf + o0), trrd(Kf + o1)), ab = cat8(trrd(Kb + o0), trrd(Kb + o1));
#pragma unroll
                for (int cb = 0; cb < 8; ++cb) {
                    const h16x8 bv = cat8(trrd(Vi + tr_addr16(lane, cb, ks, 0)), trrd(Vi + tr_addr16(lane, cb, ks, 1)));
                    accf[cb] = mfma16(af, bv, accf[cb]); accb[cb] = mfma16(ab, bv, accb[cb]);
                }
            }
        }
        h16* of = isctx ? S0F + (size_t)bh * 16384 : UF + ((size_t)bh * 16 + c) * 16384;
        h16* ob = isctx ? S0B + (size_t)bh * 16384 : UB + ((size_t)bh * 16 + c) * 16384;
#pragma unroll
        for (int cb = 0; cb < 8; ++cb)
#pragma unroll
            for (int r = 0; r < 4; ++r) {
                const int d = wid * 16 + 4 * g + r, e = cb * 16 + r16;
                of[d * 128 + e] = (h16)accf[cb][r]; ob[d * 128 + e] = (h16)accb[cb][r];
            }
        __syncthreads();
    }
}

constexpr int N_ITEMS = 384 + 544 + 576;
__device__ __forceinline__ void phase_mid(const Args& a, LAS char* lds, int vcu) {
    phase_inproj(a, lds, vcu, 1);
    const int Gn = (int)gridDim.x;
    const bool bal = (Gn == 256);
    const int cyc = bal ? 432 : Gn, nseq = (bal && vcu >= INPROJ_NU1) ? 3 : 1;
    G3Stream S; S.gs = 0; S.primed = false;
    int j = 0, t = 0;
    for (;;) {
        const int i = vcu + 88 * t + cyc * j;
        if (i >= N_ITEMS) break;
        int t2 = t + 1, j2 = j; if (t2 == nseq) { t2 = 0; ++j2; }
        const int inext = vcu + 88 * t2 + cyc * j2;
        if (i < 384) qup_unit(a, lds, S, i, (inext < 384) ? inext : -1);
        else if (i < 928) ret_state_item(a, lds, i - 384);
        else kvup_unit(a, lds, S, i - 928, (inext < N_ITEMS) ? inext - 928 : -1);
        t = t2; j = j2;
    }
}

__device__ __forceinline__ void phase_ret_scan(const Args& a) {
    const h16* UF = (const h16*)(a.ws + WS_UF); const h16* UB = (const h16*)(a.ws + WS_UB);
    const h16* S0F = (const h16*)(a.ws + WS_S0F); const h16* S0B = (const h16*)(a.ws + WS_S0B);
    h16* SF = (h16*)(a.ws + WS_SF); h16* SB = (h16*)(a.ws + WS_SB);
    for (int idx = blockIdx.x * NTHREADS + threadIdx.x; idx < 32 * 16384; idx += gridDim.x * NTHREADS) {
        const int bh = idx >> 14, el = idx & 16383, h = bh & 7;
        const float gf = exp2f(128.f * log2_gamma(a.in[I_RDEC], 0, h)), gb = exp2f(128.f * log2_gamma(a.in[I_RDEC], 1, h));
        float sf = (float)S0F[idx], sb = (float)S0B[idx];
        for (int c = 0; c < 16; ++c) {
            SF[((size_t)bh * 16 + c) * 16384 + el] = (h16)sf;
            sf = gf * sf + (float)UF[((size_t)bh * 16 + c) * 16384 + el];
        }
        for (int c = 15; c >= 0; --c) {
            SB[((size_t)bh * 16 + c) * 16384 + el] = (h16)sb;
            sb = gb * sb + (float)UB[((size_t)bh * 16 + c) * 16384 + el];
        }
    }
}

__device__ __forceinline__ void ret_out_item(const Args& a, LAS char* lds, int bh, int c) {
    const int tid = threadIdx.x, lane = tid & 63, wid = __builtin_amdgcn_readfirstlane(tid >> 6), r16 = lane & 15, g = lane >> 4;
    const int b = bh >> 3, h = bh & 7;
    const float lgf = log2_gamma(a.in[I_RDEC], 0, h), lgb = log2_gamma(a.in[I_RDEC], 1, h);
    const h16* QR = (const h16*)(a.ws + WS_QR); const h16* KR = (const h16*)(a.ws + WS_KR); const h16* VR = (const h16*)(a.ws + WS_VR);
    const h16* SF = (const h16*)(a.ws + WS_SF); const h16* SB = (const h16*)(a.ws + WS_SB);
    const h16* GS = (const h16*)(a.ws + WS_GS); h16* MIX = (h16*)(a.ws + WS_MIX);
    LAS char* Qi = lds; LAS char* Ki = lds + 32768; LAS char* Vi = lds + 65536; LAS char* Pi = lds + 98304;
    const size_t src0 = ((size_t)bh * SEQ + c * 128) * 128, st0 = ((size_t)bh * 16 + c) * 16384;
    int ra[4], tbv[8][2];
#pragma unroll
    for (int s = 0; s < 4; ++s) ra[s] = row_addr16(lane, 0, s);
#pragma unroll
    for (int eb = 0; eb < 8; ++eb) { tbv[eb][0] = tr_addr16(lane, eb, 0, 0); tbv[eb][1] = tr_addr16(lane, eb, 0, 1); }
    const int st_o = off_b(tid >> 4, tid & 15);
    u32x4 sfr[4], sbr[4];
    {
        u32x4 qv[4], kv[4], vv[4];
#pragma unroll
        for (int i = 0; i < 4; ++i) {
            const size_t s = src0 + (size_t)((tid >> 4) + 32 * i) * 128 + (tid & 15) * 8;
            qv[i] = *(const u32x4*)(QR + s); kv[i] = *(const u32x4*)(KR + s); vv[i] = *(const u32x4*)(VR + s);
        }
#pragma unroll
        for (int i = 0; i < 4; ++i) {
            const size_t s = st0 + (size_t)((tid >> 4) + 32 * i) * 128 + (tid & 15) * 8;
            sfr[i] = *(const u32x4*)(SF + s); sbr[i] = *(const u32x4*)(SB + s);
        }
#pragma unroll
        for (int i = 0; i < 4; ++i) { *(LAS u32x4*)(Qi + st_o + i * 8192) = qv[i]; *(LAS u32x4*)(Ki + st_o + i * 8192) = kv[i]; *(LAS u32x4*)(Vi + st_o + i * 8192) = vv[i]; }
    }
    __syncthreads();
    h16x8 qf[4];
#pragma unroll
    for (int s = 0; s < 4; ++s) qf[s] = *(LAS h16x8*)(Qi + ra[s] + wid * 4096);
    const int il = 16 * wid + r16;
#pragma unroll
    for (int jb = 0; jb < 8; ++jb) {
        f32x4 sa = (f32x4){0.f, 0.f, 0.f, 0.f};
#pragma unroll
        for (int s = 0; s < 4; ++s) { const h16x8 kf = *(LAS h16x8*)(Ki + ra[s] + jb * 4096); sa = mfma16(kf, qf[s], sa); }
        f32x4 pv;
#pragma unroll
        for (int r = 0; r < 4; ++r) {
            const int dl = il - (16 * jb + 4 * g + r);
            float f = 0.f;
            if (dl >= 0) f += exp2f(lgf * (float)dl);
            if (dl <= 0) f += exp2f(lgb * (float)(-dl));
            pv[r] = sa[r] * f;
        }
        *(LAS h16x4*)(Pi + off_b(il, 2 * jb + (g >> 1)) + (g & 1) * 8) = cvt4(pv);
    }
    __syncthreads();
#pragma unroll
    for (int i = 0; i < 4; ++i) *(LAS u32x4*)(Ki + st_o + i * 8192) = sfr[i];
    __syncthreads();
    const h16 xfh = (h16)exp2f(lgf * (float)(il + 1)), xbh = (h16)exp2f(lgb * (float)(128 - il));
    f32x4 ao[8];
#pragma unroll
    for (int i = 0; i < 8; ++i) ao[i] = (f32x4){0.f, 0.f, 0.f, 0.f};
#pragma unroll
    for (int s = 0; s < 4; ++s) {
        const h16x8 pf = *(LAS h16x8*)(Pi + ra[s] + wid * 4096);
        const h16x8 qsf = qf[s] * xfh;
#pragma unroll
        for (int eb = 0; eb < 8; ++eb) {
            const h16x8 vf = cat8(trrd(Vi + tbv[eb][0] + s * 8192), trrd(Vi + tbv[eb][1] + s * 8192));
            ao[eb] = mfma16(vf, pf, ao[eb]);
            const h16x8 sf = cat8(trrd(Ki + tbv[eb][0] + s * 8192), trrd(Ki + tbv[eb][1] + s * 8192));
            ao[eb] = mfma16(sf, qsf, ao[eb]);
        }
    }
    __syncthreads();
#pragma unroll
    for (int i = 0; i < 4; ++i) *(LAS u32x4*)(Vi + st_o + i * 8192) = sbr[i];
    __syncthreads();
#pragma unroll
    for (int s = 0; s < 4; ++s) {
        const h16x8 qsb = qf[s] * xbh;
#pragma unroll
        for (int eb = 0; eb < 8; ++eb) {
            const h16x8 sf = cat8(trrd(Vi + tbv[eb][0] + s * 8192), trrd(Vi + tbv[eb][1] + s * 8192));
            ao[eb] = mfma16(sf, qsb, ao[eb]);
        }
    }
    float sum = 0.f;
#pragma unroll
    for (int eb = 0; eb < 8; ++eb) sum += (ao[eb][0] + ao[eb][1]) + (ao[eb][2] + ao[eb][3]);
    sum += __shfl_xor(sum, 16); sum += __shfl_xor(sum, 32);
    const float mean = sum * (1.f / 128.f); float q = 0.f;
#pragma unroll
    for (int eb = 0; eb < 8; ++eb) { ao[eb] = ao[eb] - mean; q += (ao[eb][0] * ao[eb][0] + ao[eb][1] * ao[eb][1]) + (ao[eb][2] * ao[eb][2] + ao[eb][3] * ao[eb][3]); }
    q += __shfl_xor(q, 16); q += __shfl_xor(q, 32);
    const float rstd = 1.f / sqrtf(q * (1.f / 128.f) + EPS);
    const int t = b * SEQ + c * 128 + il;
    const float* gw = a.in[I_RGN] + h * 128;
#pragma unroll
    for (int eb = 0; eb < 8; ++eb) {
        const int e = 16 * eb + 4 * g;
        const f32x4 w = *(const f32x4*)(gw + e);
        const h16x4 gs = *(const h16x4*)(GS + (size_t)t * 1024 + h * 128 + e);
        f32x4 o;
#pragma unroll
        for (int r = 0; r < 4; ++r) o[r] = ao[eb][r] * rstd * w[r] * (float)gs[r];
        st4(MIX + (size_t)t * DM + h * 128 + e, o);
    }
    __syncthreads();
}

namespace att {
constexpr float SCALE = 0.07216878364870322f;
constexpr float THR = 8.f;
constexpr int SHM_V = 16384, SHM_K = 16384, SHM_P = 8192;
constexpr int OFF_V = 0, OFF_K = 32768, OFF_P = 65536, OFF_W = 81920, OFF_QP = 83968;
using s16x4 = __attribute__((ext_vector_type(4))) short;
#define KSWZ(row, colB) ((row) * 256 + ((colB) ^ (((row) & 7) << 4)))
#define PSWZ(row, colB) ((row) * 128 + ((colB) ^ (((row) & 7) << 4)))
#define SBAR() __builtin_amdgcn_sched_barrier(0)
__device__ __forceinline__ int crow(int r, int hi) { return (r & 3) + 8 * (r >> 2) + 4 * hi; }
__device__ __forceinline__ unsigned pk2(float lo, float hi) { h16x2 v; v[0] = (h16)lo; v[1] = (h16)hi; return __builtin_bit_cast(unsigned, v); }
__device__ __forceinline__ f32x16 mfma32(h16x8 a, h16x8 b, f32x16 c) { return __builtin_amdgcn_mfma_f32_32x32x16_f16(a, b, c, 0, 0, 0); }
__device__ __forceinline__ void partialSM(f32x16& p0, f32x16& p1, float& m_reg, float& mn, float& alpha) {
    constexpr float C = SCALE * 1.4426950408889634f;
    float pmax = p0[0];
#pragma unroll
    for (int r = 1; r < 16; ++r) pmax = fmaxf(pmax, p0[r]);
#pragma unroll
    for (int r = 0; r < 16; ++r) pmax = fmaxf(pmax, p1[r]);
    { auto rr = __builtin_amdgcn_permlane32_swap(__float_as_uint(pmax), __float_as_uint(pmax), false, false);
      pmax = fmaxf(__uint_as_float(rr[0]), __uint_as_float(rr[1])); }
    if (__builtin_expect(__all(pmax - m_reg <= THR / SCALE), 1)) { mn = m_reg; alpha = 1.f; }
    else { mn = fmaxf(m_reg, pmax); alpha = __builtin_amdgcn_exp2f((m_reg - mn) * C); m_reg = mn; }
    const float mnC = -mn * C;
#pragma unroll
    for (int r = 0; r < 16; ++r) p0[r] = fmaf(p0[r], C, mnC);
#pragma unroll
    for (int r = 0; r < 16; ++r) p1[r] = fmaf(p1[r], C, mnC);
#pragma unroll
    for (int r = 0; r < 16; ++r) p0[r] = __builtin_amdgcn_exp2f(p0[r]);
}
__device__ __forceinline__ void finishSM(f32x16& p0, f32x16& p1, float alpha, float& l_reg, h16x8& pa0, h16x8& pa1, h16x8& pa2, h16x8& pa3) {
#pragma unroll
    for (int r = 0; r < 16; ++r) p1[r] = __builtin_amdgcn_exp2f(p1[r]);
    float ps = 0;
#pragma unroll
    for (int r = 0; r < 16; ++r) ps += p0[r];
#pragma unroll
    for (int r = 0; r < 16; ++r) ps += p1[r];
    { auto rr = __builtin_amdgcn_permlane32_swap(__float_as_uint(ps), __float_as_uint(ps), false, false);
      ps = __uint_as_float(rr[0]) + __uint_as_float(rr[1]); }
    l_reg = l_reg * alpha + ps;
#define PK4(P, BASE, OUT) do { unsigned a0 = pk2(P[BASE + 0], P[BASE + 1]), a1 = pk2(P[BASE + 2], P[BASE + 3]);   \
    unsigned b0 = pk2(P[BASE + 4], P[BASE + 5]), b1 = pk2(P[BASE + 6], P[BASE + 7]);                              \
    auto r0 = __builtin_amdgcn_permlane32_swap(a0, b0, false, false); auto r1 = __builtin_amdgcn_permlane32_swap(a1, b1, false, false); \
    u32x4 w = {r0[0], r1[0], r0[1], r1[1]}; OUT = __builtin_bit_cast(h16x8, w); } while (0)
    PK4(p0, 0, pa0); PK4(p0, 8, pa1); PK4(p1, 0, pa2); PK4(p1, 8, pa3);
#undef PK4
}
__device__ __forceinline__ void qkt(f32x16& p0, f32x16& p1, LAS char* Ks, LAS char* Ps, const h16x8* qr, LAS char* qpl, int r32, int hi) {
    p0 = f32x16{}; p1 = f32x16{};
#pragma unroll
    for (int d0 = 0; d0 < 8; ++d0) { const int cb = (d0 * 16 + hi * 8) * 2;
        const h16x8 b0 = *(LAS h16x8*)(Ks + KSWZ(r32, cb));
        const h16x8 b1 = *(LAS h16x8*)(Ks + KSWZ(32 + r32, cb));
        p0 = mfma32(b0, qr[d0], p0); p1 = mfma32(b1, qr[d0], p1); }
    SBAR();
#pragma unroll
    for (int d0 = 0; d0 < 4; ++d0) { const int cb = (d0 * 16 + hi * 8) * 2;
        const h16x8 b0 = *(LAS h16x8*)(Ps + PSWZ(r32, cb));
        const h16x8 b1 = *(LAS h16x8*)(Ps + PSWZ(32 + r32, cb));
        const h16x8 qv = *(LAS h16x8*)(qpl + PSWZ(r32, cb));
        p0 = mfma32(b0, qv, p0); p1 = mfma32(b1, qv, p1); }
}
__device__ __forceinline__ int v_st(int k, int c) { const int kk = (k & ~0xC) | ((k & 4) << 1) | ((k & 8) >> 1); return ((kk >> 3) * 4 + (c >> 5)) * 512 + ((kk & 7) * 32 + (c & 31)) * 2; }
__device__ __forceinline__ int v_rd_base(int lane) { return ((lane & 3) << 3) | (((lane >> 2) & 3) << 6) | (((lane >> 4) & 1) << 5) | (((lane >> 5) & 1) << 8); }
constexpr int v_rd_off(int d0, int ks, int half) { return d0 * 512 + ks * 4096 + half * 2048; }
template <int OFF> __device__ __forceinline__ s16x4 tr_read(int vb) {
    s16x4 r; asm volatile("ds_read_b64_tr_b16 %0, %1 offset:%2" : "=&v"(r) : "v"(vb), "i"(OFF) : "memory"); return r;
}
template <int D0> __device__ __forceinline__ void pv_one(f32x16& od, int vb, h16x8 pa0, h16x8 pa1, h16x8 pa2, h16x8 pa3) {
    const s16x4 l0 = tr_read<v_rd_off(D0, 0, 0)>(vb), h0 = tr_read<v_rd_off(D0, 0, 1)>(vb), l1 = tr_read<v_rd_off(D0, 1, 0)>(vb), h1 = tr_read<v_rd_off(D0, 1, 1)>(vb);
    const s16x4 l2 = tr_read<v_rd_off(D0, 2, 0)>(vb), h2 = tr_read<v_rd_off(D0, 2, 1)>(vb), l3 = tr_read<v_rd_off(D0, 3, 0)>(vb), h3 = tr_read<v_rd_off(D0, 3, 1)>(vb);
    asm volatile("s_waitcnt lgkmcnt(0)" ::: "memory"); SBAR();
#define PK(L, H) __builtin_bit_cast(h16x8, __builtin_shufflevector(L, H, 0, 1, 2, 3, 4, 5, 6, 7))
    od = mfma32(pa0, PK(l0, h0), od);
    od = mfma32(pa1, PK(l1, h1), od);
    od = mfma32(pa2, PK(l2, h2), od);
    od = mfma32(pa3, PK(l3, h3), od);
#undef PK
}
__device__ __forceinline__ void pv_d0(f32x16* o, int vb, h16x8 pa0, h16x8 pa1, h16x8 pa2, h16x8 pa3) {
    pv_one<0>(o[0], vb, pa0, pa1, pa2, pa3); pv_one<1>(o[1], vb, pa0, pa1, pa2, pa3); pv_one<2>(o[2], vb, pa0, pa1, pa2, pa3); pv_one<3>(o[3], vb, pa0, pa1, pa2, pa3);
}
__device__ __forceinline__ void attn_body(const h16* __restrict__ Qb, const h16* __restrict__ Kh, const h16* __restrict__ Vh, const h16* __restrict__ Ph,
                                          h16* __restrict__ Ob, int seq, LAS char* lds) {
    int tid = threadIdx.x; asm volatile("" : "+v"(tid));
    const int wid = tid >> 6, lane = tid & 63, r32 = lane & 31, hi = lane >> 5;
    LAS char* V_lds = lds + OFF_V; LAS char* K_lds = lds + OFF_K; LAS char* P_lds = lds + OFF_P;
    LAS float* wsf = (LAS float*)(lds + OFF_W) + wid * 64; LAS float* li_l = wsf; LAS float* al_l = wsf + 32;
    float m_reg = -1e30f, l_reg = 0; f32x16 o[4] = {}; h16x8 qr[8];
    LAS char* qp = lds + OFF_QP + wid * 4096;
    const h16* Qw = Qb + (size_t)(wid * 32 + r32) * 192 + hi * 8;
#pragma unroll
    for (int d0 = 0; d0 < 8; ++d0) qr[d0] = *(const h16x8*)(Qw + d0 * 16);
#pragma unroll
    for (int d0 = 0; d0 < 4; ++d0) *(LAS u32x4*)(qp + PSWZ(r32, (d0 * 16 + hi * 8) * 2)) = *(const u32x4*)(Qw + 128 + d0 * 16);
    const int sr = tid >> 4, sc = (tid & 15) * 8, vst0 = v_st(sr, sc), vst1 = v_st(32 + sr, sc);
    const int pr = tid >> 3, pc = (tid & 7) * 8;
    const int vb0 = (int)(uintptr_t)V_lds + v_rd_base(lane);
    struct { u32x4 vs0, vs1, ks0, ks1, ps; } sr_[1];
    const int vo = sr * 256 + sc * 2, po = pr * 128 + pc * 2;
    const __amdgpu_buffer_rsrc_t rsK = __builtin_amdgcn_make_buffer_rsrc((void*)Kh, (short)0, seq * 256, 0x00020000);
    const __amdgpu_buffer_rsrc_t rsV = __builtin_amdgcn_make_buffer_rsrc((void*)Vh, (short)0, seq * 256, 0x00020000);
    const __amdgpu_buffer_rsrc_t rsP = __builtin_amdgcn_make_buffer_rsrc((void*)Ph, (short)0, seq * 128, 0x00020000);
#define SLOAD(i, k0) do { const int so_ = (k0) * 256; \
    sr_[i].vs0 = __builtin_bit_cast(u32x4, __builtin_amdgcn_raw_buffer_load_b128(rsV, vo, so_, 0)); sr_[i].vs1 = __builtin_bit_cast(u32x4, __builtin_amdgcn_raw_buffer_load_b128(rsV, vo, so_ + 8192, 0)); \
    sr_[i].ks0 = __builtin_bit_cast(u32x4, __builtin_amdgcn_raw_buffer_load_b128(rsK, vo, so_, 0)); sr_[i].ks1 = __builtin_bit_cast(u32x4, __builtin_amdgcn_raw_buffer_load_b128(rsK, vo, so_ + 8192, 0)); \
    sr_[i].ps = __builtin_bit_cast(u32x4, __builtin_amdgcn_raw_buffer_load_b128(rsP, po, (k0) * 128, 0)); } while (0)
#define SWRITE(b, i) do { *(LAS u32x4*)(V_lds + (b) * SHM_V + vst0) = sr_[i].vs0;          \
    *(LAS u32x4*)(V_lds + (b) * SHM_V + vst1) = sr_[i].vs1; const int kc = sc * 2;               \
    *(LAS u32x4*)(K_lds + (b) * SHM_K + KSWZ(sr, kc)) = sr_[i].ks0;                       \
    *(LAS u32x4*)(K_lds + (b) * SHM_K + KSWZ(32 + sr, kc)) = sr_[i].ks1;                  \
    *(LAS u32x4*)(P_lds + (b) * SHM_P + PSWZ(pr, pc * 2)) = sr_[i].ps; } while (0)
#define SWAIT() asm volatile("s_waitcnt vmcnt(0)" ::: "memory")
#define RESC(a) do { if (__any((a) < 1.f)) { if (hi == 0) al_l[r32] = (a); asm volatile("s_waitcnt lgkmcnt(0)" ::: "memory"); \
    _Pragma("unroll") for (int d = 0; d < 4; ++d) _Pragma("unroll") for (int r = 0; r < 16; ++r) o[d][r] *= al_l[crow(r, hi)]; } } while (0)
    f32x16 pA0, pA1, pB0, pB1; float mnA, mnB, alA, alB; h16x8 pa0, pa1, pa2, pa3; const int NT = seq / 64;
    constexpr int SE = 0, SO = 0;
    SLOAD(SE, 0); asm volatile("s_waitcnt vmcnt(0)" ::: "memory"); SWRITE(0, SE); __syncthreads();
    qkt(pA0, pA1, K_lds, P_lds, qr, qp, r32, hi); partialSM(pA0, pA1, m_reg, mnA, alA);
    SLOAD(SO, 64);
    SWAIT(); SWRITE(1, SO); __syncthreads();
    for (int j = 1; j + 1 < NT; j += 2) {
        SBAR(); qkt(pB0, pB1, K_lds + SHM_K, P_lds + SHM_P, qr, qp, r32, hi);
        finishSM(pA0, pA1, alA, l_reg, pa0, pa1, pa2, pa3); SBAR();
        SLOAD(SO, (j + 1) * 64); SBAR();
        pv_d0(o, vb0, pa0, pa1, pa2, pa3); partialSM(pB0, pB1, m_reg, mnB, alB);
        __syncthreads(); SWAIT(); SWRITE(0, SE);
        RESC(alB); __syncthreads();
        SBAR(); qkt(pA0, pA1, K_lds, P_lds, qr, qp, r32, hi);
        finishSM(pB0, pB1, alB, l_reg, pa0, pa1, pa2, pa3); SBAR();
        SLOAD(SE, (j + 2) * 64); SBAR();
        pv_d0(o, vb0 + SHM_V, pa0, pa1, pa2, pa3); partialSM(pA0, pA1, m_reg, mnA, alA);
        __syncthreads(); SWAIT(); SWRITE(1, SO);
        RESC(alA); __syncthreads();
    }
    SBAR(); qkt(pB0, pB1, K_lds + SHM_K, P_lds + SHM_P, qr, qp, r32, hi);
    finishSM(pA0, pA1, alA, l_reg, pa0, pa1, pa2, pa3); SBAR();
    pv_d0(o, vb0, pa0, pa1, pa2, pa3); partialSM(pB0, pB1, m_reg, mnB, alB);
    __syncthreads(); RESC(alB);
    finishSM(pB0, pB1, alB, l_reg, pa0, pa1, pa2, pa3); SBAR();
    pv_d0(o, vb0 + SHM_V, pa0, pa1, pa2, pa3);
    if (hi == 0) li_l[r32] = l_reg; asm volatile("s_waitcnt lgkmcnt(0)" ::: "memory");
    float rli[16];
#pragma unroll
    for (int r = 0; r < 16; ++r) rli[r] = __builtin_amdgcn_rcpf(li_l[crow(r, hi)]);
    h16* Ow = Ob + (size_t)(wid * 32) * DM;
#pragma unroll
    for (int r = 0; r < 16; ++r) { const int orow = crow(r, hi);
#pragma unroll
        for (int d0 = 0; d0 < 4; ++d0) Ow[(size_t)orow * DM + d0 * 32 + r32] = (h16)(o[d0][r] * rli[r]); }
    __syncthreads();
#undef SLOAD
#undef SWRITE
#undef SWAIT
#undef RESC
}
#undef KSWZ
#undef PSWZ
}

__device__ __forceinline__ void phase_attn(const Args& a, LAS char* lds, int vcu) {
    const h16* Q = (const h16*)(a.ws + WS_Q); const h16* KN = (const h16*)(a.ws + WS_KN); const h16* VV = (const h16*)(a.ws + WS_VV);
    const h16* KPE = (const h16*)(a.ws + WS_KPE); h16* MIX = (h16*)(a.ws + WS_MIX);
    for (int it = vcu; it < 256; it += gridDim.x) {
        const int bh = it >> 3, qb = it & 7, b = bh >> 3, h = bh & 7;
        att::attn_body(Q + ((size_t)bh * SEQ + qb * 256) * 192, KN + (size_t)bh * LK * 128, VV + (size_t)bh * LK * 128, KPE + (size_t)b * LK * 64,
                       MIX + ((size_t)b * SEQ + qb * 256) * DM + 1024 + h * 128, LK, lds);
    }
}
__device__ __forceinline__ void phase_retout(const Args& a, LAS char* lds, int vcu) {
    for (int it = vcu; it < 512; it += gridDim.x) ret_out_item(a, lds, it >> 4, it & 15);
}

__device__ __forceinline__ void phase_oproj(const Args& a, LAS char* lds, int vcu) {
    GemmThread2 G; G.init();
    const h16* MIX = (const h16*)(a.ws + WS_MIX); const float* MOD = (const float*)(a.ws + WS_MOD); h16* U = (h16*)(a.ws + WS_U);
    const float* X = a.in[I_X];
    for (int p = vcu; p < 32 * 8; p += gridDim.x) {
        const int mg = p >> 5, rem = p & 31, nt = rem >> 2, mt = mg * 4 + (rem & 3);
        f32x4 acc[8][4];
        gemm_tile_g2(lds, G, MIX + (size_t)mt * 256 * DM, DM, (const h16*)(a.ws + WS_WO16) + nt * 256, DM, DM / 64, acc);
        const int b = mt >> 3, c0 = nt * 256 + G.wn * 64 + 4 * G.g;
        const float* g1 = MOD + (size_t)b * ADAW + 2 * DM + c0;
        f32x4 gv[4];
#pragma unroll
        for (int ni = 0; ni < 4; ++ni) gv[ni] = *(const f32x4*)(g1 + ni * 16);
        const size_t ro0 = (size_t)(mt * 256 + G.wm * 128 + G.r16) * DM + c0;
        f32x4 xn[4];
#pragma unroll
        for (int ni = 0; ni < 4; ++ni) xn[ni] = *(const f32x4*)(X + ro0 + ni * 16);
#pragma unroll
        for (int mi = 0; mi < 8; ++mi) {
            const size_t ro = ro0 + (size_t)mi * 16 * DM;
            f32x4 xv[4];
#pragma unroll
            for (int ni = 0; ni < 4; ++ni) xv[ni] = xn[ni];
            if (mi < 7) {
#pragma unroll
                for (int ni = 0; ni < 4; ++ni) xn[ni] = *(const f32x4*)(X + ro + (size_t)16 * DM + ni * 16);
            }
            __builtin_amdgcn_sched_barrier(0);
            f32x4 c[4];
#pragma unroll
            for (int ni = 0; ni < 4; ++ni) c[ni] = xv[ni] * ALPHA + gv[ni] * acc[mi][ni];
            st_rows16(U + ro - 4 * G.g, c, 1.f, G.g);
        }
    }
}

__device__ __forceinline__ int rt_off(int m, int c) { return m * 4096 + ((c ^ (m & 15)) << 4); }
__device__ __forceinline__ void phase_router(const Args& a, LAS char* lds) {
    const int tid = threadIdx.x, lane = tid & 63, wid = __builtin_amdgcn_readfirstlane(tid >> 6), r16 = lane & 15, g = lane >> 4;
    const h16* U = (const h16*)(a.ws + WS_U); const float* MOD = (const float*)(a.ws + WS_MOD);
    h16* H = (h16*)(a.ws + WS_H); unsigned char* A2q = (unsigned char*)(a.ws + WS_A2);
    int* LIST = (int*)(a.ws + WS_LIST); float* WL = (float*)(a.ws + WS_WL); unsigned* CNT = (unsigned*)(a.ws + WS_CTL) + CW_CNT;
    const h16* WRH = (const h16*)(a.ws + WS_WRH);
    const float* ln1w = a.in[I_LN1W]; const float* ln1b = a.in[I_LN1B];
    LAS char* THI = lds;
    LAS f32x4* red = (LAS f32x4*)lds;
    LAS float* lg = (LAS float*)(lds + 65536);
    LAS int* asg_e = (LAS int*)(lds + LDS_MAP + 2048); LAS int* asg_t = asg_e + 64; LAS float* asg_w = (LAS float*)(asg_e + 128);
    for (int base = blockIdx.x * 32; base < T; base += gridDim.x * 32) {
#pragma unroll 1
        for (int rr = 0; rr < 4; rr += 2) {
            const int m = 4 * wid + rr, row = base + m, b = row >> 11;
            f32x4 v[2][8]; float s[2] = {0.f, 0.f};
#pragma unroll
            for (int r = 0; r < 2; ++r)
#pragma unroll
                for (int j = 0; j < 8; ++j) { const h16x4 u4 = *(const h16x4*)(U + (size_t)(row + r) * DM + j * 256 + lane * 4);
#pragma unroll
                    for (int e = 0; e < 4; ++e) v[r][j][e] = (float)u4[e];
                    s[r] += (v[r][j][0] + v[r][j][1]) + (v[r][j][2] + v[r][j][3]); }
            float mean[2], q[2] = {0.f, 0.f}, rstd[2];
#pragma unroll
            for (int r = 0; r < 2; ++r) mean[r] = wave_sum(s[r]) * (1.f / DM);
#pragma unroll
            for (int r = 0; r < 2; ++r)
#pragma unroll
                for (int j = 0; j < 8; ++j) { v[r][j] = v[r][j] - mean[r]; q[r] += (v[r][j][0] * v[r][j][0] + v[r][j][1] * v[r][j][1]) + (v[r][j][2] * v[r][j][2] + v[r][j][3] * v[r][j][3]); }
#pragma unroll
            for (int r = 0; r < 2; ++r) { rstd[r] = 1.f / sqrtf(wave_sum(q[r]) * (1.f / DM) + EPS); s[r] = 0.f; }
#pragma unroll
            for (int j = 0; j < 8; ++j) {
                const int k = j * 256 + lane * 4;
                const f32x4 lw = *(const f32x4*)(ln1w + k), lb = *(const f32x4*)(ln1b + k);
#pragma unroll
                for (int r = 0; r < 2; ++r) {
                    v[r][j] = v[r][j] * rstd[r] * lw + lb;
                    *(h16x4*)(H + (size_t)(row + r) * DM + k) = cvt4(v[r][j]);
                    s[r] += (v[r][j][0] + v[r][j][1]) + (v[r][j][2] + v[r][j][3]);
                }
            }
#pragma unroll
            for (int r = 0; r < 2; ++r) { mean[r] = wave_sum(s[r]) * (1.f / DM); q[r] = 0.f; }
#pragma unroll
            for (int r = 0; r < 2; ++r)
#pragma unroll
                for (int j = 0; j < 8; ++j) { v[r][j] = v[r][j] - mean[r]; q[r] += (v[r][j][0] * v[r][j][0] + v[r][j][1] * v[r][j][1]) + (v[r][j][2] * v[r][j][2] + v[r][j][3] * v[r][j][3]); }
#pragma unroll
            for (int r = 0; r < 2; ++r) rstd[r] = 1.f / sqrtf(wave_sum(q[r]) * (1.f / DM) + EPS);
#pragma unroll
            for (int j = 0; j < 8; ++j) {
                const int k = j * 256 + lane * 4;
                const f32x4 sh = *(const f32x4*)(MOD + (size_t)b * ADAW + 3 * DM + k), sc = *(const f32x4*)(MOD + (size_t)b * ADAW + 4 * DM + k);
#pragma unroll
                for (int r = 0; r < 2; ++r) {
                    const f32x4 tt = v[r][j] * rstd[r] * (sc + 1.f) + sh;
                    const h16x4 hi = cvt4(tt);
                    int w8 = __builtin_amdgcn_cvt_pk_fp8_f32(tt[0], tt[1], 0, false); w8 = __builtin_amdgcn_cvt_pk_fp8_f32(tt[2], tt[3], w8, true);
                    *(int*)(A2q + (size_t)(row + r) * DM + k) = w8;
                    *(LAS h16x4*)(THI + rt_off(m + r, j * 32 + (lane >> 1)) + (lane & 1) * 8) = hi;
                }
            }
        }
        __syncthreads();
        f32x4 acc[2][3];
#pragma unroll
        for (int mt = 0; mt < 2; ++mt)
#pragma unroll
            for (int nt = 0; nt < 3; ++nt) acc[mt][nt] = (f32x4){0.f, 0.f, 0.f, 0.f};
#pragma unroll 4
        for (int s8 = 0; s8 < 8; ++s8) {
            const int c = wid * 32 + s8 * 4 + g;
            const h16x8 t0 = *(LAS h16x8*)(THI + rt_off(r16, c)), t1 = *(LAS h16x8*)(THI + rt_off(16 + r16, c));
#pragma unroll
            for (int nt = 0; nt < 3; ++nt) {
                const h16x8 wh = *(const h16x8*)(WRH + (size_t)(16 * nt + r16) * DM + c * 8);
                acc[0][nt] = mfma16(wh, t0, acc[0][nt]); acc[1][nt] = mfma16(wh, t1, acc[1][nt]);
            }
        }
        __syncthreads();
#pragma unroll
        for (int mt = 0; mt < 2; ++mt)
#pragma unroll
            for (int nt = 0; nt < 3; ++nt) red[(wid * 6 + mt * 3 + nt) * 64 + lane] = acc[mt][nt];
        __syncthreads();
        if (tid < 384) {
            const int t6 = tid >> 6, l2 = tid & 63, mt = t6 / 3, nt = t6 - 3 * mt;
            f32x4 sum = (f32x4){0.f, 0.f, 0.f, 0.f};
#pragma unroll
            for (int w = 0; w < 8; ++w) sum += red[(w * 6 + t6) * 64 + l2];
#pragma unroll
            for (int r = 0; r < 4; ++r) lg[(16 * mt + (l2 & 15)) * 48 + 16 * nt + 4 * (l2 >> 4) + r] = sum[r] * (1.f / 1024.f);
        }
        __syncthreads();
        if (tid < 32) {
            const int row = base + tid;
            const float* bg = a.in[I_RGB]; const float* be = a.in[I_REB];
            float glv[4];
#pragma unroll
            for (int c = 0; c < 4; ++c) glv[c] = lg[tid * 48 + c] + bg[c];
            int gs = 0; float gm = glv[0];
#pragma unroll
            for (int c = 1; c < 4; ++c) if (glv[c] > gm) { gm = glv[c]; gs = c; }
            float gden = 0.f;
#pragma unroll
            for (int c = 0; c < 4; ++c) gden += __expf(glv[c] - gm);
            const float gp = 1.f / gden;
            float el[8];
#pragma unroll
            for (int c = 0; c < 8; ++c) el[c] = lg[tid * 48 + 4 + gs * 8 + c] + be[gs * 8 + c];
            int i0 = 0; float v0 = el[0];
#pragma unroll
            for (int c = 1; c < 8; ++c) if (el[c] > v0) { v0 = el[c]; i0 = c; }
            int i1 = -1; float v1 = -3.0e38f;
#pragma unroll
            for (int c = 0; c < 8; ++c) if (c != i0 && el[c] > v1) { v1 = el[c]; i1 = c; }
            const float ex = __expf(v1 - v0), w0 = gp / (1.f + ex), w1 = gp * ex / (1.f + ex);
            asg_e[2 * tid] = gs * 8 + i0; asg_t[2 * tid] = row * 2; asg_w[2 * tid] = w0;
            asg_e[2 * tid + 1] = gs * 8 + i1; asg_t[2 * tid + 1] = row * 2 + 1; asg_w[2 * tid + 1] = w1;
        }
        __syncthreads();
        if (tid < NEXP) {
            int c = 0;
#pragma unroll 4
            for (int i = 0; i < 64; ++i) c += (asg_e[i] == tid) ? 1 : 0;
            if (c) {
                const int sub = tid * 8 + (blockIdx.x & 7);
                unsigned pos = atomicAdd(&CNT[sub], (unsigned)c);
                for (int i = 0; i < 64; ++i) if (asg_e[i] == tid) { LIST[(size_t)sub * SUBCAP + pos] = asg_t[i]; WL[(size_t)sub * SUBCAP + pos] = asg_w[i]; ++pos; }
            }
        }
        __syncthreads();
    }
}

struct MoeMap { int upre[NEXP + 1]; int rpre[NEXP + 1]; };
__device__ __forceinline__ void moe_map(const Args& a, LAS int* mp, int units_per_mtile) {
    const unsigned* CNT = (const unsigned*)(a.ws + WS_CTL) + CW_CNT;
    LAS int* c8 = mp + 448;
    if (threadIdx.x < NEXP * 8) c8[threadIdx.x] = (int)__hip_atomic_load(&CNT[threadIdx.x], __ATOMIC_RELAXED, __HIP_MEMORY_SCOPE_AGENT);
    __syncthreads();
    if (threadIdx.x < NEXP) {
        int acc = 0;
        for (int x = 0; x < 8; ++x) { mp[128 + 9 * threadIdx.x + x] = acc; acc += c8[threadIdx.x * 8 + x]; }
        mp[128 + 9 * threadIdx.x + 8] = acc; mp[66 + threadIdx.x] = acc;
    }
    __syncthreads();
    if (threadIdx.x == 0) {
        int up = 0, rp = 0;
        for (int e = 0; e < NEXP; ++e) {
            const int c = mp[66 + e];
            const int ntm = (c + 255) >> 8;
            mp[e] = up; mp[33 + e] = rp;
            up += ntm * units_per_mtile; rp += ntm * 256;
        }
        mp[32] = up; mp[65] = rp;
    }
    __syncthreads();
}
__device__ __forceinline__ int moe_pos(const LAS int* mp, int e, int idx) {
    const LAS int* sp = mp + 128 + 9 * e;
    int x = 0;
#pragma unroll
    for (int i = 1; i < 8; ++i) x += (idx >= sp[i]) ? 1 : 0;
    return (e * 8 + x) * SUBCAP + idx - sp[x];
}
__device__ __forceinline__ void wdown_pool(const Args& a, LAS char* lds, int budget);
__device__ __forceinline__ void phase_moe1(const Args& a, LAS char* lds, int vcu) {
    GemmThread G; G.init();
    LAS int* mp = (LAS int*)(lds + LDS_MAP);
    moe_map(a, mp, 8);
    const unsigned char* A2q = (const unsigned char*)(a.ws + WS_A2); const int* LIST = (const int*)(a.ws + WS_LIST); unsigned char* HID = (unsigned char*)(a.ws + WS_HID);
    const int NU = mp[32];
    int e = 0;
    for (int p = vcu; p < NU; p += gridDim.x) {
        while (p >= mp[e + 1]) ++e;
        const int q = p - mp[e], cnt = mp[66 + e], ntm = (cnt + 255) >> 8, nt = q / ntm, mt = q % ntm;
        const unsigned char* arow[2];
#pragma unroll
        for (int i = 0; i < 2; ++i) {
            const int idx = mt * 256 + (G.tid >> 2) + 128 * i;
            const int tok = (idx < cnt) ? (LIST[moe_pos(mp, e, idx)] >> 1) : 0;
            arow[i] = A2q + (size_t)tok * DM + (G.tid & 3) * 16;
        }
        const int c = (G.tid & 31) * 4, wnc = c >> 6, within = c & 63;
        const float* wsrc = (within >= 32) ? a.in[I_EWU] : a.in[I_EWG];
        const float* bcol = wsrc + (size_t)e * DM * DE + (size_t)(G.tid >> 5) * DE + nt * 64 + wnc * 32 + (within & 31);
        f32x4 acc[4][4];
        gemm_tile(lds, G, arow, bcol, (size_t)DE, DM / 64, acc);
        {
#pragma unroll
            for (int mi = 0; mi < 4; ++mi) {
                unsigned char* dst = HID + (size_t)(mp[33 + e] + mt * 256) * DE + nt * 16384 + (G.wm * 64 + mi * 16 + G.r16) * 64 + G.wn * 32 + 4 * G.g;
#pragma unroll
                for (int ni = 0; ni < 2; ++ni) {
                    f32x4 o;
#pragma unroll
                    for (int r = 0; r < 4; ++r) o[r] = silu_f(acc[mi][ni][r]) * acc[mi][ni + 2][r];
                    int w8 = __builtin_amdgcn_cvt_pk_fp8_f32(o[0], o[1], 0, false); w8 = __builtin_amdgcn_cvt_pk_fp8_f32(o[2], o[3], w8, true);
                    *(int*)(dst + ni * 16) = w8;
                }
            }
        }
    }
    wdown_pool(a, lds, 1 << 20);
}
constexpr int POOL_ITEMS = (NEXP * DE * DM / 8) / (NTHREADS * 8);
__device__ __forceinline__ void wdown_pool(const Args& a, LAS char* lds, int budget) {
    unsigned* head = (unsigned*)(a.ws + WS_CTL) + CW_POOL;
    const float* W = a.in[I_EWD]; h16* O = (h16*)(a.ws + WS_WD16);
    LAS unsigned* slot = (LAS unsigned*)(lds + LDS_MAP + 400);
    for (int it = 0; it < budget; ++it) {
        __syncthreads();
        if (threadIdx.x == 0) *slot = atomicAdd(head, 1u);
        __syncthreads();
        const unsigned item = *slot;
        if (item >= (unsigned)POOL_ITEMS) break;
        const size_t base = (size_t)item * (NTHREADS * 8) + threadIdx.x;
        f32x4 v[8][2];
#pragma unroll
        for (int j = 0; j < 8; ++j) { const float* p = W + (base + (size_t)j * NTHREADS) * 8; v[j][0] = *(const f32x4*)p; v[j][1] = *(const f32x4*)(p + 4); }
#pragma unroll
        for (int j = 0; j < 8; ++j) {
            h16x8 o;
#pragma unroll
            for (int e = 0; e < 4; ++e) { o[e] = (h16)v[j][0][e]; o[4 + e] = (h16)v[j][1][e]; }
            *(h16x8*)(O + (base + (size_t)j * NTHREADS) * 8) = o;
        }
    }
}
__device__ __forceinline__ void phase_moe2(const Args& a, LAS char* lds, int vcu) {
    GemmThread G; G.init();
    LAS int* mp = (LAS int*)(lds + LDS_MAP);
    if (a.ph_lo == 11) moe_map(a, mp, 16);
    else { if (threadIdx.x <= 32) mp[threadIdx.x] *= 2; __syncthreads(); }
    const unsigned char* HID = (const unsigned char*)(a.ws + WS_HID); const int* LIST = (const int*)(a.ws + WS_LIST); const float* WL = (const float*)(a.ws + WS_WL);
    const h16* WD16 = (const h16*)(a.ws + WS_WD16); h16* Y = (h16*)(a.ws + WS_Y);
    LAS int* eslot = (LAS int*)(lds + LDS_ROWS); LAS float* ew = (LAS float*)(lds + LDS_MAP + 2048);
    const int NU = mp[32];
    G3Stream S; S.gs = 0; S.primed = false;
    int e = 0;
    for (int p = vcu; p < NU; p += gridDim.x) {
        while (p >= mp[e + 1]) ++e;
        const int q = p - mp[e], cnt = mp[66 + e], ntm = (cnt + 255) >> 8, nt = q / ntm, mt = q % ntm;
        const int pn = p + (int)gridDim.x; const bool hn = pn < NU;
        const unsigned char* nA = nullptr; const h16* nB = nullptr;
        if (hn) { int e2 = e; while (pn >= mp[e2 + 1]) ++e2;
            const int q2 = pn - mp[e2], ntm2 = (mp[66 + e2] + 255) >> 8, nt2 = q2 / ntm2, mt2 = q2 % ntm2;
            nA = HID + (size_t)(mp[33 + e2] + mt2 * 256) * DE; nB = WD16 + (size_t)e2 * DE * DM + nt2 * 128; }
        if (threadIdx.x < 256) {
            const int idx = mt * 256 + (int)threadIdx.x;
            const int lp = moe_pos(mp, e, idx < cnt ? idx : 0);
            eslot[threadIdx.x] = (idx < cnt) ? LIST[lp] : -1; ew[threadIdx.x] = WL[lp];
        }
        f32x4 acc[4][4];
        gemm_tile_g8(lds, G, HID + (size_t)(mp[33 + e] + mt * 256) * DE, DE, WD16 + (size_t)e * DE * DM + nt * 128, DM, DE / 64, acc, S, nA, nB);
        {
            unsigned es[4], ewv[4];
            { const int rb = (G.wm * 64 + G.r16) * 4;
              es[0] = asm_rd32<0>((int)(uintptr_t)eslot + rb); es[1] = asm_rd32<64>((int)(uintptr_t)eslot + rb); es[2] = asm_rd32<128>((int)(uintptr_t)eslot + rb); es[3] = asm_rd32<192>((int)(uintptr_t)eslot + rb);
              ewv[0] = asm_rd32<0>((int)(uintptr_t)ew + rb); ewv[1] = asm_rd32<64>((int)(uintptr_t)ew + rb); ewv[2] = asm_rd32<128>((int)(uintptr_t)ew + rb); ewv[3] = asm_rd32<192>((int)(uintptr_t)ew + rb); }
            LGKM0();
#pragma unroll
            for (int mi = 0; mi < 4; ++mi) {
                const int slot = (int)es[mi]; const float w = __uint_as_float(ewv[mi]);
                u32x4 v[2];
                acc_rows16(acc[mi], w, v);
                if (slot >= 0) {
                    h16* dst = Y + (size_t)slot * DM + nt * 128 + G.wn * 64 + 8 * G.g;
                    *(u32x4*)dst = v[0]; *(u32x4*)(dst + 32) = v[1];
                }
            }
        }
        __builtin_amdgcn_s_barrier();
    }
}

__device__ __forceinline__ void phase_final(const Args& a) {
    const int tid = threadIdx.x, lane = tid & 63, wid = tid >> 6;
    const h16* H = (const h16*)(a.ws + WS_H); const h16* Y = (const h16*)(a.ws + WS_Y); const float* MOD = (const float*)(a.ws + WS_MOD);
    const float* w2 = a.in[I_LN2W]; const float* b2 = a.in[I_LN2B];
    for (int row = blockIdx.x * 16 + 2 * wid; row < T; row += gridDim.x * 16) {
        const int b = row >> 11;
        f32x4 v[2][8]; float s[2] = {0.f, 0.f};
#pragma unroll
        for (int j = 0; j < 8; ++j) {
            const int k = j * 256 + lane * 4;
            const f32x4 g2 = *(const f32x4*)(MOD + (size_t)b * ADAW + 5 * DM + k);
#pragma unroll
            for (int r = 0; r < 2; ++r) {
                const h16x4 h4 = *(const h16x4*)(H + (size_t)(row + r) * DM + k);
                const h16x4 y0 = *(const h16x4*)(Y + (size_t)((row + r) * 2) * DM + k), y1 = *(const h16x4*)(Y + (size_t)((row + r) * 2 + 1) * DM + k);
                f32x4 hv, yv;
#pragma unroll
                for (int e = 0; e < 4; ++e) { hv[e] = (float)h4[e]; yv[e] = (float)y0[e] + (float)y1[e]; }
                v[r][j] = hv * ALPHA + g2 * yv;
                s[r] += (v[r][j][0] + v[r][j][1]) + (v[r][j][2] + v[r][j][3]);
            }
            if (j == 3) __builtin_amdgcn_sched_barrier(0);
        }
        float mean[2], q[2] = {0.f, 0.f}, rstd[2];
#pragma unroll
        for (int r = 0; r < 2; ++r) mean[r] = wave_sum(s[r]) * (1.f / DM);
#pragma unroll
        for (int r = 0; r < 2; ++r)
#pragma unroll
            for (int j = 0; j < 8; ++j) { v[r][j] = v[r][j] - mean[r]; q[r] += (v[r][j][0] * v[r][j][0] + v[r][j][1] * v[r][j][1]) + (v[r][j][2] * v[r][j][2] + v[r][j][3] * v[r][j][3]); }
#pragma unroll
        for (int r = 0; r < 2; ++r) rstd[r] = 1.f / sqrtf(wave_sum(q[r]) * (1.f / DM) + EPS);
#pragma unroll
        for (int j = 0; j < 8; ++j) {
            const int k = j * 256 + lane * 4;
            const f32x4 lw = *(const f32x4*)(w2 + k), lb = *(const f32x4*)(b2 + k);
#pragma unroll
            for (int r = 0; r < 2; ++r) *(f32x4*)(a.out + (size_t)(row + r) * DM + k) = v[r][j] * rstd[r] * lw + lb;
        }
    }
}

constexpr int NPHASE = 13;
#ifndef REP_PHASE
#define REP_PHASE -1
#endif
#ifndef ONE_LAUNCH
#define ONE_LAUNCH 1
#endif
__global__ void __launch_bounds__(NTHREADS, 2) mega(Args a) {
    extern __shared__ __attribute__((aligned(16))) unsigned char lds_raw[];
    LAS char* lds = (LAS char*)lds_raw;
    volatile LAS unsigned* misc = (volatile LAS unsigned*)(lds + LDS_MISC);
    if (threadIdx.x < 64) misc[threadIdx.x] = 0u;
    __syncthreads();
    const int G_ = gridDim.x, bx = blockIdx.x;
    const int vcu = (G_ % 8 == 0) ? (bx % 8) * (G_ / 8) + bx / 8 : bx;
    XcdBarrier bar; bar.bar = (unsigned*)(a.ws + WS_CTL) + CW_BAR; bar.x = 0; bar.st = misc + 8;
    if (ONE_LAUNCH) bar = xcd_barrier_post((unsigned*)(a.ws + WS_CTL) + CW_BAR, misc + 8);
    const int lo = a.ph_lo, hi = a.ph_hi;
#ifndef PH_MASK
#define PH_MASK 0x1fff
#endif
#define IN(k) (((PH_MASK >> (k)) & 1) && lo <= (k) && (k) < hi)
#define SEAM(k) do { if (IN(k) && IN((k) + 1)) xcd_barrier(bar); } while (0)
    if (IN(0)) { phase_cvt(a); phase_adaln(a, lds); }
    SEAM(0);
    if (IN(1)) phase_modulate(a, lds);
    SEAM(1);
    if (IN(2)) phase_inproj(a, lds, vcu, 0);
    SEAM(2);
    if (IN(3)) phase_mid(a, lds, vcu);
    if (IN(3) && IN(4)) xcd_barrier(bar);
    if (IN(5)) phase_ret_scan(a);
    SEAM(5);
    if (IN(6)) phase_attn(a, lds, vcu);
    if (IN(7)) phase_retout(a, lds, vcu);
    SEAM(7);
    if (IN(8)) phase_oproj(a, lds, vcu);
    SEAM(8);
    if (IN(9)) phase_router(a, lds);
    SEAM(9);
    if (IN(10)) phase_moe1(a, lds, vcu);
    SEAM(10);
    if (IN(11)) phase_moe2(a, lds, vcu);
    SEAM(11);
    if (IN(12)) phase_final(a);
}

extern "C" void kernel_launch(void* const* d_in, const int* in_sizes, int n_in, void* d_out, int out_size, void* d_ws, size_t ws_size, hipStream_t stream) {
    static int grid = 0;
    if (grid == 0) {
        if (n_in != 25 || out_size != T * DM || ws_size < WS_END) { fprintf(stderr, "kernel_launch: unexpected shapes: n_in %d out %d ws %zu (need %zu)\n", n_in, out_size, ws_size, (size_t)WS_END); grid = -1; return; }
        int dev = 0, cus = 0, per_cu = 0;
        if (hipGetDevice(&dev) != hipSuccess || hipDeviceGetAttribute(&cus, hipDeviceAttributeMultiprocessorCount, dev) != hipSuccess) { grid = -1; return; }
        if (hipFuncSetAttribute((const void*)mega, hipFuncAttributeMaxDynamicSharedMemorySize, LDS_BYTES) != hipSuccess) { fprintf(stderr, "kernel_launch: hipFuncSetAttribute failed\n"); grid = -1; return; }
        if (hipOccupancyMaxActiveBlocksPerMultiprocessor(&per_cu, (const void*)mega, NTHREADS, LDS_BYTES) != hipSuccess || per_cu < 1) { fprintf(stderr, "kernel_launch: occupancy query says %d blocks per CU\n", per_cu); }
        (void)hipGetLastError();
        grid = cus;
    }
    if (grid < 0) return;
    (void)hipMemsetAsync((char*)d_ws + WS_CTL, 0, CTL_BYTES, stream);
    Args a{};
    for (int i = 0; i < 25; ++i) a.in[i] = (const float*)d_in[i];
    a.out = (float*)d_out; a.ws = (unsigned char*)d_ws;
    if (ONE_LAUNCH) {
        a.ph_lo = 0; a.ph_hi = NPHASE;
        hipLaunchKernelGGL(mega, dim3(grid), dim3(NTHREADS), LDS_BYTES, stream, a);
    } else {
        for (int p = 0; p < NPHASE; ++p) { a.ph_lo = p; a.ph_hi = p + 1;
            for (int r = 0; r < 1 + (p == REP_PHASE); ++r) {
                if (p == 9) (void)hipMemsetAsync((char*)d_ws + WS_CTL, 0, CTL_BYTES, stream);
                hipLaunchKernelGGL(mega, dim3(grid), dim3(NTHREADS), LDS_BYTES, stream, a); } }
    }
    const hipError_t le = hipPeekAtLastError();
    if (le != hipSuccess) fprintf(stderr, "kernel_launch: launch failed: %s\n", hipGetErrorName(le));
}
```

```cpp
#include <hip/hip_runtime.h>
#include <cstdio>
#include <cstdint>

#ifndef REP_MASK
#define REP_MASK 0
#endif
#define REP(k) ((REP_MASK >> (k)) & 1)
#define LAS __attribute__((address_space(3)))
#define GAS __attribute__((address_space(1)))
typedef _Float16 h16;
typedef _Float16 h16x8 __attribute__((ext_vector_type(8)));
typedef _Float16 h16x4 __attribute__((ext_vector_type(4)));
typedef _Float16 h16x2 __attribute__((ext_vector_type(2)));
typedef float f32x4 __attribute__((ext_vector_type(4)));
typedef float f32x2 __attribute__((ext_vector_type(2)));
typedef float f32x16 __attribute__((ext_vector_type(16)));
typedef unsigned u32x4 __attribute__((ext_vector_type(4)));
typedef unsigned u32x2 __attribute__((ext_vector_type(2)));
typedef short s16x4v __attribute__((__vector_size__(8)));

constexpr int DM = 2048, NB = 4, SEQ = 2048, LC = 256, LK = LC + SEQ;
constexpr int T = NB * SEQ, TCX = NB * LC, TA = T + TCX;
constexpr int INW = 4928, NEXP = 32, DE = 512;
constexpr int ADAW = 6 * DM;
constexpr float EPS = 1e-6f, ALPHA = 1.189207115002721f;
constexpr float KSCALE = 0.08838834764831845f;
constexpr float L2_10000 = 13.287712379549449f;
constexpr int NTHREADS = 512;

constexpr size_t al256(size_t x) { return (x + 255) / 256 * 256; }
constexpr size_t WS_CTL = 0, CTL_BYTES = 65536;
constexpr size_t WS_PART = WS_CTL + CTL_BYTES;
constexpr size_t WS_MOD = WS_PART + al256((size_t)8 * 5 * ADAW * 4);
constexpr size_t WS_A1 = WS_MOD + al256((size_t)5 * ADAW * 4);
constexpr size_t WS_QR = WS_A1 + al256((size_t)TA * DM * 2);
constexpr size_t WS_KR = WS_QR + al256((size_t)T * 1024 * 2);
constexpr size_t WS_VR = WS_KR + al256((size_t)T * 1024 * 2);
constexpr size_t WS_KC = WS_VR + al256((size_t)T * 1024 * 2);
constexpr size_t WS_VC = WS_KC + al256((size_t)TCX * 1024 * 2);
constexpr size_t WS_GS = WS_VC + al256((size_t)TCX * 1024 * 2);
constexpr size_t WS_CQ = WS_GS + al256((size_t)T * 1024 * 2);
constexpr size_t WS_CKV = WS_CQ + al256((size_t)T * 512 * 2);
constexpr size_t WS_KPE = WS_CKV + al256((size_t)NB * LK * 256 * 2);
constexpr size_t WS_Q = WS_KPE + al256((size_t)NB * LK * 64 * 2);
constexpr size_t WS_KN = WS_Q + al256((size_t)T * 1536 * 2);
constexpr size_t WS_VV = WS_KN + al256((size_t)NB * 8 * LK * 128 * 2);
constexpr size_t WS_UF = WS_VV + al256((size_t)NB * 8 * LK * 128 * 2);
constexpr size_t WS_UB = WS_UF + al256((size_t)32 * 16 * 16384 * 4);
constexpr size_t WS_S0F = WS_UB + al256((size_t)32 * 16 * 16384 * 4);
constexpr size_t WS_S0B = WS_S0F + al256((size_t)32 * 16384 * 4);
constexpr size_t WS_SF = WS_S0B + al256((size_t)32 * 16384 * 4);
constexpr size_t WS_SB = WS_SF + al256((size_t)32 * 16 * 16384 * 2);
constexpr size_t WS_MIX = WS_SB + al256((size_t)32 * 16 * 16384 * 2);
constexpr size_t WS_U = WS_MIX + al256((size_t)T * DM * 2);
constexpr size_t WS_H = WS_U + al256((size_t)T * DM * 2);
constexpr size_t WS_A2 = WS_H + al256((size_t)T * DM * 2);
constexpr int SUBCAP = 2048;
constexpr size_t WS_LIST = WS_A2 + al256((size_t)T * DM * 2);
constexpr size_t WS_WL = WS_LIST + al256((size_t)NEXP * 8 * SUBCAP * 4);
constexpr int HID_ROWS = 2 * T + NEXP * 256;
constexpr size_t WS_HID = WS_WL + al256((size_t)NEXP * 8 * SUBCAP * 4);
constexpr size_t WS_Y = WS_HID + al256((size_t)HID_ROWS * DE * 2);
constexpr int WINP = 5120;
constexpr size_t WS_WIN16 = WS_Y + al256((size_t)2 * T * DM * 2);
constexpr size_t WS_WO16 = WS_WIN16 + al256((size_t)DM * WINP * 2);
constexpr size_t WS_WUQ16 = WS_WO16 + al256((size_t)DM * DM * 2);
constexpr size_t WS_WUKV16 = WS_WUQ16 + al256((size_t)512 * 1536 * 2);
constexpr size_t WS_WRH = WS_WUKV16 + al256((size_t)256 * 2048 * 2);
constexpr size_t WS_WRL = WS_WRH + al256((size_t)48 * DM * 2);
constexpr size_t WS_WD16 = WS_WRL + al256((size_t)48 * DM * 2);
constexpr size_t WS_END = WS_WD16 + al256((size_t)NEXP * DE * DM * 2);

constexpr int CW_CNT = 256;
constexpr int CW_POOL = 128;
constexpr int CW_ACNT = 159;
constexpr int CW_UCNT = 192;
constexpr int CW_MCNT = 224;
constexpr int CW_SCAN = 160;
constexpr int CW_BAR = 1024;

constexpr int LDS_BYTES = 151808;
constexpr int LDS_ROWS = 147456;
constexpr int LDS_MAP = 148480;
constexpr int LDS_MISC = 151552;

template <int M> __device__ __forceinline__ float swz_xor(float v) {
    return __int_as_float(__builtin_amdgcn_ds_swizzle(__float_as_int(v), 0x1F | (M << 10)));
}
__device__ __forceinline__ float wave_sum(float v) {
    v += swz_xor<1>(v); v += swz_xor<2>(v); v += swz_xor<4>(v); v += swz_xor<8>(v); v += swz_xor<16>(v);
    { auto rr = __builtin_amdgcn_permlane32_swap(__float_as_uint(v), __float_as_uint(v), false, false); v = __uint_as_float(rr[0]) + __uint_as_float(rr[1]); }
    return v;
}
__device__ __forceinline__ float silu_f(float x) { return x / (1.f + __expf(-x)); }
__device__ __forceinline__ h16x4 cvt4(f32x4 v) { h16x4 r; r[0] = (h16)v[0]; r[1] = (h16)v[1]; r[2] = (h16)v[2]; r[3] = (h16)v[3]; return r; }
__device__ __forceinline__ h16x4 trrd(LAS char* p) { s16x4v t = __builtin_amdgcn_ds_read_tr16_b64_v4i16((LAS s16x4v*)p); return __builtin_bit_cast(h16x4, t); }
__device__ __forceinline__ h16x8 cat8(h16x4 a, h16x4 b) { return __builtin_shufflevector(a, b, 0, 1, 2, 3, 4, 5, 6, 7); }
__device__ __forceinline__ f32x4 mfma16(h16x8 a, h16x8 b, f32x4 c) { return __builtin_amdgcn_mfma_f32_16x16x32_f16(a, b, c, 0, 0, 0); }

__device__ __forceinline__ int a_off(int row, int ch) { return row * 128 + ((ch ^ (row & 7)) << 4); }
__device__ __forceinline__ int off_b(int row, int ch) { return 256 * row + 16 * (ch ^ (((row & 3) << 2) | ((row >> 2) & 3))); }
__device__ __forceinline__ int tr_addr16(int lane, int c, int ks, int t) {
    const int g = lane >> 4, q = (lane & 15) >> 2, p = lane & 3;
    return off_b(32 * ks + 8 * g + 4 * t + q, 2 * c + (p >> 1)) + 8 * (p & 1);
}
__device__ __forceinline__ int row_addr16(int lane, int rb, int s) { return off_b((lane & 15) + 16 * rb, 4 * s + (lane >> 4)); }

#define XB_TMO      128
#define XB_XCNT(j)  (256  + 64 * (j))
#define XB_XSUB(j)  (1280 + 64 * (j))
#define XB_XGEN(j)  (2304 + 64 * (j))
#define XB_TOP      3328
#define XB_TOPGEN   3392
#define XCD_BAR_WORDS 3456
#define XB_SPIN_CAP (1u << 22)
__device__ __forceinline__ unsigned xb_ld(unsigned* p)              { return __hip_atomic_load(p, __ATOMIC_RELAXED, __HIP_MEMORY_SCOPE_AGENT); }
__device__ __forceinline__ unsigned xb_add(unsigned* p, unsigned v) { return __hip_atomic_fetch_add(p, v, __ATOMIC_RELAXED, __HIP_MEMORY_SCOPE_AGENT); }
__device__ __forceinline__ unsigned xb_xcc_id() { return (unsigned)__builtin_amdgcn_s_getreg((3 << 11) | 20) & 0xFu; }
#define XB_SPIN(cond, bar) do { unsigned _sp = 0; while (cond) { __builtin_amdgcn_s_sleep(1); \
    if ((++_sp & 255u) == 0u) { if (xb_ld(&(bar)[XB_TMO])) break; if (_sp > XB_SPIN_CAP) { atomicAdd(&(bar)[XB_TMO], 1u); break; } } } } while (0)
struct XcdBarrier { unsigned* bar; unsigned x; volatile LAS unsigned* st; };
__device__ __forceinline__ XcdBarrier xcd_barrier_post(unsigned* bar, volatile LAS unsigned* st) {
    XcdBarrier b; b.bar = bar; b.x = xb_xcc_id(); b.st = st;
    if (threadIdx.x == 0) (void)xb_add(&bar[XB_XCNT(b.x)], 1u);
    return b;
}
__device__ __forceinline__ void xcd_barrier_complete(unsigned* bar, unsigned x, unsigned& nloc, unsigned& nx) {
    const unsigned G = gridDim.x * gridDim.y * gridDim.z;
    unsigned sum, cnt, mine, sp = 0u;
    for (;;) {
        sum = 0u; cnt = 0u; mine = 0u;
#pragma unroll
        for (unsigned j = 0; j < 16; ++j) { const unsigned c = xb_ld(&bar[XB_XCNT(j)]); sum += c; cnt += (c > 0u) ? 1u : 0u; mine = (j == x) ? c : mine; }
        if (sum == G) break;
        __builtin_amdgcn_s_sleep(1);
        if ((++sp & 255u) == 0u) { if (xb_ld(&bar[XB_TMO])) break; if (sp > XB_SPIN_CAP) { atomicAdd(&bar[XB_TMO], 1u); break; } }
    }
    nloc = mine > 0u ? mine : 1u; nx = cnt > 0u ? cnt : 1u;
}
__device__ __forceinline__ void xcd_barrier(const XcdBarrier& b) {
    asm volatile("s_waitcnt vmcnt(0)" ::: "memory");
    __syncthreads();
    if (threadIdx.x == 0) {
        unsigned* bar = b.bar;
        __builtin_amdgcn_s_waitcnt(0);
        unsigned nloc = b.st[0], nx = b.st[1];
        if (nloc == 0u) { xcd_barrier_complete(bar, b.x, nloc, nx); b.st[0] = nloc; b.st[1] = nx; }
        const unsigned old = xb_add(&bar[XB_XSUB(b.x)], 1u);
        const unsigned gen = old / nloc;
        if (old + 1u == (gen + 1u) * nloc) {
            __builtin_amdgcn_fence(__ATOMIC_RELEASE, "agent");
            asm volatile("s_waitcnt vmcnt(0)" ::: "memory");
            const unsigned og = xb_add(&bar[XB_TOP], 1u);
            const unsigned tg = og / nx;
            if (og + 1u == (tg + 1u) * nx) xb_add(&bar[XB_TOPGEN], 1u);
            else XB_SPIN(xb_ld(&bar[XB_TOPGEN]) == tg, bar);
            __builtin_amdgcn_fence(__ATOMIC_ACQUIRE, "agent");
            xb_add(&bar[XB_XGEN(b.x)], 1u);
            asm volatile("s_waitcnt vmcnt(0)" ::: "memory");
        } else {
            XB_SPIN(xb_ld(&bar[XB_XGEN(b.x)]) == gen, bar);
            __builtin_amdgcn_fence(__ATOMIC_ACQUIRE, "agent");
            asm volatile("s_waitcnt vmcnt(0)" ::: "memory");
        }
    }
    __syncthreads();
}

struct Args {
    const float* in[25];
    float* out;
    unsigned char* ws;
    int ph_lo, ph_hi;
};
enum { I_X = 0, I_C, I_CTX, I_CCTX, I_WADA, I_BADA, I_WIN, I_RDEC, I_RGN, I_QNORM, I_KVNORM, I_WUQ, I_WUKV, I_WO, I_LN1W, I_LN1B,
       I_RGW, I_RGB, I_REW, I_REB, I_EWG, I_EWU, I_EWD, I_LN2W, I_LN2B };

__device__ __forceinline__ void wdown_pool(const Args& a, LAS char* lds, int budget);
constexpr int GEMM_STAGE = 49152, GEMM_ROWS_OFF = LDS_ROWS;
struct GemmThread {
    int tid, lane, wid, wm, wn, r16, g;
    int a_st;
    int b_st;
    int ta[2];
    int tb[4][2];
    __device__ __forceinline__ void init(bool opaque = false) {
        tid = threadIdx.x; if (opaque) asm volatile("" : "+v"(tid));
        lane = tid & 63; wid = __builtin_amdgcn_readfirstlane(tid >> 6); wm = wid >> 1; wn = wid & 1; r16 = lane & 15; g = lane >> 4;
        a_st = a_off(tid >> 3, tid & 7);
        const int nq = tid & 31, kk = tid >> 5;
        b_st = off_b(kk, nq >> 1) + (nq & 1) * 8;
#pragma unroll
        for (int ks = 0; ks < 2; ++ks) ta[ks] = a_off(wm * 64 + r16, ks * 4 + g);
#pragma unroll
        for (int ni = 0; ni < 4; ++ni)
#pragma unroll
            for (int t = 0; t < 2; ++t) tb[ni][t] = tr_addr16(lane, wn * 4 + ni, 0, t);
    }
};

typedef _Float16 h16x2v __attribute__((ext_vector_type(2)));
__device__ __forceinline__ h16x8 fp8x8_to_h16(unsigned w0, unsigned w1) {
    const h16x2v a = __builtin_amdgcn_cvt_scalef32_pk_f16_fp8((int)w0, 1.0f, false), b = __builtin_amdgcn_cvt_scalef32_pk_f16_fp8((int)w0, 1.0f, true);
    const h16x2v c = __builtin_amdgcn_cvt_scalef32_pk_f16_fp8((int)w1, 1.0f, false), d = __builtin_amdgcn_cvt_scalef32_pk_f16_fp8((int)w1, 1.0f, true);
    h16x8 r; r[0] = a[0]; r[1] = a[1]; r[2] = b[0]; r[3] = b[1]; r[4] = c[0]; r[5] = c[1]; r[6] = d[0]; r[7] = d[1];
    return r;
}
__device__ __forceinline__ void gemm_tile(LAS char* lds, const GemmThread& G, const unsigned char* const (&arow)[2], const float* bcol, size_t ldb,
                                          int nk, f32x4 (&acc)[4][4]) {
#pragma unroll
    for (int i = 0; i < 4; ++i)
#pragma unroll
        for (int j = 0; j < 4; ++j) acc[i][j] = (f32x4){0.f, 0.f, 0.f, 0.f};
    u32x4 ar0[2], ar1[2]; f32x4 br0[4], br1[4];
    const int aq0 = a_off(G.tid >> 2, 2 * (G.tid & 3)), aq1 = a_off(G.tid >> 2, 2 * (G.tid & 3) + 1);
#define GT_LOAD(AR, BR, kt) do { _Pragma("unroll") for (int i = 0; i < 2; ++i) AR[i] = *(const u32x4*)(arow[i] + (size_t)(kt) * 64); \
        _Pragma("unroll") for (int i = 0; i < 4; ++i) BR[i] = *(const f32x4*)(bcol + (size_t)((kt) * 64 + 16 * i) * ldb); } while (0)
#define GT_STORE(AR, BR, buf) do { LAS char* Ab_ = lds + (buf) * GEMM_STAGE; _Pragma("unroll") for (int i = 0; i < 2; ++i) { \
        *(LAS h16x8*)(Ab_ + aq0 + i * 16384) = fp8x8_to_h16(AR[i][0], AR[i][1]); *(LAS h16x8*)(Ab_ + aq1 + i * 16384) = fp8x8_to_h16(AR[i][2], AR[i][3]); } \
        _Pragma("unroll") for (int i = 0; i < 4; ++i) *(LAS h16x4*)(Ab_ + 32768 + G.b_st + i * 4096) = cvt4(BR[i]); } while (0)
#define GT_COMP(buf) do { LAS char* Ab = lds + (buf) * GEMM_STAGE; LAS char* Bb = Ab + 32768; \
        _Pragma("unroll") for (int ks = 0; ks < 2; ++ks) { h16x8 bf[4], af[4]; \
            _Pragma("unroll") for (int ni = 0; ni < 4; ++ni) bf[ni] = cat8(trrd(Bb + G.tb[ni][0] + ks * 8192), trrd(Bb + G.tb[ni][1] + ks * 8192)); \
            _Pragma("unroll") for (int mi = 0; mi < 4; ++mi) af[mi] = *(LAS h16x8*)(Ab + G.ta[ks] + mi * 2048); \
            _Pragma("unroll") for (int mi = 0; mi < 4; ++mi) _Pragma("unroll") for (int ni = 0; ni < 4; ++ni) acc[mi][ni] = mfma16(bf[ni], af[mi], acc[mi][ni]); } } while (0)
    __syncthreads();
    GT_LOAD(ar0, br0, 0);
    GT_LOAD(ar1, br1, 1);
    GT_STORE(ar0, br0, 0);
    __syncthreads();
    int kt = 0;
    for (; kt + 2 < nk; kt += 2) {
        GT_LOAD(ar0, br0, kt + 2); __builtin_amdgcn_sched_barrier(0);
        GT_COMP(0); __builtin_amdgcn_sched_barrier(0);
        GT_STORE(ar1, br1, 1);
        __syncthreads();
        GT_LOAD(ar1, br1, kt + 3); __builtin_amdgcn_sched_barrier(0);
        GT_COMP(1); __builtin_amdgcn_sched_barrier(0);
        GT_STORE(ar0, br0, 0);
        __syncthreads();
    }
    GT_COMP(0);
    GT_STORE(ar1, br1, 1);
    __syncthreads();
    GT_COMP(1);
#undef GT_LOAD
#undef GT_STORE
#undef GT_COMP
}

typedef short s16x4 __attribute__((ext_vector_type(4)));
template <int OFF> __device__ __forceinline__ s16x4 asm_tr(int addr) { s16x4 r; asm volatile("ds_read_b64_tr_b16 %0, %1 offset:%2" : "=v"(r) : "v"(addr), "i"(OFF) : "memory"); return r; }
template <int OFF> __device__ __forceinline__ h16x8 asm_rd128(int addr) { h16x8 r; asm volatile("ds_read_b128 %0, %1 offset:%2" : "=v"(r) : "v"(addr), "i"(OFF) : "memory"); return r; }
#define LGKM0() do { asm volatile("s_waitcnt lgkmcnt(0)" ::: "memory"); __builtin_amdgcn_sched_barrier(0); } while (0)
__device__ __forceinline__ h16x8 cat8s(s16x4 a, s16x4 b) { return __builtin_bit_cast(h16x8, __builtin_shufflevector(a, b, 0, 1, 2, 3, 4, 5, 6, 7)); }
struct G3Stream { int gs; bool primed; };
template <bool RMS>
__device__ __forceinline__ void gemm_tile_g(LAS char* lds, const GemmThread& G, const h16* Ab, int lda, const h16* Bb, int ldb, int nk, f32x4 (&acc)[4][4],
                                            G3Stream& S, const h16* nAb, const h16* nBb) {
#pragma unroll
    for (int i = 0; i < 4; ++i)
#pragma unroll
        for (int j = 0; j < 4; ++j) acc[i][j] = (f32x4){0.f, 0.f, 0.f, 0.f};
    float ss[4] = {0.f, 0.f, 0.f, 0.f};
    const bool loader = G.wid < 4; const int wq = G.wid & 3;
    const size_t a_i = (size_t)64 * lda, a_h = (size_t)32 * lda, b_i = (size_t)32 * ldb, b_h = (size_t)16 * ldb, b_k = (size_t)64 * ldb;
    const size_t lane_a = (size_t)(8 * wq + (G.lane >> 3)) * lda + (((G.lane & 7) ^ (G.lane >> 3)) << 3);
    const size_t lane_b = (size_t)(4 * wq + (G.lane >> 4)) * ldb + (((G.lane & 15) ^ (((G.lane >> 4) << 2) | wq)) << 3);
    const bool has_next = (nAb != nullptr);
    const h16* asrc = Ab + lane_a; const h16* bsrc = Bb + lane_b;
    const h16* nasrc = (has_next ? nAb : Ab) + lane_a; const h16* nbsrc = (has_next ? nBb : Bb) + lane_b;
    LAS char* wbase = lds + wq * 1024;
    const int lbase = (int)(uintptr_t)lds;
#define G3_ISSUE_(AS, BS, kt, st) do { LAS char* sb_ = wbase + (st) * GEMM_STAGE; \
        _Pragma("unroll") for (int h = 0; h < 2; ++h) { \
        _Pragma("unroll") for (int i = 0; i < 4; ++i) __builtin_amdgcn_global_load_lds((const unsigned*)((AS) + i * a_i + h * a_h + (size_t)(kt) * 64), (LAS unsigned*)(sb_ + h * 4096 + i * 8192), 16, 0, 0); \
        _Pragma("unroll") for (int i = 0; i < 2; ++i) __builtin_amdgcn_global_load_lds((const unsigned*)((BS) + i * b_i + h * b_h + (size_t)(kt) * b_k), (LAS unsigned*)(sb_ + 32768 + h * 4096 + i * 8192), 16, 0, 0); } } while (0)
#define G3_ISSUE(kt, st) G3_ISSUE_(asrc, bsrc, kt, st)
#define G3_READ(BF, AF, KS) do { \
        BF[0] = cat8s(asm_tr<32768 + (KS) * 8192>(sbase + G.tb[0][0]), asm_tr<32768 + (KS) * 8192>(sbase + G.tb[0][1])); \
        BF[1] = cat8s(asm_tr<32768 + (KS) * 8192>(sbase + G.tb[1][0]), asm_tr<32768 + (KS) * 8192>(sbase + G.tb[1][1])); \
        BF[2] = cat8s(asm_tr<32768 + (KS) * 8192>(sbase + G.tb[2][0]), asm_tr<32768 + (KS) * 8192>(sbase + G.tb[2][1])); \
        BF[3] = cat8s(asm_tr<32768 + (KS) * 8192>(sbase + G.tb[3][0]), asm_tr<32768 + (KS) * 8192>(sbase + G.tb[3][1])); \
        AF[0] = asm_rd128<0>(sbase + G.ta[KS]); AF[1] = asm_rd128<2048>(sbase + G.ta[KS]); AF[2] = asm_rd128<4096>(sbase + G.ta[KS]); AF[3] = asm_rd128<6144>(sbase + G.ta[KS]); } while (0)
#define G3_MMA(BF, AF) do { _Pragma("unroll") for (int mi = 0; mi < 4; ++mi) _Pragma("unroll") for (int ni = 0; ni < 4; ++ni) acc[mi][ni] = mfma16(BF[ni], AF[mi], acc[mi][ni]); } while (0)
    int sc = S.gs, si = (S.gs == 0) ? 2 : S.gs - 1;
    if (!S.primed) {
        asm volatile("s_waitcnt vmcnt(0)" ::: "memory");
        __builtin_amdgcn_s_barrier();
        asm volatile("" ::: "memory");
        if (loader) { G3_ISSUE(0, sc); G3_ISSUE(1, (sc == 2) ? 0 : sc + 1); }
    }
    for (int kt = 0; kt < nk; ++kt) {
        if (loader) { if ((kt == 0 && S.primed) || !(kt + 1 < nk || has_next)) asm volatile("s_waitcnt vmcnt(0)" ::: "memory"); else asm volatile("s_waitcnt vmcnt(12)" ::: "memory"); }
        __builtin_amdgcn_s_barrier();
        asm volatile("" ::: "memory");
        if (loader) {
            if (kt + 2 < nk) G3_ISSUE(kt + 2, si);
            else if (has_next) G3_ISSUE_(nasrc, nbsrc, kt + 2 - nk, si);
        }
        const int sbase = lbase + sc * GEMM_STAGE;
        h16x8 bf0[4], af0[4], bf1[4], af1[4];
        G3_READ(bf0, af0, 0);
        if (RMS) {
            h16x8 hv[4];
            hv[0] = asm_rd128<0>(sbase + G.a_st); hv[1] = asm_rd128<8192>(sbase + G.a_st); hv[2] = asm_rd128<16384>(sbase + G.a_st); hv[3] = asm_rd128<24576>(sbase + G.a_st);
            LGKM0();
#pragma unroll
            for (int i = 0; i < 4; ++i)
#pragma unroll
                for (int e = 0; e < 8; ++e) { const float f = (float)hv[i][e]; ss[i] += f * f; }
        } else LGKM0();
        G3_READ(bf1, af1, 1);
        G3_MMA(bf0, af0);
        LGKM0();
        G3_MMA(bf1, af1);
        sc = (sc == 2) ? 0 : sc + 1; si = (si == 2) ? 0 : si + 1;
    }
#undef G3_ISSUE
#undef G3_ISSUE_
#undef G3_READ
#undef G3_MMA
    S.gs = sc; S.primed = has_next;
    if (RMS) {
        LAS float* rs = (LAS float*)(lds + GEMM_ROWS_OFF);
#pragma unroll
        for (int i = 0; i < 4; ++i) {
            float s = ss[i]; s += __shfl_xor(s, 1); s += __shfl_xor(s, 2); s += __shfl_xor(s, 4);
            if ((G.tid & 7) == 0) rs[(G.tid >> 3) + 64 * i] = __builtin_amdgcn_rsqf(s / (float)(nk * 64) + EPS);
        }
        asm volatile("s_waitcnt lgkmcnt(0)" ::: "memory");
        __builtin_amdgcn_s_barrier();
        asm volatile("" ::: "memory");
    }
}

constexpr int G2_STAGE = 65536;
struct GemmThread2 {
    int tid, lane, wid, wm, wn, r16, g;
    int ta[2];
    int tb[4][2];
    __device__ __forceinline__ void init() {
        tid = threadIdx.x; lane = tid & 63; wid = __builtin_amdgcn_readfirstlane(tid >> 6); wm = wid >> 2; wn = wid & 3; r16 = lane & 15; g = lane >> 4;
#pragma unroll
        for (int ks = 0; ks < 2; ++ks) ta[ks] = a_off(wm * 128 + r16, ks * 4 + g);
#pragma unroll
        for (int ni = 0; ni < 4; ++ni)
#pragma unroll
            for (int t = 0; t < 2; ++t) tb[ni][t] = 32768 + (wn >> 1) * 16384 + tr_addr16(lane, (wn & 1) * 4 + ni, 0, t);
    }
};
__device__ __forceinline__ void gemm_tile_g2(LAS char* lds, const GemmThread2& G, const h16* Ab, int lda, const h16* Bb, int ldb, int nk, f32x4 (&acc)[8][4]) {
#pragma unroll
    for (int i = 0; i < 8; ++i)
#pragma unroll
        for (int j = 0; j < 4; ++j) acc[i][j] = (f32x4){0.f, 0.f, 0.f, 0.f};
    const bool loader = G.wid < 4;
    const int wq = G.wid & 3;
    const unsigned aoff = (unsigned)(((8 * wq + (G.lane >> 3)) * lda + (((G.lane & 7) ^ (G.lane >> 3)) << 3)) * 2);
    const unsigned boff = (unsigned)(((4 * wq + (G.lane >> 4)) * ldb + (((G.lane & 15) ^ (((G.lane >> 4) << 2) | wq)) << 3)) * 2);
    const char* asrc = (const char*)Ab; const char* bsrc = (const char*)Bb;
    const size_t a_i = (size_t)128 * lda, a_h = (size_t)64 * lda, b_i = (size_t)64 * ldb, b_h = (size_t)32 * ldb, b_k = (size_t)128 * ldb;
    LAS char* wbase = lds + wq * 1024;
    const int lbase = (int)(uintptr_t)lds;
#define G2_ISSUE(kt, st) do { LAS char* sb_ = wbase + (st) * G2_STAGE; \
        _Pragma("unroll") for (int h = 0; h < 2; ++h) { \
        _Pragma("unroll") for (int i = 0; i < 4; ++i) __builtin_amdgcn_global_load_lds((const unsigned*)(asrc + (i * a_i + h * a_h + (size_t)(kt) * 128) + aoff), (LAS unsigned*)(sb_ + h * 4096 + i * 8192), 16, 0, 0); \
        _Pragma("unroll") for (int i = 0; i < 4; ++i) __builtin_amdgcn_global_load_lds((const unsigned*)(bsrc + ((i & 1) * b_i + (i >> 1) * 256 + h * b_h + (size_t)(kt) * b_k) + boff), (LAS unsigned*)(sb_ + 32768 + h * 4096 + (i >> 1) * 16384 + (i & 1) * 8192), 16, 0, 0); } } while (0)
#define G2_RB(BF, KS) do { \
        BF[0] = cat8s(asm_tr<(KS) * 8192>(sbase + G.tb[0][0]), asm_tr<(KS) * 8192>(sbase + G.tb[0][1])); \
        BF[1] = cat8s(asm_tr<(KS) * 8192>(sbase + G.tb[1][0]), asm_tr<(KS) * 8192>(sbase + G.tb[1][1])); \
        BF[2] = cat8s(asm_tr<(KS) * 8192>(sbase + G.tb[2][0]), asm_tr<(KS) * 8192>(sbase + G.tb[2][1])); \
        BF[3] = cat8s(asm_tr<(KS) * 8192>(sbase + G.tb[3][0]), asm_tr<(KS) * 8192>(sbase + G.tb[3][1])); } while (0)
#define G2_RA(AF, KS, H) do { AF[0] = asm_rd128<(H) * 8192>(sbase + G.ta[KS]); AF[1] = asm_rd128<(H) * 8192 + 2048>(sbase + G.ta[KS]); \
        AF[2] = asm_rd128<(H) * 8192 + 4096>(sbase + G.ta[KS]); AF[3] = asm_rd128<(H) * 8192 + 6144>(sbase + G.ta[KS]); } while (0)
#define G2_MMA(BF, AF, H) do { _Pragma("unroll") for (int mi = 0; mi < 4; ++mi) _Pragma("unroll") for (int ni = 0; ni < 4; ++ni) \
        acc[(H) * 4 + mi][ni] = mfma16(BF[ni], AF[mi], acc[(H) * 4 + mi][ni]); } while (0)
    asm volatile("s_waitcnt vmcnt(0)" ::: "memory");
    __builtin_amdgcn_s_barrier();
    asm volatile("" ::: "memory");
    if (loader) G2_ISSUE(0, 0);
    for (int kt = 0; kt < nk; ++kt) {
        if (loader) asm volatile("s_waitcnt vmcnt(0)" ::: "memory");
        __builtin_amdgcn_s_barrier();
        asm volatile("" ::: "memory");
        if (loader) { if (kt + 1 < nk) G2_ISSUE(kt + 1, (kt + 1) & 1); }
        const int sbase = lbase + (kt & 1) * G2_STAGE;
        h16x8 bf0[4], bf1[4], afx[4], afy[4];
        G2_RB(bf0, 0); G2_RA(afx, 0, 0);
        LGKM0();
        G2_RA(afy, 0, 1); G2_RB(bf1, 1);
        G2_MMA(bf0, afx, 0);
        LGKM0();
        G2_RA(afx, 1, 0);
        G2_MMA(bf0, afy, 1);
        LGKM0();
        G2_RA(afy, 1, 1);
        G2_MMA(bf1, afx, 0);
        LGKM0();
        G2_MMA(bf1, afy, 1);
    }
#undef G2_ISSUE
#undef G2_RB
#undef G2_RA
#undef G2_MMA
}

template <int OFF> __device__ __forceinline__ unsigned asm_rd32(int addr) { unsigned r; asm volatile("ds_read_b32 %0, %1 offset:%2" : "=v"(r) : "v"(addr), "i"(OFF) : "memory"); return r; }
template <int OFF> __device__ __forceinline__ u32x2 asm_rd64(int addr) { u32x2 r; asm volatile("ds_read_b64 %0, %1 offset:%2" : "=v"(r) : "v"(addr), "i"(OFF) : "memory"); return r; }
__device__ __forceinline__ void gemm_tile_g8(LAS char* lds, const GemmThread& G, const unsigned char* Ab, int lda, const h16* Bb, int ldb, int nk, f32x4 (&acc)[4][4],
                                             G3Stream& S, const unsigned char* nAb, const h16* nBb) {
#pragma unroll
    for (int i = 0; i < 4; ++i)
#pragma unroll
        for (int j = 0; j < 4; ++j) acc[i][j] = (f32x4){0.f, 0.f, 0.f, 0.f};
    const bool loader = G.wid < 4; const int wq = G.wid & 3;
    const size_t a_i = (size_t)128 * 64, b_i = (size_t)32 * ldb, b_h = (size_t)16 * ldb, b_k = (size_t)64 * ldb;
    const size_t lane_a = (size_t)(16 * wq + (G.lane >> 2)) * 64 + (((G.lane & 3) ^ ((G.lane >> 4) & 3)) << 4);
    const size_t lane_b = (size_t)(4 * wq + (G.lane >> 4)) * ldb + (((G.lane & 15) ^ (((G.lane >> 4) << 2) | wq)) << 3);
    const bool has_next = (nAb != nullptr);
    const unsigned char* asrc = Ab + lane_a; const h16* bsrc = Bb + lane_b;
    const unsigned char* nasrc = (has_next ? nAb : Ab) + lane_a; const h16* nbsrc = (has_next ? nBb : Bb) + lane_b;
    LAS char* wbase = lds + wq * 1024;
    const int lbase = (int)(uintptr_t)lds;
    int ta8[2];
    { const int x2 = 2 * ((G.r16 >> 2) & 3);
#pragma unroll
      for (int ks = 0; ks < 2; ++ks) ta8[ks] = (G.wm * 64 + G.r16) * 64 + (((4 * ks + G.g) ^ x2) << 3); }
#define G8_ISSUE_(AS, BS, kt, st) do { LAS char* sb_ = wbase + (st) * GEMM_STAGE; \
        _Pragma("unroll") for (int h = 0; h < 2; ++h) { \
        _Pragma("unroll") for (int i = 0; i < 2; ++i) __builtin_amdgcn_global_load_lds((const unsigned*)((AS) + i * a_i + h * 4096 + (size_t)(kt) * 16384), (LAS unsigned*)(sb_ + h * 4096 + i * 8192), 16, 0, 0); \
        _Pragma("unroll") for (int i = 0; i < 2; ++i) __builtin_amdgcn_global_load_lds((const unsigned*)((BS) + i * b_i + h * b_h + (size_t)(kt) * b_k), (LAS unsigned*)(sb_ + 32768 + h * 4096 + i * 8192), 16, 0, 0); } } while (0)
#define G8_ISSUE(kt, st) G8_ISSUE_(asrc, bsrc, kt, st)
#define G8_READ(BF, AR, KS) do { \
        BF[0] = cat8s(asm_tr<32768 + (KS) * 8192>(sbase + G.tb[0][0]), asm_tr<32768 + (KS) * 8192>(sbase + G.tb[0][1])); \
        BF[1] = cat8s(asm_tr<32768 + (KS) * 8192>(sbase + G.tb[1][0]), asm_tr<32768 + (KS) * 8192>(sbase + G.tb[1][1])); \
        BF[2] = cat8s(asm_tr<32768 + (KS) * 8192>(sbase + G.tb[2][0]), asm_tr<32768 + (KS) * 8192>(sbase + G.tb[2][1])); \
        BF[3] = cat8s(asm_tr<32768 + (KS) * 8192>(sbase + G.tb[3][0]), asm_tr<32768 + (KS) * 8192>(sbase + G.tb[3][1])); \
        AR[0] = asm_rd64<0>(sbase + ta8[KS]); AR[1] = asm_rd64<1024>(sbase + ta8[KS]); AR[2] = asm_rd64<2048>(sbase + ta8[KS]); AR[3] = asm_rd64<3072>(sbase + ta8[KS]); } while (0)
#define G8_MMA(BF, AR) do { h16x8 af_[4]; _Pragma("unroll") for (int mi = 0; mi < 4; ++mi) af_[mi] = fp8x8_to_h16(AR[mi][0], AR[mi][1]); \
        _Pragma("unroll") for (int mi = 0; mi < 4; ++mi) _Pragma("unroll") for (int ni = 0; ni < 4; ++ni) acc[mi][ni] = mfma16(BF[ni], af_[mi], acc[mi][ni]); } while (0)
    int sc = S.gs, si = (S.gs == 0) ? 2 : S.gs - 1;
    if (!S.primed) {
        asm volatile("s_waitcnt vmcnt(0)" ::: "memory");
        __builtin_amdgcn_s_barrier();
        asm volatile("" ::: "memory");
        if (loader) { G8_ISSUE(0, sc); G8_ISSUE(1, (sc == 2) ? 0 : sc + 1); }
    }
    for (int kt = 0; kt < nk; ++kt) {
        if (loader) { if ((kt == 0 && S.primed) || !(kt + 1 < nk || has_next)) asm volatile("s_waitcnt vmcnt(0)" ::: "memory"); else asm volatile("s_waitcnt vmcnt(8)" ::: "memory"); }
        __builtin_amdgcn_s_barrier();
        asm volatile("" ::: "memory");
        if (loader) {
            if (kt + 2 < nk) G8_ISSUE(kt + 2, si);
            else if (has_next) G8_ISSUE_(nasrc, nbsrc, kt + 2 - nk, si);
        }
        const int sbase = lbase + sc * GEMM_STAGE;
        h16x8 bf0[4], bf1[4]; u32x2 ar0[4], ar1[4];
        G8_READ(bf0, ar0, 0);
        LGKM0();
        G8_READ(bf1, ar1, 1);
        G8_MMA(bf0, ar0);
        LGKM0();
        G8_MMA(bf1, ar1);
        sc = (sc == 2) ? 0 : sc + 1; si = (si == 2) ? 0 : si + 1;
    }
#undef G8_ISSUE
#undef G8_ISSUE_
#undef G8_READ
#undef G8_MMA
    S.gs = sc; S.primed = has_next;
}

__device__ __forceinline__ void cvt_weight(const float* W, const float* rowscale, h16* O, int K, int N, int NP, int gtid, int gthreads) {
    const int cpr = NP >> 3;
    for (int idx = gtid; idx < K * cpr; idx += gthreads) {
        const int k = idx / cpr, c = (idx - k * cpr) << 3;
        h16x8 o;
        if (c < N) {
            f32x4 v0 = *(const f32x4*)(W + (size_t)k * N + c), v1 = *(const f32x4*)(W + (size_t)k * N + c + 4);
            if (rowscale) { const float r = rowscale[k]; v0 = v0 * r; v1 = v1 * r; }
#pragma unroll
            for (int e = 0; e < 4; ++e) { o[e] = (h16)v0[e]; o[4 + e] = (h16)v1[e]; }
        } else {
#pragma unroll
            for (int e = 0; e < 8; ++e) o[e] = (h16)0.f;
        }
        *(h16x8*)(O + (size_t)k * NP + c) = o;
    }
}
__device__ __forceinline__ void phase_cvt(const Args& a) {
    const int gtid = blockIdx.x * NTHREADS + threadIdx.x, gth = gridDim.x * NTHREADS;
    cvt_weight(a.in[I_WIN], nullptr, (h16*)(a.ws + WS_WIN16), DM, INW, WINP, gtid, gth);
    cvt_weight(a.in[I_WO], nullptr, (h16*)(a.ws + WS_WO16), DM, DM, DM, gtid, gth);
    cvt_weight(a.in[I_WUQ], a.in[I_QNORM], (h16*)(a.ws + WS_WUQ16), 512, 1536, 1536, gtid, gth);
    cvt_weight(a.in[I_WUKV], a.in[I_KVNORM], (h16*)(a.ws + WS_WUKV16), 256, 2048, 2048, gtid, gth);
    h16* WRH = (h16*)(a.ws + WS_WRH); h16* WRL = (h16*)(a.ws + WS_WRL);
    for (int idx = gtid; idx < 48 * DM; idx += gth) {
        const int n = idx / DM, k = idx - n * DM;
        float w = 0.f;
        if (n < 4) w = a.in[I_RGW][k * 4 + n];
        else if (n < 36) w = a.in[I_REW][(size_t)((n - 4) >> 3) * DM * 8 + (size_t)k * 8 + ((n - 4) & 7)];
        w *= 1024.f;
        const h16 hi = (h16)w; const h16 lo = (h16)(w - (float)hi);
        WRH[idx] = hi; WRL[idx] = lo;
    }
}

__device__ __forceinline__ void adaln_init(const Args& a, LAS char* lds) {
    LAS float* sact = (LAS float*)lds;
    const float* c = a.in[I_C]; const float* cc = a.in[I_CCTX];
    for (int i = threadIdx.x; i < 5 * DM; i += NTHREADS) { const float v = (i < 4 * DM) ? c[i] : cc[i - 4 * DM]; sact[i] = silu_f(v); }
    __syncthreads();
}
__device__ __forceinline__ void adaln_unit(const Args& a, LAS char* lds, int nc, int kc, bool wt) {
    const int tid = threadIdx.x;
    LAS float* sact = (LAS float*)lds;
    LAS f32x4* red = (LAS f32x4*)(lds + 40960);
    const float* W = a.in[I_WADA];
    float* PART = (float*)(a.ws + WS_PART);
    const int col4 = tid & 31, ksub = tid >> 5;
    const int k0 = kc * 256 + ksub * 16;
    const float* wp = W + (size_t)k0 * ADAW + nc * 128 + col4 * 4;
    f32x4 acc[5];
#pragma unroll
    for (int r = 0; r < 5; ++r) acc[r] = (f32x4){0.f, 0.f, 0.f, 0.f};
#pragma unroll 8
    for (int kk = 0; kk < 16; ++kk) {
        const f32x4 w = *(const f32x4*)(wp + (size_t)kk * ADAW);
#pragma unroll
        for (int r = 0; r < 5; ++r) acc[r] += w * sact[r * DM + k0 + kk];
    }
#pragma unroll
    for (int r = 0; r < 5; ++r) red[(ksub * 5 + r) * 32 + col4] = acc[r];
    __syncthreads();
    if (tid < 160) {
        const int r = tid >> 5, c4 = tid & 31;
        f32x4 s = (f32x4){0.f, 0.f, 0.f, 0.f};
#pragma unroll
        for (int j = 0; j < 16; ++j) s += red[(j * 5 + r) * 32 + c4];
        float* dst = PART + ((size_t)kc * 5 + r) * ADAW + nc * 128 + c4 * 4;
        if (wt) { const u32x4 sv = __builtin_bit_cast(u32x4, s); asm volatile("global_store_dwordx4 %0, %1, off sc1\n\ts_nop 1" :: "v"(dst), "v"(sv) : "memory"); }
        else *(f32x4*)dst = s;
    }
    asm volatile("s_waitcnt vmcnt(0)" ::: "memory");
    __syncthreads();
}
__device__ __forceinline__ void phase_adaln(const Args& a, LAS char* lds) {
    adaln_init(a, lds);
    for (int u = blockIdx.x; u < 768; u += gridDim.x) adaln_unit(a, lds, u % 96, u / 96, false);
}

__device__ __forceinline__ float mod_sum(const float* PART, const float* bada, int r, int n) {
    float s = bada[n];
#pragma unroll
    for (int kc = 0; kc < 8; ++kc) s += PART[((size_t)kc * 5 + r) * ADAW + n];
    return s;
}
__device__ __forceinline__ void mod_finalize(const Args& a) {
    const float* PART = (const float*)(a.ws + WS_PART); const float* bada = a.in[I_BADA];
    float* MOD = (float*)(a.ws + WS_MOD);
    for (int idx = blockIdx.x * NTHREADS + threadIdx.x; idx < 5 * ADAW; idx += gridDim.x * NTHREADS) MOD[idx] = mod_sum(PART, bada, idx / ADAW, idx % ADAW);
}
__device__ __forceinline__ void phase_modulate(const Args& a, LAS char* lds) {
    const int tid = threadIdx.x, lane = tid & 63, wid = tid >> 6;
    const float* PART = (const float*)(a.ws + WS_PART); const float* bada = a.in[I_BADA];
    const int per = (TA + gridDim.x - 1) / gridDim.x;
    const int r0 = blockIdx.x * per, r1 = (r0 + per < TA) ? r0 + per : TA;
    if (r0 >= r1) return;
    const int mrA = (r0 < T) ? r0 / SEQ : 4, mrB = (r1 - 1 < T) ? (r1 - 1) / SEQ : 4;
    LAS float* smod = (LAS float*)(lds + 65536);
    for (int i4 = tid; i4 < 2 * 2 * DM / 4; i4 += NTHREADS) {
        const int i = i4 * 4, slot = i / (2 * DM), n = i % (2 * DM);
        const int r = slot ? mrB : mrA;
        f32x4 sacc = *(const f32x4*)(bada + n);
#pragma unroll
        for (int kc = 0; kc < 8; ++kc) sacc += *(const f32x4*)(PART + ((size_t)kc * 5 + r) * ADAW + n);
        *(LAS f32x4*)(smod + i) = sacc;
    }
    __syncthreads();
    h16* A1 = (h16*)(a.ws + WS_A1);
    for (int row = r0 + wid; row < r1; row += 8) {
        const float* xr = (row < T) ? a.in[I_X] + (size_t)row * DM : a.in[I_CTX] + (size_t)(row - T) * DM;
        const int mr = (row < T) ? row / SEQ : 4;
        LAS float* sm = smod + ((mr == mrA) ? 0 : 2 * DM);
        f32x4 v[8]; float s = 0.f;
#pragma unroll
        for (int j = 0; j < 8; ++j) { v[j] = *(const f32x4*)(xr + j * 256 + lane * 4); s += (v[j][0] + v[j][1]) + (v[j][2] + v[j][3]); }
        const float mean = wave_sum(s) * (1.f / DM); float q = 0.f;
#pragma unroll
        for (int j = 0; j < 8; ++j) { v[j] = v[j] - mean; q += (v[j][0] * v[j][0] + v[j][1] * v[j][1]) + (v[j][2] * v[j][2] + v[j][3] * v[j][3]); }
        const float rstd = 1.f / sqrtf(wave_sum(q) * (1.f / DM) + EPS);
#pragma unroll
        for (int j = 0; j < 8; ++j) {
            const int k = j * 256 + lane * 4;
            const f32x4 sh = *(LAS f32x4*)(sm + k), sc = *(LAS f32x4*)(sm + DM + k);
            const f32x4 y = v[j] * rstd * (sc + 1.f) + sh;
            *(h16x4*)(A1 + (size_t)row * DM + k) = cvt4(y);
        }
    }
}

__device__ __forceinline__ void acc_rows16(const f32x4 (&c)[4], float w, u32x4 (&v)[2]) {
    u32x2 x[4];
#pragma unroll
    for (int ni = 0; ni < 4; ++ni) x[ni] = __builtin_bit_cast(u32x2, cvt4(c[ni] * w));
#pragma unroll
    for (int n1 = 0; n1 < 2; ++n1) {
#pragma unroll
        for (int d = 0; d < 2; ++d) {
            auto p = __builtin_amdgcn_permlane32_swap(x[2 * n1][d], x[2 * n1 + 1][d], false, false);
            auto q = __builtin_amdgcn_permlane16_swap(p[0], p[1], false, false);
            x[2 * n1][d] = q[0]; x[2 * n1 + 1][d] = q[1];
        }
        v[n1] = (u32x4){x[2 * n1][0], x[2 * n1][1], x[2 * n1 + 1][0], x[2 * n1 + 1][1]};
    }
}
__device__ __forceinline__ void st_rows16(h16* rowp, const f32x4 (&c)[4], float w, int g) {
    u32x4 v[2];
    acc_rows16(c, w, v);
    *(u32x4*)(rowp + 8 * g) = v[0]; *(u32x4*)(rowp + 8 * g + 32) = v[1];
}
__device__ __forceinline__ void st16_wt(void* p, u32x4 v) { asm volatile("global_store_dwordx4 %0, %1, off sc1\n\ts_nop 1" :: "v"(p), "v"(v) : "memory"); }
__device__ __forceinline__ void st_rows16_wt(h16* rowp, const f32x4 (&c)[4], float w, int g) {
    u32x4 v[2];
    acc_rows16(c, w, v);
    st16_wt(rowp + 8 * g, v[0]); st16_wt(rowp + 8 * g + 32, v[1]);
}
__device__ __forceinline__ void st4(h16* p, f32x4 v) { *(h16x4*)p = cvt4(v); }
__device__ __forceinline__ void rope4(f32x4 x1, f32x4 x2, float pos, int i0, float step, float sc, f32x4& o1, f32x4& o2) {
#pragma unroll
    for (int r = 0; r < 4; ++r) {
        const float invf = exp2f(-(float)(i0 + r) * step);
        const float ang = pos * invf;
        const float s = __sinf(ang), c = __cosf(ang);
        o1[r] = (x1[r] * c - x2[r] * s) * sc; o2[r] = (x1[r] * s + x2[r] * c) * sc;
    }
}
template <int NM>
__device__ __forceinline__ void inproj_epi(const Args& a, const f32x4 (&acc)[NM][4], bool lat, int b, int m0, int l0, int nt, int wn, int g) {
    h16* QR = (h16*)(a.ws + WS_QR); h16* KR = (h16*)(a.ws + WS_KR); h16* VR = (h16*)(a.ws + WS_VR);
    h16* KC = (h16*)(a.ws + WS_KC); h16* VC = (h16*)(a.ws + WS_VC); h16* GS = (h16*)(a.ws + WS_GS);
    h16* CQ = (h16*)(a.ws + WS_CQ); h16* CKV = (h16*)(a.ws + WS_CKV); h16* KPE = (h16*)(a.ws + WS_KPE);
    const int cw = wn * 64;
    if (nt < 16) {
        const int h = nt & 7; const bool isq = nt < 8;
        h16* dst = isq ? QR : (lat ? KR : KC);
        const float sc = isq ? 1.f : KSCALE;
#pragma unroll
        for (int mi = 0; mi < NM; ++mi) {
            const int l = l0 + mi * 16;
            const size_t ro = lat ? ((size_t)(b * 8 + h) * SEQ + l) * 128 : ((size_t)(b * 8 + h) * LC + l) * 128;
            const float pos = (wn == 0) ? (float)(l >> 6) : (float)(l & 63);
            f32x4 c[4];
#pragma unroll
            for (int ni = 0; ni < 2; ++ni) {
                if (lat) rope4(acc[mi][ni], acc[mi][ni + 2], pos, ni * 16 + 4 * g, L2_10000 / 32.f, sc, c[ni], c[ni + 2]);
                else { c[ni] = acc[mi][ni] * sc; c[ni + 2] = acc[mi][ni + 2] * sc; }
            }
            st_rows16(dst + ro + cw, c, 1.f, g);
        }
    } else if (nt < 24) {
        const int h = nt - 16; h16* dst = lat ? VR : VC;
#pragma unroll
        for (int mi = 0; mi < NM; ++mi) {
            const int l = l0 + mi * 16;
            const size_t ro = lat ? ((size_t)(b * 8 + h) * SEQ + l) * 128 : ((size_t)(b * 8 + h) * LC + l) * 128;
            st_rows16(dst + ro + cw, acc[mi], 1.f, g);
        }
    } else if (nt < 32) {
#pragma unroll
        for (int mi = 0; mi < NM; ++mi) {
            f32x4 c[4];
#pragma unroll
            for (int ni = 0; ni < 4; ++ni)
#pragma unroll
                for (int r = 0; r < 4; ++r) c[ni][r] = silu_f(acc[mi][ni][r]);
            st_rows16(GS + (size_t)(m0 + mi * 16) * 1024 + (nt - 24) * 128 + cw, c, 1.f, g);
        }
    } else if (nt < 36) {
#pragma unroll
        for (int mi = 0; mi < NM; ++mi) st_rows16(CQ + (size_t)(m0 + mi * 16) * 512 + (nt - 32) * 128 + cw, acc[mi], 1.f, g);
    } else if (nt < 38) {
#pragma unroll
        for (int mi = 0; mi < NM; ++mi) {
            const int key = (lat ? LC : 0) + l0 + mi * 16;
            st_rows16(CKV + ((size_t)b * LK + key) * 256 + (nt - 36) * 128 + cw, acc[mi], 1.f, g);
        }
    } else if (nt == 38 && wn == 0) {
#pragma unroll
        for (int mi = 0; mi < NM; ++mi) {
            const int l = l0 + mi * 16, key = (lat ? LC : 0) + l;
            f32x4 c[4];
#pragma unroll
            for (int hf = 0; hf < 2; ++hf) {
                const float pos = hf ? (float)(l & 63) : (float)(l >> 6);
                if (lat) rope4(acc[mi][2 * hf], acc[mi][2 * hf + 1], pos, 4 * g, L2_10000 / 16.f, 1.f, c[2 * hf], c[2 * hf + 1]);
                else { c[2 * hf] = acc[mi][2 * hf]; c[2 * hf + 1] = acc[mi][2 * hf + 1]; }
            }
            st_rows16(KPE + ((size_t)b * LK + key) * 64, c, 1.f, g);
        }
    }
}
__device__ __forceinline__ void inproj_unit(int list, int p, int& mt, int& nt) {
    if (list == 0) {
        if (p < 352) { const int mg = p / 44, rem = p - mg * 44, ti = rem >> 2; mt = mg * 4 + (rem & 3); nt = (ti < 8) ? 4 + ti : 8 + ti; }
        else if (p < 388) { const int q = p - 352, ti = q >> 2; mt = 32 + (q & 3); nt = (ti < 8) ? 4 + ti : 18; }
        else { const int q = p - 388; mt = q >> 2; nt = q & 3; }
    } else {
        if (p < 4) { mt = 31; nt = p; }
        else if (p < 132) { const int q = p - 4; mt = q >> 2; nt = 12 + (q & 3); }
        else if (p < 164) { mt = p - 132; nt = 19; }
        else { mt = 32 + (p - 164); nt = 19; }
    }
}
constexpr int INPROJ_NU0 = 512, INPROJ_NU1 = 168;
__device__ __forceinline__ void phase_inproj(const Args& a, LAS char* lds, int vcu, int list) {
    GemmThread2 G; G.init();
    const h16* A1 = (const h16*)(a.ws + WS_A1); const h16* W16 = (const h16*)(a.ws + WS_WIN16);
    const int NU = list ? INPROJ_NU1 : INPROJ_NU0;
    for (int p = vcu; p < NU; p += gridDim.x) {
        int mt, nt;
        inproj_unit(list, p, mt, nt);
        f32x4 acc[8][4];
        gemm_tile_g2(lds, G, A1 + (size_t)mt * 256 * DM, DM, W16 + nt * 256, WINP, DM / 64, acc);
        const bool lat = mt < 32;
        const int b = lat ? (mt >> 3) : (mt - 32);
        int r16l = G.r16, gl = G.g;
        asm volatile("" : "+v"(r16l), "+v"(gl));
        const int m0 = mt * 256 + G.wm * 128 + r16l;
        const int l0 = lat ? (m0 & (SEQ - 1)) : (m0 - T - b * LC);
        const int cb = nt * 4 + G.wn;
        inproj_epi<8>(a, acc, lat, b, m0, l0, cb >> 1, cb & 1, gl);
    }
    if (list == 0) {
        const int rounds = (NU + (int)gridDim.x - 1) / (int)gridDim.x, mine = (vcu < NU) ? (NU - vcu + (int)gridDim.x - 1) / (int)gridDim.x : 0;
        if (mine < rounds) wdown_pool(a, lds, 8 * (rounds - mine));
    }
}

__device__ __forceinline__ void qup_unit(const Args& a, LAS char* lds, G3Stream& S, int p, int pn) {
    GemmThread G; G.init(true);
    const h16* CQ = (const h16*)(a.ws + WS_CQ); h16* Q = (h16*)(a.ws + WS_Q);
    LAS float* rs = (LAS float*)(lds + GEMM_ROWS_OFF);
    const int mt = p / 12, nt = p % 12;
    const bool hn = pn >= 0;
    f32x4 acc[4][4];
    gemm_tile_g<true>(lds, G, CQ + (size_t)mt * 256 * 512, 512, (const h16*)(a.ws + WS_WUQ16) + nt * 128, 1536, 512 / 64, acc, S,
                      hn ? CQ + (size_t)(pn / 12) * 256 * 512 : nullptr, hn ? (const h16*)(a.ws + WS_WUQ16) + (pn % 12) * 128 : nullptr);
    const int c0 = nt * 128 + G.wn * 64, head = c0 / 192, d0 = c0 % 192;
#pragma unroll
    for (int mi = 0; mi < 4; ++mi) {
        const int ml = G.wm * 64 + mi * 16 + G.r16, m = mt * 256 + ml;
        const float r = rs[ml];
        const int b = m >> 11, l = m & (SEQ - 1);
        h16* dst = Q + ((size_t)(b * 8 + head) * SEQ + l) * 192 + d0;
        if (d0 < 128) st_rows16(dst, acc[mi], r, G.g);
        else {
            f32x4 c[4];
#pragma unroll
            for (int hf = 0; hf < 2; ++hf) {
                const float pos = hf ? (float)(l & 63) : (float)(l >> 6);
                rope4(acc[mi][2 * hf], acc[mi][2 * hf + 1], pos, 4 * G.g, L2_10000 / 16.f, r, c[2 * hf], c[2 * hf + 1]);
            }
            st_rows16(dst, c, 1.f, G.g);
        }
    }
}
__device__ __forceinline__ void kvup_unit(const Args& a, LAS char* lds, G3Stream& S, int p, int pn) {
    GemmThread G; G.init(true);
    const h16* CKV = (const h16*)(a.ws + WS_CKV); h16* KN = (h16*)(a.ws + WS_KN); h16* VV = (h16*)(a.ws + WS_VV);
    LAS float* rs = (LAS float*)(lds + GEMM_ROWS_OFF);
    const int mt = p >> 4, nt = p & 15;
    const bool hn = pn >= 0;
    f32x4 acc[4][4];
    gemm_tile_g<true>(lds, G, CKV + (size_t)mt * 256 * 256, 256, (const h16*)(a.ws + WS_WUKV16) + nt * 128, 2048, 256 / 64, acc, S,
                      hn ? CKV + (size_t)(pn >> 4) * 256 * 256 : nullptr, hn ? (const h16*)(a.ws + WS_WUKV16) + (pn & 15) * 128 : nullptr);
    const int head = nt >> 1; h16* base = (nt & 1) ? VV : KN;
#pragma unroll
    for (int mi = 0; mi < 4; ++mi) {
        const int ml = G.wm * 64 + mi * 16 + G.r16, m = mt * 256 + ml;
        const float r = rs[ml];
        const int b = m / LK, key = m % LK;
        st_rows16(base + ((size_t)(b * 8 + head) * LK + key) * 128 + G.wn * 64, acc[mi], r, G.g);
    }
}

__device__ __forceinline__ float log2_gamma(const float* rdec, int dir, int h) {
    const float x = rdec[dir * 8 + h];
    return -log1pf(__expf(-x)) * 1.4426950408889634f;
}

__device__ __forceinline__ void ret_state_item(const Args& a, LAS char* lds, int it) {
    int tid = threadIdx.x; asm volatile("" : "+v"(tid));
    const int lane = tid & 63, wid = __builtin_amdgcn_readfirstlane(tid >> 6), r16 = lane & 15, g = lane >> 4;
    const h16* KR = (const h16*)(a.ws + WS_KR); const h16* VR = (const h16*)(a.ws + WS_VR);
    const h16* KC = (const h16*)(a.ws + WS_KC); const h16* VC = (const h16*)(a.ws + WS_VC);
    h16* UF = (h16*)(a.ws + WS_UF); h16* UB = (h16*)(a.ws + WS_UB); h16* S0F = (h16*)(a.ws + WS_S0F); h16* S0B = (h16*)(a.ws + WS_S0B);
    LAS char* Kf = lds; LAS char* Kb = lds + 32768; LAS char* Vi = lds + 65536;
    __syncthreads();
    {
        const int bh = it / 17, c = it % 17, h = bh & 7;
        const float lgf = log2_gamma(a.in[I_RDEC], 0, h), lgb = log2_gamma(a.in[I_RDEC], 1, h);
        const bool isctx = (c == 16);
        const int J = isctx ? 256 : 128;
        const h16* Kp = isctx ? KC + (size_t)bh * LC * 128 : KR + ((size_t)bh * SEQ + c * 128) * 128;
        const h16* Vp = isctx ? VC + (size_t)bh * LC * 128 : VR + ((size_t)bh * SEQ + c * 128) * 128;
        f32x4 accf[8], accb[8];
#pragma unroll
        for (int i = 0; i < 8; ++i) { accf[i] = (f32x4){0.f, 0.f, 0.f, 0.f}; accb[i] = (f32x4){0.f, 0.f, 0.f, 0.f}; }
        for (int sub = 0; sub < J / 128; ++sub) {
            if (sub) __syncthreads();
            h16x8 kvl[4], vvl[4];
#pragma unroll
            for (int i = 0; i < 4; ++i) {
                const int j = sub * 128 + (tid >> 4) + 32 * i;
                kvl[i] = *(const h16x8*)(Kp + (size_t)j * 128 + (tid & 15) * 8); vvl[i] = *(const h16x8*)(Vp + (size_t)j * 128 + (tid & 15) * 8);
            }
            __builtin_amdgcn_sched_barrier(0);
#pragma unroll
            for (int i = 0; i < 4; ++i) {
                const int row = (tid >> 4) + 32 * i, ch = tid & 15, j = sub * 128 + row;
                const h16x8 kv = kvl[i];
                const h16x8 vv = vvl[i];
                const float zf = exp2f(lgf * (float)(J - 1 - j)), zb = exp2f(lgb * (float)j);
                h16x8 kf, kb;
#pragma unroll
                for (int e = 0; e < 8; ++e) { const float f = (float)kv[e]; kf[e] = (h16)(f * zf); kb[e] = (h16)(f * zb); }
                const int o = off_b(row, ch);
                *(LAS h16x8*)(Kf + o) = kf; *(LAS h16x8*)(Kb + o) = kb; *(LAS h16x8*)(Vi + o) = vv;
            }
            __syncthreads();
#pragma unroll
            for (int ks = 0; ks < 4; ++ks) {
                const int o0 = tr_addr16(lane, wid, ks, 0), o1 = tr_addr16(lane, wid, ks, 1);
                const h16x8 af = cat8(trrd(Kf + o0), trrd(Kf + o1)), ab = cat8(trrd(Kb + o0), trrd(Kb + o1));
#pragma unroll
                for (int cb = 0; cb < 8; ++cb) {
                    const h16x8 bv = cat8(trrd(Vi + tr_addr16(lane, cb, ks, 0)), trrd(Vi + tr_addr16(lane, cb, ks, 1)));
                    accf[cb] = mfma16(bv, af, accf[cb]); accb[cb] = mfma16(bv, ab, accb[cb]);
                }
            }
        }
        h16* of = isctx ? S0F + (size_t)bh * 16384 : UF + ((size_t)bh * 16 + c) * 16384;
        h16* ob = isctx ? S0B + (size_t)bh * 16384 : UB + ((size_t)bh * 16 + c) * 16384;
        {
            const int d = wid * 16 + r16;
#pragma unroll
            for (int grp = 0; grp < 2; ++grp) {
                f32x4 cf[4], cbk[4];
#pragma unroll
                for (int ni = 0; ni < 4; ++ni) { cf[ni] = accf[4 * grp + ni]; cbk[ni] = accb[4 * grp + ni]; }
                st_rows16_wt(of + d * 128 + grp * 64, cf, 1.f, g); st_rows16_wt(ob + d * 128 + grp * 64, cbk, 1.f, g);
            }
        }
        asm volatile("s_waitcnt vmcnt(0)" ::: "memory");
        __syncthreads();
        if (tid == 0) (void)xb_add((unsigned*)(a.ws + WS_CTL) + CW_SCAN + bh, 1u);
    }
}

constexpr int N_ITEMS = 384 + 544 + 576;
__device__ __forceinline__ void phase_ret_scan(const Args& a);
__device__ __forceinline__ void phase_mid(const Args& a, LAS char* lds, int vcu) {
    phase_inproj(a, lds, vcu, 1);
    const int Gn = (int)gridDim.x;
    const bool bal = (Gn == 256);
    const int cyc = bal ? 432 : Gn, nseq = (bal && vcu >= INPROJ_NU1) ? 3 : 1;
    G3Stream S; S.gs = 0; S.primed = false;
    int j = 0, t = 0;
    for (;;) {
        const int i = vcu + 88 * t + cyc * j;
        if (i >= N_ITEMS) break;
        int t2 = t + 1, j2 = j; if (t2 == nseq) { t2 = 0; ++j2; }
        const int inext = vcu + 88 * t2 + cyc * j2;
        if (i < 384) qup_unit(a, lds, S, i, (inext < 384) ? inext : -1);
        else if (i < 928) ret_state_item(a, lds, i - 384);
        else kvup_unit(a, lds, S, i - 928, (inext < N_ITEMS) ? inext - 928 : -1);
        t = t2; j = j2;
    }
    for (int sl = vcu; sl < 256; sl += Gn) {
        const int bh = sl >> 3, h = bh & 7;
        if (threadIdx.x == 0) {
            unsigned* SC = (unsigned*)(a.ws + WS_CTL) + CW_SCAN; unsigned* bar = (unsigned*)(a.ws + WS_CTL) + CW_BAR;
            XB_SPIN(xb_ld(&SC[bh]) < 17u, bar);
            __builtin_amdgcn_fence(__ATOMIC_ACQUIRE, "agent");
            asm volatile("s_waitcnt vmcnt(0)" ::: "memory");
        }
        __syncthreads();
        const h16* UF = (const h16*)(a.ws + WS_UF); const h16* UB = (const h16*)(a.ws + WS_UB);
        const h16* S0F = (const h16*)(a.ws + WS_S0F); const h16* S0B = (const h16*)(a.ws + WS_S0B);
        h16* SF = (h16*)(a.ws + WS_SF); h16* SB = (h16*)(a.ws + WS_SB);
        const int el = (sl & 7) * 2048 + (int)threadIdx.x * 4, idx = bh * 16384 + el;
        const float gf = exp2f(128.f * log2_gamma(a.in[I_RDEC], 0, h)), gb = exp2f(128.f * log2_gamma(a.in[I_RDEC], 1, h));
        h16x4 u[16];
        {
#pragma unroll
            for (int c = 0; c < 16; ++c) u[c] = *(const h16x4*)(UF + ((size_t)bh * 16 + c) * 16384 + el);
            const h16x4 s0 = *(const h16x4*)(S0F + idx);
            f32x4 sf;
#pragma unroll
            for (int e = 0; e < 4; ++e) sf[e] = (float)s0[e];
#pragma unroll
            for (int c = 0; c < 16; ++c) {
                *(h16x4*)(SF + ((size_t)bh * 16 + c) * 16384 + el) = cvt4(sf);
#pragma unroll
                for (int e = 0; e < 4; ++e) sf[e] = gf * sf[e] + (float)u[c][e];
            }
        }
        {
#pragma unroll
            for (int c = 0; c < 16; ++c) u[c] = *(const h16x4*)(UB + ((size_t)bh * 16 + c) * 16384 + el);
            const h16x4 s0 = *(const h16x4*)(S0B + idx);
            f32x4 sb;
#pragma unroll
            for (int e = 0; e < 4; ++e) sb[e] = (float)s0[e];
#pragma unroll
            for (int c = 15; c >= 0; --c) {
                *(h16x4*)(SB + ((size_t)bh * 16 + c) * 16384 + el) = cvt4(sb);
#pragma unroll
                for (int e = 0; e < 4; ++e) sb[e] = gb * sb[e] + (float)u[c][e];
            }
        }
    }
}

__device__ __forceinline__ void phase_ret_scan(const Args& a) {
    const h16* UF = (const h16*)(a.ws + WS_UF); const h16* UB = (const h16*)(a.ws + WS_UB);
    const h16* S0F = (const h16*)(a.ws + WS_S0F); const h16* S0B = (const h16*)(a.ws + WS_S0B);
    h16* SF = (h16*)(a.ws + WS_SF); h16* SB = (h16*)(a.ws + WS_SB);
    for (int idx = blockIdx.x * NTHREADS + threadIdx.x; idx < 32 * 16384; idx += gridDim.x * NTHREADS) {
        const int bh = idx >> 14, el = idx & 16383, h = bh & 7;
        const float gf = exp2f(128.f * log2_gamma(a.in[I_RDEC], 0, h)), gb = exp2f(128.f * log2_gamma(a.in[I_RDEC], 1, h));
        float sf = (float)S0F[idx], sb = (float)S0B[idx];
        for (int c = 0; c < 16; ++c) {
            SF[((size_t)bh * 16 + c) * 16384 + el] = (h16)sf;
            sf = gf * sf + (float)UF[((size_t)bh * 16 + c) * 16384 + el];
        }
        for (int c = 15; c >= 0; --c) {
            SB[((size_t)bh * 16 + c) * 16384 + el] = (h16)sb;
            sb = gb * sb + (float)UB[((size_t)bh * 16 + c) * 16384 + el];
        }
    }
}

__device__ __forceinline__ void ret_out_item(const Args& a, LAS char* lds, int bh, int c) {
    const int tid = threadIdx.x, lane = tid & 63, wid = __builtin_amdgcn_readfirstlane(tid >> 6), r16 = lane & 15, g = lane >> 4;
    const int b = bh >> 3, h = bh & 7;
    const float lgf = log2_gamma(a.in[I_RDEC], 0, h), lgb = log2_gamma(a.in[I_RDEC], 1, h);
    const h16* QR = (const h16*)(a.ws + WS_QR); const h16* KR = (const h16*)(a.ws + WS_KR); const h16* VR = (const h16*)(a.ws + WS_VR);
    const h16* SF = (const h16*)(a.ws + WS_SF); const h16* SB = (const h16*)(a.ws + WS_SB);
    const h16* GS = (const h16*)(a.ws + WS_GS); h16* MIX = (h16*)(a.ws + WS_MIX);
    LAS char* Qi = lds; LAS char* Ki = lds + 32768; LAS char* Vi = lds + 65536; LAS char* Pi = lds + 98304;
    const size_t src0 = ((size_t)bh * SEQ + c * 128) * 128, st0 = ((size_t)bh * 16 + c) * 16384;
    int ra[4], tbv[8][2];
#pragma unroll
    for (int s = 0; s < 4; ++s) ra[s] = row_addr16(lane, 0, s);
#pragma unroll
    for (int eb = 0; eb < 8; ++eb) { tbv[eb][0] = tr_addr16(lane, eb, 0, 0); tbv[eb][1] = tr_addr16(lane, eb, 0, 1); }
    const int st_o = off_b(tid >> 4, tid & 15);
    u32x4 sfr[4], sbr[4];
    {
        u32x4 qv[4], kv[4], vv[4];
#pragma unroll
        for (int i = 0; i < 4; ++i) {
            const size_t s = src0 + (size_t)((tid >> 4) + 32 * i) * 128 + (tid & 15) * 8;
            qv[i] = *(const u32x4*)(QR + s); kv[i] = *(const u32x4*)(KR + s); vv[i] = *(const u32x4*)(VR + s);
        }
#pragma unroll
        for (int i = 0; i < 4; ++i) {
            const size_t s = st0 + (size_t)((tid >> 4) + 32 * i) * 128 + (tid & 15) * 8;
            sfr[i] = *(const u32x4*)(SF + s); sbr[i] = *(const u32x4*)(SB + s);
        }
#pragma unroll
        for (int i = 0; i < 4; ++i) { *(LAS u32x4*)(Qi + st_o + i * 8192) = qv[i]; *(LAS u32x4*)(Ki + st_o + i * 8192) = kv[i]; *(LAS u32x4*)(Vi + st_o + i * 8192) = vv[i]; }
    }
    __syncthreads();
    h16x8 qf[4];
#pragma unroll
    for (int s = 0; s < 4; ++s) qf[s] = *(LAS h16x8*)(Qi + ra[s] + wid * 4096);
    const int il = 16 * wid + r16;
#pragma unroll
    for (int jb = 0; jb < 8; ++jb) {
        f32x4 sa = (f32x4){0.f, 0.f, 0.f, 0.f};
#pragma unroll
        for (int s = 0; s < 4; ++s) { const h16x8 kf = *(LAS h16x8*)(Ki + ra[s] + jb * 4096); sa = mfma16(kf, qf[s], sa); }
        f32x4 pv;
#pragma unroll
        for (int r = 0; r < 4; ++r) {
            const int dl = il - (16 * jb + 4 * g + r);
            float f = 0.f;
            if (dl >= 0) f += exp2f(lgf * (float)dl);
            if (dl <= 0) f += exp2f(lgb * (float)(-dl));
            pv[r] = sa[r] * f;
        }
        *(LAS h16x4*)(Pi + off_b(il, 2 * jb + (g >> 1)) + (g & 1) * 8) = cvt4(pv);
    }
    __syncthreads();
#pragma unroll
    for (int i = 0; i < 4; ++i) *(LAS u32x4*)(Ki + st_o + i * 8192) = sfr[i];
    __syncthreads();
    const h16 xfh = (h16)exp2f(lgf * (float)(il + 1)), xbh = (h16)exp2f(lgb * (float)(128 - il));
    f32x4 ao[8];
#pragma unroll
    for (int i = 0; i < 8; ++i) ao[i] = (f32x4){0.f, 0.f, 0.f, 0.f};
#pragma unroll
    for (int s = 0; s < 4; ++s) {
        const h16x8 pf = *(LAS h16x8*)(Pi + ra[s] + wid * 4096);
        const h16x8 qsf = qf[s] * xfh;
#pragma unroll
        for (int eb = 0; eb < 8; ++eb) {
            const h16x8 vf = cat8(trrd(Vi + tbv[eb][0] + s * 8192), trrd(Vi + tbv[eb][1] + s * 8192));
            ao[eb] = mfma16(vf, pf, ao[eb]);
            const h16x8 sf = cat8(trrd(Ki + tbv[eb][0] + s * 8192), trrd(Ki + tbv[eb][1] + s * 8192));
            ao[eb] = mfma16(sf, qsf, ao[eb]);
        }
    }
    __syncthreads();
#pragma unroll
    for (int i = 0; i < 4; ++i) *(LAS u32x4*)(Vi + st_o + i * 8192) = sbr[i];
    __syncthreads();
#pragma unroll
    for (int s = 0; s < 4; ++s) {
        const h16x8 qsb = qf[s] * xbh;
#pragma unroll
        for (int eb = 0; eb < 8; ++eb) {
            const h16x8 sf = cat8(trrd(Vi + tbv[eb][0] + s * 8192), trrd(Vi + tbv[eb][1] + s * 8192));
            ao[eb] = mfma16(sf, qsb, ao[eb]);
        }
    }
    float sum = 0.f;
#pragma unroll
    for (int eb = 0; eb < 8; ++eb) sum += (ao[eb][0] + ao[eb][1]) + (ao[eb][2] + ao[eb][3]);
    sum += __shfl_xor(sum, 16); sum += __shfl_xor(sum, 32);
    const float mean = sum * (1.f / 128.f); float q = 0.f;
#pragma unroll
    for (int eb = 0; eb < 8; ++eb) { ao[eb] = ao[eb] - mean; q += (ao[eb][0] * ao[eb][0] + ao[eb][1] * ao[eb][1]) + (ao[eb][2] * ao[eb][2] + ao[eb][3] * ao[eb][3]); }
    q += __shfl_xor(q, 16); q += __shfl_xor(q, 32);
    const float rstd = 1.f / sqrtf(q * (1.f / 128.f) + EPS);
    const int t = b * SEQ + c * 128 + il;
    const float* gw = a.in[I_RGN] + h * 128;
#pragma unroll
    for (int grp = 0; grp < 2; ++grp) {
        f32x4 o[4];
#pragma unroll
        for (int ni = 0; ni < 4; ++ni) {
            const int e = 16 * (4 * grp + ni) + 4 * g;
            const f32x4 w = *(const f32x4*)(gw + e);
            const h16x4 gs = *(const h16x4*)(GS + (size_t)t * 1024 + h * 128 + e);
#pragma unroll
            for (int r = 0; r < 4; ++r) o[ni][r] = ao[4 * grp + ni][r] * rstd * w[r] * (float)gs[r];
        }
        st_rows16_wt(MIX + (size_t)t * DM + h * 128 + grp * 64, o, 1.f, g);
    }
    asm volatile("s_waitcnt vmcnt(0)" ::: "memory");
    __syncthreads();
    if (tid == 0) (void)xb_add((unsigned*)(a.ws + WS_CTL) + CW_MCNT + b * 8 + (c >> 1), 1u);
}

namespace att {
constexpr float SCALE = 0.07216878364870322f;
constexpr float THR = 8.f;
constexpr int SHM_V = 16384, SHM_K = 16384, SHM_P = 8192;
constexpr int OFF_V = 0, OFF_K = 32768, OFF_P = 65536, OFF_W = 81920, OFF_QP = 83968;
using s16x4 = __attribute__((ext_vector_type(4))) short;
#define KSWZ(row, colB) ((row) * 256 + ((colB) ^ (((row) & 7) << 4)))
#define PSWZ(row, colB) ((row) * 128 + ((colB) ^ (((row) & 7) << 4)))
#define SBAR() __builtin_amdgcn_sched_barrier(0)
__device__ __forceinline__ int crow(int r, int hi) { return (r & 3) + 8 * (r >> 2) + 4 * hi; }
__device__ __forceinline__ unsigned pk2(float lo, float hi) { h16x2 v; v[0] = (h16)lo; v[1] = (h16)hi; return __builtin_bit_cast(unsigned, v); }
__device__ __forceinline__ f32x16 mfma32(h16x8 a, h16x8 b, f32x16 c) { return __builtin_amdgcn_mfma_f32_32x32x16_f16(a, b, c, 0, 0, 0); }
__device__ __forceinline__ void partialSM(f32x16& p0, f32x16& p1, float& m_reg, float& mn, float& alpha) {
    constexpr float C = SCALE * 1.4426950408889634f;
    float pmax = p0[0];
#pragma unroll
    for (int r = 1; r < 16; ++r) pmax = fmaxf(pmax, p0[r]);
#pragma unroll
    for (int r = 0; r < 16; ++r) pmax = fmaxf(pmax, p1[r]);
    { auto rr = __builtin_amdgcn_permlane32_swap(__float_as_uint(pmax), __float_as_uint(pmax), false, false);
      pmax = fmaxf(__uint_as_float(rr[0]), __uint_as_float(rr[1])); }
    if (__builtin_expect(__all(pmax - m_reg <= THR / SCALE), 1)) { mn = m_reg; alpha = 1.f; }
    else { mn = fmaxf(m_reg, pmax); alpha = __builtin_amdgcn_exp2f((m_reg - mn) * C); m_reg = mn; }
    const float mnC = -mn * C;
#pragma unroll
    for (int r = 0; r < 16; ++r) p0[r] = fmaf(p0[r], C, mnC);
#pragma unroll
    for (int r = 0; r < 16; ++r) p1[r] = fmaf(p1[r], C, mnC);
#pragma unroll
    for (int r = 0; r < 16; ++r) p0[r] = __builtin_amdgcn_exp2f(p0[r]);
}
__device__ __forceinline__ void finishSM(f32x16& p0, f32x16& p1, float alpha, float& l_reg, h16x8& pa0, h16x8& pa1, h16x8& pa2, h16x8& pa3) {
#pragma unroll
    for (int r = 0; r < 16; ++r) p1[r] = __builtin_amdgcn_exp2f(p1[r]);
    float ps = 0;
#pragma unroll
    for (int r = 0; r < 16; ++r) ps += p0[r];
#pragma unroll
    for (int r = 0; r < 16; ++r) ps += p1[r];
    { auto rr = __builtin_amdgcn_permlane32_swap(__float_as_uint(ps), __float_as_uint(ps), false, false);
      ps = __uint_as_float(rr[0]) + __uint_as_float(rr[1]); }
    l_reg = l_reg * alpha + ps;
#define PK4(P, BASE, OUT) do { unsigned a0 = pk2(P[BASE + 0], P[BASE + 1]), a1 = pk2(P[BASE + 2], P[BASE + 3]);   \
    unsigned b0 = pk2(P[BASE + 4], P[BASE + 5]), b1 = pk2(P[BASE + 6], P[BASE + 7]);                              \
    auto r0 = __builtin_amdgcn_permlane32_swap(a0, b0, false, false); auto r1 = __builtin_amdgcn_permlane32_swap(a1, b1, false, false); \
    u32x4 w = {r0[0], r1[0], r0[1], r1[1]}; OUT = __builtin_bit_cast(h16x8, w); } while (0)
    PK4(p0, 0, pa0); PK4(p0, 8, pa1); PK4(p1, 0, pa2); PK4(p1, 8, pa3);
#undef PK4
}
__device__ __forceinline__ void qkt(f32x16& p0, f32x16& p1, LAS char* Ks, LAS char* Ps, const h16x8* qr, LAS char* qpl, int r32, int hi) {
    p0 = f32x16{}; p1 = f32x16{};
#pragma unroll
    for (int d0 = 0; d0 < 8; ++d0) { const int cb = (d0 * 16 + hi * 8) * 2;
        const h16x8 b0 = *(LAS h16x8*)(Ks + KSWZ(r32, cb));
        const h16x8 b1 = *(LAS h16x8*)(Ks + KSWZ(32 + r32, cb));
        p0 = mfma32(b0, qr[d0], p0); p1 = mfma32(b1, qr[d0], p1); }
    SBAR();
#pragma unroll
    for (int d0 = 0; d0 < 4; ++d0) { const int cb = (d0 * 16 + hi * 8) * 2;
        const h16x8 b0 = *(LAS h16x8*)(Ps + PSWZ(r32, cb));
        const h16x8 b1 = *(LAS h16x8*)(Ps + PSWZ(32 + r32, cb));
        const h16x8 qv = *(LAS h16x8*)(qpl + PSWZ(r32, cb));
        p0 = mfma32(b0, qv, p0); p1 = mfma32(b1, qv, p1); }
}
__device__ __forceinline__ int v_st(int k, int c) { const int kk = (k & ~0xC) | ((k & 4) << 1) | ((k & 8) >> 1); return ((kk >> 3) * 4 + (c >> 5)) * 512 + ((kk & 7) * 32 + (c & 31)) * 2; }
__device__ __forceinline__ int v_rd_base(int lane) { return ((lane & 3) << 3) | (((lane >> 2) & 3) << 6) | (((lane >> 4) & 1) << 5) | (((lane >> 5) & 1) << 8); }
constexpr int v_rd_off(int d0, int ks, int half) { return d0 * 512 + ks * 4096 + half * 2048; }
template <int OFF> __device__ __forceinline__ s16x4 tr_read(int vb) {
    s16x4 r; asm volatile("ds_read_b64_tr_b16 %0, %1 offset:%2" : "=&v"(r) : "v"(vb), "i"(OFF) : "memory"); return r;
}
template <int D0> __device__ __forceinline__ void pv_one(f32x16& od, int vb, h16x8 pa0, h16x8 pa1, h16x8 pa2, h16x8 pa3) {
    const s16x4 l0 = tr_read<v_rd_off(D0, 0, 0)>(vb), h0 = tr_read<v_rd_off(D0, 0, 1)>(vb), l1 = tr_read<v_rd_off(D0, 1, 0)>(vb), h1 = tr_read<v_rd_off(D0, 1, 1)>(vb);
    const s16x4 l2 = tr_read<v_rd_off(D0, 2, 0)>(vb), h2 = tr_read<v_rd_off(D0, 2, 1)>(vb), l3 = tr_read<v_rd_off(D0, 3, 0)>(vb), h3 = tr_read<v_rd_off(D0, 3, 1)>(vb);
    asm volatile("s_waitcnt lgkmcnt(0)" ::: "memory"); SBAR();
#define PK(L, H) __builtin_bit_cast(h16x8, __builtin_shufflevector(L, H, 0, 1, 2, 3, 4, 5, 6, 7))
    od = mfma32(pa0, PK(l0, h0), od);
    od = mfma32(pa1, PK(l1, h1), od);
    od = mfma32(pa2, PK(l2, h2), od);
    od = mfma32(pa3, PK(l3, h3), od);
#undef PK
}
__device__ __forceinline__ void pv_d0(f32x16* o, int vb, h16x8 pa0, h16x8 pa1, h16x8 pa2, h16x8 pa3) {
    pv_one<0>(o[0], vb, pa0, pa1, pa2, pa3); pv_one<1>(o[1], vb, pa0, pa1, pa2, pa3); pv_one<2>(o[2], vb, pa0, pa1, pa2, pa3); pv_one<3>(o[3], vb, pa0, pa1, pa2, pa3);
}
__device__ __forceinline__ void attn_body(const h16* __restrict__ Qb, const h16* __restrict__ Kh, const h16* __restrict__ Vh, const h16* __restrict__ Ph,
                                          h16* __restrict__ Ob, int seq, LAS char* lds) {
    int tid = threadIdx.x; asm volatile("" : "+v"(tid));
    const int wid = tid >> 6, lane = tid & 63, r32 = lane & 31, hi = lane >> 5;
    LAS char* V_lds = lds + OFF_V; LAS char* K_lds = lds + OFF_K; LAS char* P_lds = lds + OFF_P;
    LAS float* wsf = (LAS float*)(lds + OFF_W) + wid * 64; LAS float* li_l = wsf; LAS float* al_l = wsf + 32;
    float m_reg = -1e30f, l_reg = 0; f32x16 o[4] = {}; h16x8 qr[8];
    LAS char* qp = lds + OFF_QP + wid * 4096;
    const h16* Qw = Qb + (size_t)(wid * 32 + r32) * 192 + hi * 8;
#pragma unroll
    for (int d0 = 0; d0 < 8; ++d0) qr[d0] = *(const h16x8*)(Qw + d0 * 16);
#pragma unroll
    for (int d0 = 0; d0 < 4; ++d0) *(LAS u32x4*)(qp + PSWZ(r32, (d0 * 16 + hi * 8) * 2)) = *(const u32x4*)(Qw + 128 + d0 * 16);
    const int sr = tid >> 4, sc = (tid & 15) * 8, vst0 = v_st(sr, sc), vst1 = v_st(32 + sr, sc);
    const int pr = tid >> 3, pc = (tid & 7) * 8;
    const int vb0 = (int)(uintptr_t)V_lds + v_rd_base(lane);
    struct { u32x4 vs0, vs1, ks0, ks1, ps; } sr_[1];
    const int vo = sr * 256 + sc * 2, po = pr * 128 + pc * 2;
    const __amdgpu_buffer_rsrc_t rsK = __builtin_amdgcn_make_buffer_rsrc((void*)Kh, (short)0, seq * 256, 0x00020000);
    const __amdgpu_buffer_rsrc_t rsV = __builtin_amdgcn_make_buffer_rsrc((void*)Vh, (short)0, seq * 256, 0x00020000);
    const __amdgpu_buffer_rsrc_t rsP = __builtin_amdgcn_make_buffer_rsrc((void*)Ph, (short)0, seq * 128, 0x00020000);
#define SLOAD(i, k0) do { const int so_ = (k0) * 256; \
    sr_[i].vs0 = __builtin_bit_cast(u32x4, __builtin_amdgcn_raw_buffer_load_b128(rsV, vo, so_, 0)); sr_[i].vs1 = __builtin_bit_cast(u32x4, __builtin_amdgcn_raw_buffer_load_b128(rsV, vo, so_ + 8192, 0)); \
    sr_[i].ks0 = __builtin_bit_cast(u32x4, __builtin_amdgcn_raw_buffer_load_b128(rsK, vo, so_, 0)); sr_[i].ks1 = __builtin_bit_cast(u32x4, __builtin_amdgcn_raw_buffer_load_b128(rsK, vo, so_ + 8192, 0)); \
    sr_[i].ps = __builtin_bit_cast(u32x4, __builtin_amdgcn_raw_buffer_load_b128(rsP, po, (k0) * 128, 0)); } while (0)
#define SWRITE(b, i) do { *(LAS u32x4*)(V_lds + (b) * SHM_V + vst0) = sr_[i].vs0;          \
    *(LAS u32x4*)(V_lds + (b) * SHM_V + vst1) = sr_[i].vs1; const int kc = sc * 2;               \
    *(LAS u32x4*)(K_lds + (b) * SHM_K + KSWZ(sr, kc)) = sr_[i].ks0;                       \
    *(LAS u32x4*)(K_lds + (b) * SHM_K + KSWZ(32 + sr, kc)) = sr_[i].ks1;                  \
    *(LAS u32x4*)(P_lds + (b) * SHM_P + PSWZ(pr, pc * 2)) = sr_[i].ps; } while (0)
#define SWAIT() asm volatile("s_waitcnt vmcnt(0)" ::: "memory")
#define RESC(a) do { if (__any((a) < 1.f)) { if (hi == 0) al_l[r32] = (a); asm volatile("s_waitcnt lgkmcnt(0)" ::: "memory"); \
    _Pragma("unroll") for (int d = 0; d < 4; ++d) _Pragma("unroll") for (int r = 0; r < 16; ++r) o[d][r] *= al_l[crow(r, hi)]; } } while (0)
    f32x16 pA0, pA1, pB0, pB1; float mnA, mnB, alA, alB; h16x8 pa0, pa1, pa2, pa3; const int NT = seq / 64;
    constexpr int SE = 0, SO = 0;
    SLOAD(SE, 0); asm volatile("s_waitcnt vmcnt(0)" ::: "memory"); SWRITE(0, SE); __syncthreads();
    qkt(pA0, pA1, K_lds, P_lds, qr, qp, r32, hi); partialSM(pA0, pA1, m_reg, mnA, alA);
    SLOAD(SO, 64);
    SWAIT(); SWRITE(1, SO); __syncthreads();
    for (int j = 1; j + 1 < NT; j += 2) {
        SBAR(); qkt(pB0, pB1, K_lds + SHM_K, P_lds + SHM_P, qr, qp, r32, hi);
        finishSM(pA0, pA1, alA, l_reg, pa0, pa1, pa2, pa3); SBAR();
        SLOAD(SO, (j + 1) * 64); SBAR();
        pv_d0(o, vb0, pa0, pa1, pa2, pa3); partialSM(pB0, pB1, m_reg, mnB, alB);
        __syncthreads(); SWAIT(); SWRITE(0, SE);
        RESC(alB); __syncthreads();
        SBAR(); qkt(pA0, pA1, K_lds, P_lds, qr, qp, r32, hi);
        finishSM(pB0, pB1, alB, l_reg, pa0, pa1, pa2, pa3); SBAR();
        SLOAD(SE, (j + 2) * 64); SBAR();
        pv_d0(o, vb0 + SHM_V, pa0, pa1, pa2, pa3); partialSM(pA0, pA1, m_reg, mnA, alA);
        __syncthreads(); SWAIT(); SWRITE(1, SO);
        RESC(alA); __syncthreads();
    }
    SBAR(); qkt(pB0, pB1, K_lds + SHM_K, P_lds + SHM_P, qr, qp, r32, hi);
    finishSM(pA0, pA1, alA, l_reg, pa0, pa1, pa2, pa3); SBAR();
    pv_d0(o, vb0, pa0, pa1, pa2, pa3); partialSM(pB0, pB1, m_reg, mnB, alB);
    __syncthreads(); RESC(alB);
    finishSM(pB0, pB1, alB, l_reg, pa0, pa1, pa2, pa3); SBAR();
    pv_d0(o, vb0 + SHM_V, pa0, pa1, pa2, pa3);
    if (hi == 0) li_l[r32] = l_reg; asm volatile("s_waitcnt lgkmcnt(0)" ::: "memory");
    float rli[16];
#pragma unroll
    for (int r = 0; r < 16; ++r) rli[r] = __builtin_amdgcn_rcpf(li_l[crow(r, hi)]);
    h16* Ow = Ob + (size_t)(wid * 32) * DM;
#pragma unroll
    for (int r = 0; r < 16; ++r) { const int orow = crow(r, hi);
#pragma unroll
        for (int d0 = 0; d0 < 4; ++d0) { const unsigned ov = (unsigned)__builtin_bit_cast(unsigned short, (h16)(o[d0][r] * rli[r]));
            asm volatile("global_store_short %0, %1, off sc1" :: "v"(Ow + (size_t)orow * DM + d0 * 32 + r32), "v"(ov) : "memory"); } }
    asm volatile("s_waitcnt vmcnt(0)" ::: "memory");
    __syncthreads();
#undef SLOAD
#undef SWRITE
#undef SWAIT
#undef RESC
}
#undef KSWZ
#undef PSWZ
}

__device__ __forceinline__ void phase_attn(const Args& a, LAS char* lds, int vcu) {
    const h16* Q = (const h16*)(a.ws + WS_Q); const h16* KN = (const h16*)(a.ws + WS_KN); const h16* VV = (const h16*)(a.ws + WS_VV);
    const h16* KPE = (const h16*)(a.ws + WS_KPE); h16* MIX = (h16*)(a.ws + WS_MIX);
    for (int it0 = vcu; it0 < 256; it0 += gridDim.x) {
        int it = it0;
        if (gridDim.x == 256) { const int x = it0 >> 5, l = it0 & 31, mt = 4 * x + (l >> 3), hh = l & 7; it = (((mt >> 3) * 8 + hh) << 3) | (mt & 7); }
        const int bh = it >> 3, qb = it & 7, b = bh >> 3, h = bh & 7;
        att::attn_body(Q + ((size_t)bh * SEQ + qb * 256) * 192, KN + (size_t)bh * LK * 128, VV + (size_t)bh * LK * 128, KPE + (size_t)b * LK * 64,
                       MIX + ((size_t)b * SEQ + qb * 256) * DM + 1024 + h * 128, LK, lds);
        if (threadIdx.x == 0) (void)xb_add((unsigned*)(a.ws + WS_CTL) + CW_MCNT + b * 8 + qb, 1u);
    }
}
__device__ __forceinline__ void phase_retout(const Args& a, LAS char* lds, int vcu) {
    if (gridDim.x == 256) {
        const int x = vcu >> 5, l = vcu & 31;
        for (int j = 0; j < 2; ++j) { const int idx = l + 32 * j, h = idx & 7, cl = idx >> 3; ret_out_item(a, lds, (x >> 1) * 8 + h, (x & 1) * 8 + cl); }
    } else
    for (int it = vcu; it < 512; it += gridDim.x) ret_out_item(a, lds, it >> 4, it & 15);
}

__device__ __forceinline__ void phase_oproj(const Args& a, LAS char* lds, int vcu) {
    GemmThread2 G; G.init();
    const h16* MIX = (const h16*)(a.ws + WS_MIX); const float* MOD = (const float*)(a.ws + WS_MOD); h16* U = (h16*)(a.ws + WS_U);
    const float* X = a.in[I_X];
    for (int p = vcu; p < 32 * 8; p += gridDim.x) {
        const int mg = p >> 5, rem = p & 31, nt = rem >> 2, mt = mg * 4 + (rem & 3);
        if (threadIdx.x == 0 && a.ph_lo != 8) {
            unsigned* MC = (unsigned*)(a.ws + WS_CTL) + CW_MCNT; unsigned* bar = (unsigned*)(a.ws + WS_CTL) + CW_BAR;
            XB_SPIN(xb_ld(&MC[mt]) < 24u, bar);
            __builtin_amdgcn_fence(__ATOMIC_ACQUIRE, "agent");
            asm volatile("s_waitcnt vmcnt(0)" ::: "memory");
        }
        __syncthreads();
        f32x4 acc[8][4];
        gemm_tile_g2(lds, G, MIX + (size_t)mt * 256 * DM, DM, (const h16*)(a.ws + WS_WO16) + nt * 256, DM, DM / 64, acc);
        const int b = mt >> 3, c0 = nt * 256 + G.wn * 64 + 4 * G.g;
        const float* g1 = MOD + (size_t)b * ADAW + 2 * DM + c0;
        f32x4 gv[4];
#pragma unroll
        for (int ni = 0; ni < 4; ++ni) gv[ni] = *(const f32x4*)(g1 + ni * 16);
        const size_t ro0 = (size_t)(mt * 256 + G.wm * 128 + G.r16) * DM + c0;
        f32x4 xn[4];
#pragma unroll
        for (int ni = 0; ni < 4; ++ni) xn[ni] = *(const f32x4*)(X + ro0 + ni * 16);
#pragma unroll
        for (int mi = 0; mi < 8; ++mi) {
            const size_t ro = ro0 + (size_t)mi * 16 * DM;
            f32x4 xv[4];
#pragma unroll
            for (int ni = 0; ni < 4; ++ni) xv[ni] = xn[ni];
            if (mi < 7) {
#pragma unroll
                for (int ni = 0; ni < 4; ++ni) xn[ni] = *(const f32x4*)(X + ro + (size_t)16 * DM + ni * 16);
            }
            __builtin_amdgcn_sched_barrier(0);
            f32x4 c[4];
#pragma unroll
            for (int ni = 0; ni < 4; ++ni) c[ni] = xv[ni] * ALPHA + gv[ni] * acc[mi][ni];
            st_rows16_wt(U + ro - 4 * G.g, c, 1.f, G.g);
        }
        asm volatile("s_waitcnt vmcnt(0)" ::: "memory");
        __syncthreads();
        if (threadIdx.x == 0) (void)xb_add((unsigned*)(a.ws + WS_CTL) + CW_UCNT + mt, 1u);
    }
}

__device__ __forceinline__ int rt_off(int m, int c) { return m * 4096 + ((c ^ (m & 15)) << 4); }
__device__ __forceinline__ void phase_router(const Args& a, LAS char* lds, int vcu) {
    const int tid = threadIdx.x, lane = tid & 63, wid = __builtin_amdgcn_readfirstlane(tid >> 6), r16 = lane & 15, g = lane >> 4;
    const h16* U = (const h16*)(a.ws + WS_U); const float* MOD = (const float*)(a.ws + WS_MOD);
    h16* H = (h16*)(a.ws + WS_H); unsigned char* A2q = (unsigned char*)(a.ws + WS_A2);
    int* LIST = (int*)(a.ws + WS_LIST); float* WL = (float*)(a.ws + WS_WL); unsigned* CNT = (unsigned*)(a.ws + WS_CTL) + CW_CNT;
    const h16* WRH = (const h16*)(a.ws + WS_WRH);
    const float* ln1w = a.in[I_LN1W]; const float* ln1b = a.in[I_LN1B];
    LAS char* THI = lds;
    LAS f32x4* red = (LAS f32x4*)lds;
    LAS float* lg = (LAS float*)(lds + 65536);
    LAS int* asg_e = (LAS int*)(lds + LDS_MAP + 2048); LAS int* asg_t = asg_e + 64; LAS float* asg_w = (LAS float*)(asg_e + 128);
    LAS float* rbias = (LAS float*)(lds + LDS_ROWS);
    if (tid < 36) rbias[tid] = (tid < 4) ? a.in[I_RGB][tid] : a.in[I_REB][tid - 4];
    for (int base = vcu * 32; base < T; base += gridDim.x * 32) {
        if (tid == 0 && a.ph_lo != 9) {
            unsigned* UC = (unsigned*)(a.ws + WS_CTL) + CW_UCNT; unsigned* bar = (unsigned*)(a.ws + WS_CTL) + CW_BAR;
            XB_SPIN(xb_ld(&UC[base >> 8]) < 8u, bar);
            __builtin_amdgcn_fence(__ATOMIC_ACQUIRE, "agent");
            asm volatile("s_waitcnt vmcnt(0)" ::: "memory");
        }
        __syncthreads();
#pragma unroll 1
        for (int rr = 0; rr < 4; rr += 2) {
            const int m = 4 * wid + rr, row = base + m, b = row >> 11;
            f32x4 v[2][8]; float s[2] = {0.f, 0.f};
#pragma unroll
            for (int r = 0; r < 2; ++r)
#pragma unroll
                for (int j = 0; j < 8; ++j) { const h16x4 u4 = *(const h16x4*)(U + (size_t)(row + r) * DM + j * 256 + lane * 4);
#pragma unroll
                    for (int e = 0; e < 4; ++e) v[r][j][e] = (float)u4[e];
                    s[r] += (v[r][j][0] + v[r][j][1]) + (v[r][j][2] + v[r][j][3]); }
            float mean[2], q[2] = {0.f, 0.f}, rstd[2];
#pragma unroll
            for (int r = 0; r < 2; ++r) mean[r] = wave_sum(s[r]) * (1.f / DM);
#pragma unroll
            for (int r = 0; r < 2; ++r)
#pragma unroll
                for (int j = 0; j < 8; ++j) { v[r][j] = v[r][j] - mean[r]; q[r] += (v[r][j][0] * v[r][j][0] + v[r][j][1] * v[r][j][1]) + (v[r][j][2] * v[r][j][2] + v[r][j][3] * v[r][j][3]); }
#pragma unroll
            for (int r = 0; r < 2; ++r) { rstd[r] = 1.f / sqrtf(wave_sum(q[r]) * (1.f / DM) + EPS); s[r] = 0.f; }
            {
                f32x4 lwv[8], lbv[8];
#pragma unroll
                for (int j = 0; j < 8; ++j) { lwv[j] = *(const f32x4*)(ln1w + j * 256 + lane * 4); lbv[j] = *(const f32x4*)(ln1b + j * 256 + lane * 4); }
                __builtin_amdgcn_sched_barrier(0);
#pragma unroll
                for (int j = 0; j < 8; ++j)
#pragma unroll
                    for (int r = 0; r < 2; ++r) {
                        v[r][j] = v[r][j] * rstd[r] * lwv[j] + lbv[j];
                        s[r] += (v[r][j][0] + v[r][j][1]) + (v[r][j][2] + v[r][j][3]);
                    }
            }
#pragma unroll
            for (int j = 0; j < 8; ++j)
#pragma unroll
                for (int r = 0; r < 2; ++r) *(h16x4*)(H + (size_t)(row + r) * DM + j * 256 + lane * 4) = cvt4(v[r][j]);
#pragma unroll
            for (int r = 0; r < 2; ++r) { mean[r] = wave_sum(s[r]) * (1.f / DM); q[r] = 0.f; }
#pragma unroll
            for (int r = 0; r < 2; ++r)
#pragma unroll
                for (int j = 0; j < 8; ++j) { v[r][j] = v[r][j] - mean[r]; q[r] += (v[r][j][0] * v[r][j][0] + v[r][j][1] * v[r][j][1]) + (v[r][j][2] * v[r][j][2] + v[r][j][3] * v[r][j][3]); }
#pragma unroll
            for (int r = 0; r < 2; ++r) rstd[r] = 1.f / sqrtf(wave_sum(q[r]) * (1.f / DM) + EPS);
            {
                f32x4 shv[8], scv[8];
#pragma unroll
                for (int j = 0; j < 8; ++j) { shv[j] = *(const f32x4*)(MOD + (size_t)b * ADAW + 3 * DM + j * 256 + lane * 4); scv[j] = *(const f32x4*)(MOD + (size_t)b * ADAW + 4 * DM + j * 256 + lane * 4); }
                __builtin_amdgcn_sched_barrier(0);
#pragma unroll
                for (int j = 0; j < 8; ++j)
#pragma unroll
                    for (int r = 0; r < 2; ++r) v[r][j] = v[r][j] * rstd[r] * (scv[j] + 1.f) + shv[j];
            }
#pragma unroll
            for (int j = 0; j < 8; ++j) {
                const int k = j * 256 + lane * 4;
#pragma unroll
                for (int r = 0; r < 2; ++r) {
                    const f32x4 tt = v[r][j];
                    const h16x4 hi = cvt4(tt);
                    int w8 = __builtin_amdgcn_cvt_pk_fp8_f32(tt[0], tt[1], 0, false); w8 = __builtin_amdgcn_cvt_pk_fp8_f32(tt[2], tt[3], w8, true);
                    *(int*)(A2q + (size_t)(row + r) * DM + k) = w8;
                    *(LAS h16x4*)(THI + rt_off(m + r, j * 32 + (lane >> 1)) + (lane & 1) * 8) = hi;
                }
            }
        }
        __syncthreads();
        f32x4 acc[2][3];
#pragma unroll
        for (int mt = 0; mt < 2; ++mt)
#pragma unroll
            for (int nt = 0; nt < 3; ++nt) acc[mt][nt] = (f32x4){0.f, 0.f, 0.f, 0.f};
#pragma unroll 4
        for (int s8 = 0; s8 < 8; ++s8) {
            const int c = wid * 32 + s8 * 4 + g;
            const h16x8 t0 = *(LAS h16x8*)(THI + rt_off(r16, c)), t1 = *(LAS h16x8*)(THI + rt_off(16 + r16, c));
#pragma unroll
            for (int nt = 0; nt < 3; ++nt) {
                const h16x8 wh = *(const h16x8*)(WRH + (size_t)(16 * nt + r16) * DM + c * 8);
                acc[0][nt] = mfma16(wh, t0, acc[0][nt]); acc[1][nt] = mfma16(wh, t1, acc[1][nt]);
            }
        }
        __syncthreads();
#pragma unroll
        for (int mt = 0; mt < 2; ++mt)
#pragma unroll
            for (int nt = 0; nt < 3; ++nt) red[(wid * 6 + mt * 3 + nt) * 64 + lane] = acc[mt][nt];
        __syncthreads();
        if (tid < 384) {
            const int t6 = tid >> 6, l2 = tid & 63, mt = t6 / 3, nt = t6 - 3 * mt;
            f32x4 sum = (f32x4){0.f, 0.f, 0.f, 0.f};
#pragma unroll
            for (int w = 0; w < 8; ++w) sum += red[(w * 6 + t6) * 64 + l2];
#pragma unroll
            for (int r = 0; r < 4; ++r) lg[(16 * mt + (l2 & 15)) * 48 + 16 * nt + 4 * (l2 >> 4) + r] = sum[r] * (1.f / 1024.f);
        }
        __syncthreads();
        if (tid < 32) {
            const int row = base + tid;
            const LAS float* bg = rbias; const LAS float* be = rbias + 4;
            float glv[4];
#pragma unroll
            for (int c = 0; c < 4; ++c) glv[c] = lg[tid * 48 + c] + bg[c];
            int gs = 0; float gm = glv[0];
#pragma unroll
            for (int c = 1; c < 4; ++c) if (glv[c] > gm) { gm = glv[c]; gs = c; }
            float gden = 0.f;
#pragma unroll
            for (int c = 0; c < 4; ++c) gden += __expf(glv[c] - gm);
            const float gp = 1.f / gden;
            float el[8];
#pragma unroll
            for (int c = 0; c < 8; ++c) el[c] = lg[tid * 48 + 4 + gs * 8 + c] + be[gs * 8 + c];
            int i0 = 0; float v0 = el[0];
#pragma unroll
            for (int c = 1; c < 8; ++c) if (el[c] > v0) { v0 = el[c]; i0 = c; }
            int i1 = -1; float v1 = -3.0e38f;
#pragma unroll
            for (int c = 0; c < 8; ++c) if (c != i0 && el[c] > v1) { v1 = el[c]; i1 = c; }
            const float ex = __expf(v1 - v0), w0 = gp / (1.f + ex), w1 = gp * ex / (1.f + ex);
            asg_e[2 * tid] = gs * 8 + i0; asg_t[2 * tid] = row * 2; asg_w[2 * tid] = w0;
            asg_e[2 * tid + 1] = gs * 8 + i1; asg_t[2 * tid + 1] = row * 2 + 1; asg_w[2 * tid + 1] = w1;
        }
        __syncthreads();
        if (tid < 64) {
            const int my_e = asg_e[tid], my_t = asg_t[tid]; const float my_w = asg_w[tid];
            int rank = 0, cnt = 0;
            for (int ex = 0; ex < NEXP; ++ex) {
                const unsigned long long m = __ballot(my_e == ex);
                if (my_e == ex) { rank = __popcll(m & ((1ull << tid) - 1ull)); cnt = __popcll(m); }
            }
            const int sub = my_e * 8 + (blockIdx.x & 7);
            LAS int* ebase = asg_e + 192;
            if (rank == 0) ebase[my_e] = (int)atomicAdd(&CNT[sub], (unsigned)cnt);
            asm volatile("s_waitcnt vmcnt(0) lgkmcnt(0)" ::: "memory");
            const int pos = ebase[my_e] + rank;
            LIST[(size_t)sub * SUBCAP + pos] = my_t; WL[(size_t)sub * SUBCAP + pos] = my_w;
        }
        __syncthreads();
    }
}

struct MoeMap { int upre[NEXP + 1]; int rpre[NEXP + 1]; };
__device__ __forceinline__ void moe_map(const Args& a, LAS int* mp, int units_per_mtile) {
    const unsigned* CNT = (const unsigned*)(a.ws + WS_CTL) + CW_CNT;
    LAS int* c8 = mp + 448;
    if (threadIdx.x < NEXP * 8) c8[threadIdx.x] = (int)__hip_atomic_load(&CNT[threadIdx.x], __ATOMIC_RELAXED, __HIP_MEMORY_SCOPE_AGENT);
    __syncthreads();
    if (threadIdx.x < NEXP) {
        int acc = 0;
        for (int x = 0; x < 8; ++x) { mp[128 + 9 * threadIdx.x + x] = acc; acc += c8[threadIdx.x * 8 + x]; }
        mp[128 + 9 * threadIdx.x + 8] = acc; mp[66 + threadIdx.x] = acc;
    }
    __syncthreads();
    if (threadIdx.x == 0) {
        int up = 0, rp = 0;
        for (int e = 0; e < NEXP; ++e) {
            const int c = mp[66 + e];
            const int ntm = (c + 255) >> 8;
            mp[e] = up; mp[33 + e] = rp;
            up += ntm * units_per_mtile; rp += ntm * 256;
        }
        mp[32] = up; mp[65] = rp;
    }
    __syncthreads();
}
__device__ __forceinline__ int moe_pos(const LAS int* mp, int e, int idx) {
    const LAS int* sp = mp + 128 + 9 * e;
    int x = 0;
#pragma unroll
    for (int i = 1; i < 8; ++i) x += (idx >= sp[i]) ? 1 : 0;
    return (e * 8 + x) * SUBCAP + idx - sp[x];
}
__device__ __forceinline__ void wdown_pool(const Args& a, LAS char* lds, int budget);
__device__ __forceinline__ void phase_moe1(const Args& a, LAS char* lds, int vcu) {
    GemmThread G; G.init();
    LAS int* mp = (LAS int*)(lds + LDS_MAP);
    moe_map(a, mp, 8);
    const unsigned char* A2q = (const unsigned char*)(a.ws + WS_A2); const int* LIST = (const int*)(a.ws + WS_LIST); unsigned char* HID = (unsigned char*)(a.ws + WS_HID);
    const int NU = mp[32];
    int e = 0;
    for (int p = vcu; p < NU; p += gridDim.x) {
        while (p >= mp[e + 1]) ++e;
        const int q = p - mp[e], cnt = mp[66 + e], ntm = (cnt + 255) >> 8, nt = q / ntm, mt = q % ntm;
        const unsigned char* arow[2];
#pragma unroll
        for (int i = 0; i < 2; ++i) {
            const int idx = mt * 256 + (G.tid >> 2) + 128 * i;
            const int tok = (idx < cnt) ? (LIST[moe_pos(mp, e, idx)] >> 1) : 0;
            arow[i] = A2q + (size_t)tok * DM + (G.tid & 3) * 16;
        }
        const int c = (G.tid & 31) * 4, wnc = c >> 6, within = c & 63;
        const float* wsrc = (within >= 32) ? a.in[I_EWU] : a.in[I_EWG];
        const float* bcol = wsrc + (size_t)e * DM * DE + (size_t)(G.tid >> 5) * DE + nt * 64 + wnc * 32 + (within & 31);
        f32x4 acc[4][4];
        gemm_tile(lds, G, arow, bcol, (size_t)DE, DM / 64, acc);
        {
#pragma unroll
            for (int mi = 0; mi < 4; ++mi) {
                unsigned char* dst = HID + (size_t)(mp[33 + e] + mt * 256) * DE + nt * 16384 + (G.wm * 64 + mi * 16 + G.r16) * 64 + G.wn * 32 + 4 * G.g;
#pragma unroll
                for (int ni = 0; ni < 2; ++ni) {
                    f32x4 o;
#pragma unroll
                    for (int r = 0; r < 4; ++r) o[r] = silu_f(acc[mi][ni][r]) * acc[mi][ni + 2][r];
                    int w8 = __builtin_amdgcn_cvt_pk_fp8_f32(o[0], o[1], 0, false); w8 = __builtin_amdgcn_cvt_pk_fp8_f32(o[2], o[3], w8, true);
                    *(int*)(dst + ni * 16) = w8;
                }
            }
        }
    }
    wdown_pool(a, lds, 1 << 20);
}
constexpr int POOL_ITEMS = (NEXP * DE * DM / 8) / (NTHREADS * 8);
__device__ __forceinline__ void wdown_pool(const Args& a, LAS char* lds, int budget) {
    unsigned* head = (unsigned*)(a.ws + WS_CTL) + CW_POOL;
    const float* W = a.in[I_EWD]; h16* O = (h16*)(a.ws + WS_WD16);
    LAS unsigned* slot = (LAS unsigned*)(lds + LDS_MAP + 400);
    for (int it = 0; it < budget; ++it) {
        __syncthreads();
        if (threadIdx.x == 0) *slot = atomicAdd(head, 1u);
        __syncthreads();
        const unsigned item = *slot;
        if (item >= (unsigned)POOL_ITEMS) break;
        const size_t base = (size_t)item * (NTHREADS * 8) + threadIdx.x;
        f32x4 v[8][2];
#pragma unroll
        for (int j = 0; j < 8; ++j) { const float* p = W + (base + (size_t)j * NTHREADS) * 8; v[j][0] = *(const f32x4*)p; v[j][1] = *(const f32x4*)(p + 4); }
#pragma unroll
        for (int j = 0; j < 8; ++j) {
            h16x8 o;
#pragma unroll
            for (int e = 0; e < 4; ++e) { o[e] = (h16)v[j][0][e]; o[4 + e] = (h16)v[j][1][e]; }
            *(h16x8*)(O + (base + (size_t)j * NTHREADS) * 8) = o;
        }
    }
}
__device__ __forceinline__ void phase_moe2(const Args& a, LAS char* lds, int vcu) {
    GemmThread G; G.init();
    LAS int* mp = (LAS int*)(lds + LDS_MAP);
    if (a.ph_lo == 11) moe_map(a, mp, 16);
    else { if (threadIdx.x <= 32) mp[threadIdx.x] *= 2; __syncthreads(); }
    const unsigned char* HID = (const unsigned char*)(a.ws + WS_HID); const int* LIST = (const int*)(a.ws + WS_LIST); const float* WL = (const float*)(a.ws + WS_WL);
    const h16* WD16 = (const h16*)(a.ws + WS_WD16); h16* Y = (h16*)(a.ws + WS_Y);
    LAS int* eslot = (LAS int*)(lds + LDS_ROWS); LAS float* ew = (LAS float*)(lds + LDS_MAP + 2048);
    const int NU = mp[32];
    G3Stream S; S.gs = 0; S.primed = false;
    int e = 0;
    for (int p = vcu; p < NU; p += gridDim.x) {
        while (p >= mp[e + 1]) ++e;
        const int q = p - mp[e], cnt = mp[66 + e], ntm = (cnt + 255) >> 8, nt = q / ntm, mt = q % ntm;
        const int pn = p + (int)gridDim.x; const bool hn = pn < NU;
        const unsigned char* nA = nullptr; const h16* nB = nullptr;
        if (hn) { int e2 = e; while (pn >= mp[e2 + 1]) ++e2;
            const int q2 = pn - mp[e2], ntm2 = (mp[66 + e2] + 255) >> 8, nt2 = q2 / ntm2, mt2 = q2 % ntm2;
            nA = HID + (size_t)(mp[33 + e2] + mt2 * 256) * DE; nB = WD16 + (size_t)e2 * DE * DM + nt2 * 128; }
        if (threadIdx.x < 256) {
            const int idx = mt * 256 + (int)threadIdx.x;
            const int lp = moe_pos(mp, e, idx < cnt ? idx : 0);
            eslot[threadIdx.x] = (idx < cnt) ? LIST[lp] : -1; ew[threadIdx.x] = WL[lp];
        }
        f32x4 acc[4][4];
        gemm_tile_g8(lds, G, HID + (size_t)(mp[33 + e] + mt * 256) * DE, DE, WD16 + (size_t)e * DE * DM + nt * 128, DM, DE / 64, acc, S, nA, nB);
        {
            unsigned es[4], ewv[4];
            { const int rb = (G.wm * 64 + G.r16) * 4;
              es[0] = asm_rd32<0>((int)(uintptr_t)eslot + rb); es[1] = asm_rd32<64>((int)(uintptr_t)eslot + rb); es[2] = asm_rd32<128>((int)(uintptr_t)eslot + rb); es[3] = asm_rd32<192>((int)(uintptr_t)eslot + rb);
              ewv[0] = asm_rd32<0>((int)(uintptr_t)ew + rb); ewv[1] = asm_rd32<64>((int)(uintptr_t)ew + rb); ewv[2] = asm_rd32<128>((int)(uintptr_t)ew + rb); ewv[3] = asm_rd32<192>((int)(uintptr_t)ew + rb); }
            LGKM0();
#pragma unroll
            for (int mi = 0; mi < 4; ++mi) {
                const int slot = (int)es[mi]; const float w = __uint_as_float(ewv[mi]);
                u32x4 v[2];
                acc_rows16(acc[mi], w, v);
                if (slot >= 0) {
                    h16* dst = Y + (size_t)slot * DM + nt * 128 + G.wn * 64 + 8 * G.g;
                    *(u32x4*)dst = v[0]; *(u32x4*)(dst + 32) = v[1];
                }
            }
        }
        __builtin_amdgcn_s_barrier();
    }
}

__device__ __forceinline__ void phase_final(const Args& a) {
    const int tid = threadIdx.x, lane = tid & 63, wid = tid >> 6;
    const h16* H = (const h16*)(a.ws + WS_H); const h16* Y = (const h16*)(a.ws + WS_Y); const float* MOD = (const float*)(a.ws + WS_MOD);
    const float* w2 = a.in[I_LN2W]; const float* b2 = a.in[I_LN2B];
    for (int row = blockIdx.x * 16 + 2 * wid; row < T; row += gridDim.x * 16) {
        const int b = row >> 11;
        f32x4 v[2][8]; float s[2] = {0.f, 0.f};
#pragma unroll
        for (int j = 0; j < 8; ++j) {
            const int k = j * 256 + lane * 4;
            const f32x4 g2 = *(const f32x4*)(MOD + (size_t)b * ADAW + 5 * DM + k);
#pragma unroll
            for (int r = 0; r < 2; ++r) {
                const h16x4 h4 = *(const h16x4*)(H + (size_t)(row + r) * DM + k);
                const h16x4 y0 = *(const h16x4*)(Y + (size_t)((row + r) * 2) * DM + k), y1 = *(const h16x4*)(Y + (size_t)((row + r) * 2 + 1) * DM + k);
                f32x4 hv, yv;
#pragma unroll
                for (int e = 0; e < 4; ++e) { hv[e] = (float)h4[e]; yv[e] = (float)y0[e] + (float)y1[e]; }
                v[r][j] = hv * ALPHA + g2 * yv;
                s[r] += (v[r][j][0] + v[r][j][1]) + (v[r][j][2] + v[r][j][3]);
            }
            if (j == 3) __builtin_amdgcn_sched_barrier(0);
        }
        float mean[2], q[2] = {0.f, 0.f}, rstd[2];
#pragma unroll
        for (int r = 0; r < 2; ++r) mean[r] = wave_sum(s[r]) * (1.f / DM);
#pragma unroll
        for (int r = 0; r < 2; ++r)
#pragma unroll
            for (int j = 0; j < 8; ++j) { v[r][j] = v[r][j] - mean[r]; q[r] += (v[r][j][0] * v[r][j][0] + v[r][j][1] * v[r][j][1]) + (v[r][j][2] * v[r][j][2] + v[r][j][3] * v[r][j][3]); }
#pragma unroll
        for (int r = 0; r < 2; ++r) rstd[r] = 1.f / sqrtf(wave_sum(q[r]) * (1.f / DM) + EPS);
        {
            f32x4 lwv[8], lbv[8];
#pragma unroll
            for (int j = 0; j < 8; ++j) { lwv[j] = *(const f32x4*)(w2 + j * 256 + lane * 4); lbv[j] = *(const f32x4*)(b2 + j * 256 + lane * 4); }
            __builtin_amdgcn_sched_barrier(0);
#pragma unroll
            for (int j = 0; j < 8; ++j)
#pragma unroll
                for (int r = 0; r < 2; ++r) v[r][j] = v[r][j] * rstd[r] * lwv[j] + lbv[j];
        }
#pragma unroll
        for (int j = 0; j < 8; ++j)
#pragma unroll
            for (int r = 0; r < 2; ++r) *(f32x4*)(a.out + (size_t)(row + r) * DM + j * 256 + lane * 4) = v[r][j];
    }
}

__device__ __forceinline__ void phase_front(const Args& a, LAS char* lds) {
    unsigned* AC = (unsigned*)(a.ws + WS_CTL) + CW_ACNT; unsigned* bar = (unsigned*)(a.ws + WS_CTL) + CW_BAR;
    const int bx = blockIdx.x;
    adaln_init(a, lds);
    adaln_unit(a, lds, bx & 31, bx >> 5, true);
    if (threadIdx.x == 0) (void)xb_add(AC, 1u);
    phase_cvt(a);
    if (threadIdx.x == 0) {
        XB_SPIN(xb_ld(AC) < 256u, bar);
        __builtin_amdgcn_fence(__ATOMIC_ACQUIRE, "agent");
        asm volatile("s_waitcnt vmcnt(0)" ::: "memory");
    }
    __syncthreads();
    phase_modulate(a, lds);
    __syncthreads();
    for (int j = 0; j < 2; ++j) { const int u = bx + 256 * j; adaln_unit(a, lds, 32 + (u & 63), u >> 6, false); }
}

constexpr int NPHASE = 13;
#ifndef REP_PHASE
#define REP_PHASE -1
#endif
#ifndef ONE_LAUNCH
#define ONE_LAUNCH 1
#endif
__global__ void __launch_bounds__(NTHREADS, 2) mega(Args a) {
    extern __shared__ __attribute__((aligned(16))) unsigned char lds_raw[];
    LAS char* lds = (LAS char*)lds_raw;
    volatile LAS unsigned* misc = (volatile LAS unsigned*)(lds + LDS_MISC);
    if (threadIdx.x < 64) misc[threadIdx.x] = 0u;
    __syncthreads();
    const int G_ = gridDim.x, bx = blockIdx.x;
    const int vcu = (G_ % 8 == 0) ? (bx % 8) * (G_ / 8) + bx / 8 : bx;
    XcdBarrier bar; bar.bar = (unsigned*)(a.ws + WS_CTL) + CW_BAR; bar.x = 0; bar.st = misc + 8;
    if (ONE_LAUNCH) bar = xcd_barrier_post((unsigned*)(a.ws + WS_CTL) + CW_BAR, misc + 8);
    const int lo = a.ph_lo, hi = a.ph_hi;
#ifndef PH_MASK
#define PH_MASK 0x1fff
#endif
#define IN(k) (((PH_MASK >> (k)) & 1) && lo <= (k) && (k) < hi)
#define SEAM(k) do { if (IN(k) && IN((k) + 1)) xcd_barrier(bar); } while (0)
    if (IN(0) && IN(1) && gridDim.x == 256) phase_front(a, lds);
    else {
        if (IN(0)) { phase_cvt(a); phase_adaln(a, lds); }
        SEAM(0);
        if (IN(1)) phase_modulate(a, lds);
    }
    SEAM(1);
    if (IN(2)) { mod_finalize(a); phase_inproj(a, lds, vcu, 0); }
    SEAM(2);
    if (IN(3)) phase_mid(a, lds, vcu);
    if (IN(3) && IN(4)) xcd_barrier(bar);
    if (IN(6)) phase_attn(a, lds, vcu);
    if (IN(7)) phase_retout(a, lds, vcu);
    if (IN(8)) phase_oproj(a, lds, vcu);
    if (IN(9)) phase_router(a, lds, vcu);
    SEAM(9);
    if (IN(10)) phase_moe1(a, lds, vcu);
    SEAM(10);
    if (IN(11)) phase_moe2(a, lds, vcu);
    SEAM(11);
    if (IN(12)) phase_final(a);
}

extern "C" void kernel_launch(void* const* d_in, const int* in_sizes, int n_in, void* d_out, int out_size, void* d_ws, size_t ws_size, hipStream_t stream) {
    static int grid = 0;
    if (grid == 0) {
        if (n_in != 25 || out_size != T * DM || ws_size < WS_END) { fprintf(stderr, "kernel_launch: unexpected shapes: n_in %d out %d ws %zu (need %zu)\n", n_in, out_size, ws_size, (size_t)WS_END); grid = -1; return; }
        int dev = 0, cus = 0, per_cu = 0;
        if (hipGetDevice(&dev) != hipSuccess || hipDeviceGetAttribute(&cus, hipDeviceAttributeMultiprocessorCount, dev) != hipSuccess) { grid = -1; return; }
        if (hipFuncSetAttribute((const void*)mega, hipFuncAttributeMaxDynamicSharedMemorySize, LDS_BYTES) != hipSuccess) { fprintf(stderr, "kernel_launch: hipFuncSetAttribute failed\n"); grid = -1; return; }
        if (hipOccupancyMaxActiveBlocksPerMultiprocessor(&per_cu, (const void*)mega, NTHREADS, LDS_BYTES) != hipSuccess || per_cu < 1) { fprintf(stderr, "kernel_launch: occupancy query says %d blocks per CU\n", per_cu); }
        (void)hipGetLastError();
        grid = cus;
    }
    if (grid < 0) return;
    (void)hipMemsetAsync((char*)d_ws + WS_CTL, 0, CTL_BYTES, stream);
    Args a{};
    for (int i = 0; i < 25; ++i) a.in[i] = (const float*)d_in[i];
    a.out = (float*)d_out; a.ws = (unsigned char*)d_ws;
    if (ONE_LAUNCH) {
        a.ph_lo = 0; a.ph_hi = NPHASE;
        hipLaunchKernelGGL(mega, dim3(grid), dim3(NTHREADS), LDS_BYTES, stream, a);
    } else {
        for (int p = 0; p < NPHASE; ++p) { a.ph_lo = p; a.ph_hi = p + 1;
            for (int r = 0; r < 1 + (p == REP_PHASE); ++r) {
                if (p == 9) (void)hipMemsetAsync((char*)d_ws + WS_CTL, 0, CTL_BYTES, stream);
                hipLaunchKernelGGL(mega, dim3(grid), dim3(NTHREADS), LDS_BYTES, stream, a); } }
    }
    const hipError_t le = hipPeekAtLastError();
    if (le != hipSuccess) fprintf(stderr, "kernel_launch: launch failed: %s\n", hipGetErrorName(le));
}
```
